# Optimizing an MI355X kernel written in HIP

```python
import math
import jax, jax.numpy as jnp
from jax import lax
import numpy as np

D_MODEL = 1024
BATCH = 8
SEQ = 2048
DEPTH = 2

CHUNK = 64
Q_BLOCK = 128
HEAD_DIM = 64
ROPE_THETA = 10000.0
EPS = 1e-6
MAX_POS_OFFSET = 4096
A_HEADS = 8
A_KV_LORA = 256
IDX_HEADS = 4
IDX_DIM = 64
TOPK_MAX = 256
B_HEADS = 8
C_HEADS = 8
C_V_DIM = 128
A_WIDTH = A_HEADS * HEAD_DIM
B_WIDTH = B_HEADS * HEAD_DIM
C_QK_WIDTH = C_HEADS * HEAD_DIM
C_WIDTH = C_HEADS * C_V_DIM
N_BRANCH = 3
IN_SIZES = (A_WIDTH, A_KV_LORA, IDX_HEADS * IDX_DIM, IDX_DIM, IDX_HEADS,
            B_WIDTH, B_WIDTH, B_WIDTH,
            C_QK_WIDTH, C_QK_WIDTH, C_WIDTH, C_WIDTH,
            N_BRANCH * D_MODEL)
N_IN = sum(IN_SIZES)
N_EXPERTS = 64
TOP_K = 8
N_GROUPS = 8
TOPK_GROUPS = 4
EXPERT_DIM = 256
SHARED_DIM = 256
ROUTED_SCALE = 2.5
MOE_BLOCK = 128
N_ADA = 6

kernel_name = "chunk_causal_hybrid_dsa_stickbreak_retention_moe"


def rms_norm(x, g):
    xf = x.astype(jnp.float32)
    y = xf * lax.rsqrt(jnp.mean(xf * xf, axis=-1, keepdims=True) + EPS)
    return (y * g.astype(jnp.float32)).astype(x.dtype)


def rope(x, positions):
    half = x.shape[-1] // 2
    inv_freq = ROPE_THETA ** (-jnp.arange(half, dtype=jnp.float32) / half)
    ang = positions.astype(jnp.float32)[:, :, None, None] * inv_freq
    cos, sin = jnp.cos(ang), jnp.sin(ang)
    xf = x.astype(jnp.float32)
    x1, x2 = xf[..., :half], xf[..., half:]
    return jnp.concatenate([x1 * cos - x2 * sin, x2 * cos + x1 * sin], axis=-1).astype(x.dtype)


def dsa_mixer(q, c_kv, iq, ik, iw, g_kv, w_uk, w_uv, positions):
    b, s, h, d = q.shape
    topk = min(TOPK_MAX, s // 4)
    c_kv = rms_norm(c_kv, g_kv)
    k = rope((c_kv @ w_uk)[:, :, None, :], positions)[:, :, 0]
    v = c_kv @ w_uv
    q = rope(q, positions)
    iq = rope(iq, positions).astype(jnp.float32)
    ik = rope(ik[:, :, None, :], positions)[:, :, 0].astype(jnp.float32)
    iw = iw.astype(jnp.float32) * IDX_HEADS ** -0.5
    key_chunk = jnp.arange(s) // CHUNK

    def block(i):
        t0 = i * Q_BLOCK
        qb = lax.dynamic_slice_in_dim(q, t0, Q_BLOCK, axis=1)
        iqb = lax.dynamic_slice_in_dim(iq, t0, Q_BLOCK, axis=1)
        iwb = lax.dynamic_slice_in_dim(iw, t0, Q_BLOCK, axis=1)
        q_chunk = (t0 + jnp.arange(Q_BLOCK)) // CHUNK
        admissible = key_chunk[None, :] <= q_chunk[:, None]
        logits = jnp.einsum('bthd,bsd->bths', iqb, ik) * IDX_DIM ** -0.5
        score = jnp.einsum('bth,bths->bts', iwb, jax.nn.relu(logits))
        score = jnp.where(admissible[None], score, -jnp.inf)
        _, idx = lax.top_k(score, topk)
        valid = key_chunk[idx] <= q_chunk[None, :, None]
        k_sel = jax.vmap(lambda kb, ib: kb[ib])(k, idx)
        v_sel = jax.vmap(lambda vb, ib: vb[ib])(v, idx)
        sc = jnp.einsum('bthd,btkd->bhtk', qb, k_sel).astype(jnp.float32) * d ** -0.5
        sc = jnp.where(valid[:, None], sc, -jnp.inf)
        p = jax.nn.softmax(sc, axis=-1).astype(v.dtype)
        return jnp.einsum('bhtk,btkd->bthd', p, v_sel)

    out = lax.map(block, jnp.arange(s // Q_BLOCK))
    return jnp.moveaxis(out, 0, 1).reshape(b, s, h * d)


def stick_breaking_mixer(q, k, v):
    b, s, h, d = q.shape
    key_pos = jnp.arange(s)

    def block(i):
        t0 = i * Q_BLOCK
        qb = lax.dynamic_slice_in_dim(q, t0, Q_BLOCK, axis=1)
        z = jnp.einsum('bthd,bshd->bhts', qb, k).astype(jnp.float32) * d ** -0.5
        causal = key_pos[None, :] < (t0 + jnp.arange(Q_BLOCK))[:, None]
        log_beta = jax.nn.log_sigmoid(z)
        log_not = jnp.where(causal, jax.nn.log_sigmoid(-z), 0.0)
        tail = lax.cumsum(log_not, axis=3, reverse=True) - log_not
        a = jnp.where(causal, jnp.exp(log_beta + tail), 0.0)
        return jnp.einsum('bhts,bshd->bthd', a.astype(v.dtype), v)

    out = lax.map(block, jnp.arange(s // Q_BLOCK))
    return jnp.moveaxis(out, 0, 1).reshape(b, s, h * d)


def head_group_norm(o, g):
    b, s, h, dv = o.shape
    of = o.astype(jnp.float32)
    mu = jnp.mean(of, axis=-1, keepdims=True)
    var = jnp.mean(jnp.square(of - mu), axis=-1, keepdims=True)
    y = ((of - mu) * lax.rsqrt(var + EPS)).reshape(b, s, h * dv)
    return y * g.astype(jnp.float32)


def retention_mixer(q, k, v, gate, g_ret, positions):
    b, s, h, dk = q.shape
    dv = v.shape[-1]
    n = s // CHUNK
    log_g = jnp.log(1.0 - 2.0 ** (-5.0 - jnp.arange(h, dtype=jnp.float32)))
    q = rope(q, positions)
    k = rope(k, positions) * dk ** -0.5
    qc = q.reshape(b, n, CHUNK, h, dk)
    kc = k.reshape(b, n, CHUNK, h, dk)
    vc = v.reshape(b, n, CHUNK, h, dv)
    pos = jnp.arange(CHUNK, dtype=jnp.float32)
    decay_in = jnp.exp(log_g[:, None, None] * jnp.abs(pos[:, None] - pos[None, :]))
    sc = jnp.einsum('bnahd,bnchd->bnhac', qc, kc) * decay_in
    intra = jnp.einsum('bnhac,bnche->bnahe', sc, vc)
    zeta = jnp.exp(log_g[:, None] * (CHUNK - 1 - pos))
    kv = jnp.einsum('bnchd,hc,bnche->bnhde', kc, zeta, vc)
    g_chunk = jnp.exp(log_g * CHUNK)[None, :, None, None]

    def step(state, kv_i):
        return state * g_chunk + kv_i, state

    _, prev = lax.scan(step, jnp.zeros_like(kv[:, 0]), jnp.moveaxis(kv, 1, 0))
    prev = jnp.moveaxis(prev, 0, 1)
    xi = jnp.exp(log_g[:, None] * (pos + 1.0))
    cross = jnp.einsum('bnahd,bnhde,ha->bnahe', qc, prev, xi)
    o = (intra + cross).reshape(b, s, h, dv)
    o = head_group_norm(o, g_ret).astype(gate.dtype)
    return jax.nn.silu(gate.reshape(b, s, h * dv)) * o


def mixing_sublayer(h, positions, w_in, g_kv, w_uk, w_uv, g_ret, w_o_a, w_o_b, w_o_c, w_out):
    b, s, d_model = h.shape
    split_points = [int(p) for p in np.cumsum(IN_SIZES)[:-1]]
    z = h @ w_in
    (qa, ckv, iq, ik, iw, qb, kb, vb, qc, kc, vc, gc, gates) = jnp.split(z, split_points, axis=-1)
    ya = dsa_mixer(qa.reshape(b, s, A_HEADS, HEAD_DIM), ckv,
                   iq.reshape(b, s, IDX_HEADS, IDX_DIM), ik, iw, g_kv, w_uk, w_uv, positions) @ w_o_a
    yb = stick_breaking_mixer(qb.reshape(b, s, B_HEADS, HEAD_DIM), kb.reshape(b, s, B_HEADS, HEAD_DIM),
                              vb.reshape(b, s, B_HEADS, HEAD_DIM)) @ w_o_b
    yc = retention_mixer(qc.reshape(b, s, C_HEADS, HEAD_DIM), kc.reshape(b, s, C_HEADS, HEAD_DIM),
                         vc.reshape(b, s, C_HEADS, C_V_DIM), gc.reshape(b, s, C_HEADS, C_V_DIM),
                         g_ret, positions) @ w_o_c
    g = jax.nn.sigmoid(gates.astype(jnp.float32)).astype(h.dtype).reshape(b, s, N_BRANCH, d_model)
    merged = g[:, :, 0] * ya + g[:, :, 1] * yb + g[:, :, 2] * yc
    return merged @ w_out


def moe_sublayer(h, w_router, router_bias, w1, w3, w2, ws1, ws3, ws2):
    b, s, d_model = h.shape
    x = h.reshape(-1, d_model)
    t = x.shape[0]
    scores = jax.nn.sigmoid((x @ w_router).astype(jnp.float32))
    sel = scores + router_bias.astype(jnp.float32)
    grp_score = lax.top_k(sel.reshape(t, N_GROUPS, N_EXPERTS // N_GROUPS), 2)[0].sum(-1)
    _, top_groups = lax.top_k(grp_score, TOPK_GROUPS)
    gmask = jnp.any(top_groups[:, :, None] == jnp.arange(N_GROUPS)[None, None, :], axis=1)
    sel = jnp.where(jnp.repeat(gmask, N_EXPERTS // N_GROUPS, axis=1), sel, -jnp.inf)
    _, eidx = lax.top_k(sel, TOP_K)
    wts = jnp.take_along_axis(scores, eidx, axis=1)
    wts = wts / jnp.sum(wts, axis=-1, keepdims=True) * ROUTED_SCALE
    n_assign = t * TOP_K
    flat_e = eidx.reshape(-1)
    flat_tok = jnp.repeat(jnp.arange(t, dtype=jnp.int32), TOP_K)
    order = jnp.argsort(flat_e)
    se, stok, sw = flat_e[order], flat_tok[order], wts.reshape(-1)[order]
    counts = jnp.zeros((N_EXPERTS,), jnp.int32).at[flat_e].add(1)
    starts = jnp.cumsum(counts) - counts
    padded = (counts + MOE_BLOCK - 1) // MOE_BLOCK * MOE_BLOCK
    pad_ends = jnp.cumsum(padded)
    pad_starts = pad_ends - padded
    dest = pad_starts[se] + (jnp.arange(n_assign, dtype=jnp.int32) - starts[se])
    n_blocks = (n_assign + N_EXPERTS * (MOE_BLOCK - 1) + MOE_BLOCK - 1) // MOE_BLOCK
    n_rows = n_blocks * MOE_BLOCK
    row_tok = jnp.full((n_rows,), t, jnp.int32).at[dest].set(stok)
    row_w = jnp.zeros((n_rows,), jnp.float32).at[dest].set(sw)
    block_e = jnp.minimum(jnp.searchsorted(pad_ends, jnp.arange(n_blocks) * MOE_BLOCK, side='right'),
                          N_EXPERTS - 1)
    x_pad = jnp.concatenate([x, jnp.zeros((1, d_model), x.dtype)], axis=0)

    def run_block(args):
        tok, wt, e = args
        xb = x_pad[tok]
        hid = jax.nn.silu(xb @ w1[e]) * (xb @ w3[e])
        return (hid @ w2[e]) * wt[:, None].astype(x.dtype)

    out = lax.map(run_block, (row_tok.reshape(n_blocks, MOE_BLOCK), row_w.reshape(n_blocks, MOE_BLOCK), block_e))
    routed = jax.ops.segment_sum(out.reshape(n_rows, d_model), row_tok, num_segments=t + 1)[:t]
    shared = (jax.nn.silu(x @ ws1) * (x @ ws3)) @ ws2
    return (routed + shared).reshape(b, s, d_model)


def setup_inputs(seed: int = 0) -> dict:
    key = jax.random.key(seed)
    ks = jax.random.split(key, 32)
    f32 = jnp.float32
    nrm = lambda k, shape, fan_in: jax.random.normal(k, shape, f32) * fan_in ** -0.5
    gain = lambda k, shape: 1.0 + 0.05 * jax.random.normal(k, shape, f32)
    offsets = jax.random.randint(ks[2], (BATCH, 1), 0, MAX_POS_OFFSET, dtype=jnp.int32)
    return {
        "x": jax.random.normal(ks[0], (BATCH, SEQ, D_MODEL), f32),
        "c": jax.random.normal(ks[1], (BATCH, D_MODEL), f32),
        "positions": offsets + jnp.arange(SEQ, dtype=jnp.int32)[None, :],
        "ada_w": nrm(ks[3], (DEPTH, D_MODEL, N_ADA * D_MODEL), D_MODEL) * 0.5,
        "ada_b": 0.02 * jax.random.normal(ks[4], (DEPTH, N_ADA * D_MODEL), f32),
        "g_pre_mix": gain(ks[5], (DEPTH, D_MODEL)),
        "g_post_mix": gain(ks[6], (DEPTH, D_MODEL)),
        "g_pre_ffn": gain(ks[7], (DEPTH, D_MODEL)),
        "g_post_ffn": gain(ks[8], (DEPTH, D_MODEL)),
        "w_in": nrm(ks[9], (DEPTH, D_MODEL, N_IN), D_MODEL),
        "g_kv": gain(ks[10], (DEPTH, A_KV_LORA)),
        "w_uk": nrm(ks[11], (DEPTH, A_KV_LORA, HEAD_DIM), A_KV_LORA),
        "w_uv": nrm(ks[12], (DEPTH, A_KV_LORA, HEAD_DIM), A_KV_LORA),
        "g_ret": gain(ks[13], (DEPTH, C_WIDTH)),
        "w_o_a": nrm(ks[14], (DEPTH, A_WIDTH, D_MODEL), A_WIDTH),
        "w_o_b": nrm(ks[15], (DEPTH, B_WIDTH, D_MODEL), B_WIDTH),
        "w_o_c": nrm(ks[16], (DEPTH, C_WIDTH, D_MODEL), C_WIDTH),
        "w_out": nrm(ks[17], (DEPTH, D_MODEL, D_MODEL), D_MODEL),
        "w_router": nrm(ks[18], (DEPTH, D_MODEL, N_EXPERTS), D_MODEL),
        "router_bias": 0.01 * jax.random.normal(ks[19], (DEPTH, N_EXPERTS), f32),
        "w1": nrm(ks[20], (DEPTH, N_EXPERTS, D_MODEL, EXPERT_DIM), D_MODEL),
        "w3": nrm(ks[21], (DEPTH, N_EXPERTS, D_MODEL, EXPERT_DIM), D_MODEL),
        "w2": nrm(ks[22], (DEPTH, N_EXPERTS, EXPERT_DIM, D_MODEL), EXPERT_DIM),
        "ws1": nrm(ks[23], (DEPTH, D_MODEL, SHARED_DIM), D_MODEL),
        "ws3": nrm(ks[24], (DEPTH, D_MODEL, SHARED_DIM), D_MODEL),
        "ws2": nrm(ks[25], (DEPTH, SHARED_DIM, D_MODEL), SHARED_DIM),
    }


def reference(x, c, positions, ada_w, ada_b, g_pre_mix, g_post_mix, g_pre_ffn, g_post_ffn,
              w_in, g_kv, w_uk, w_uv, g_ret, w_o_a, w_o_b, w_o_c, w_out,
              w_router, router_bias, w1, w3, w2, ws1, ws3, ws2):
    for l in range(DEPTH):
        mod = (jax.nn.silu(c) @ ada_w[l] + ada_b[l])[:, None, :]
        sh1, sc1, gt1, sh2, sc2, gt2 = jnp.split(mod, N_ADA, axis=-1)
        h = rms_norm(x, g_pre_mix[l]) * (1.0 + sc1) + sh1
        y = mixing_sublayer(h, positions, w_in[l], g_kv[l], w_uk[l], w_uv[l], g_ret[l],
                            w_o_a[l], w_o_b[l], w_o_c[l], w_out[l])
        x = x + gt1 * rms_norm(y, g_post_mix[l])
        h = rms_norm(x, g_pre_ffn[l]) * (1.0 + sc2) + sh2
        y = moe_sublayer(h, w_router[l], router_bias[l], w1[l], w3[l], w2[l], ws1[l], ws3[l], ws2[l])
        x = x + gt2 * rms_norm(y, g_post_ffn[l])
    return x
```

```cpp
#include <hip/hip_runtime.h>
#include <stdint.h>
#include <stdio.h>
#include <string.h>

typedef unsigned short bf16_t;
typedef short bf16x8 __attribute__((ext_vector_type(8)));
typedef short bf16x4 __attribute__((ext_vector_type(4)));
typedef float f32x4 __attribute__((ext_vector_type(4)));
typedef float f32x2 __attribute__((ext_vector_type(2)));
typedef unsigned u32x4 __attribute__((ext_vector_type(4)));
typedef unsigned u32x2 __attribute__((ext_vector_type(2)));

constexpr int T_ = 16384, S_ = 2048, NB_ = 8, D_ = 1024, DEPTH_ = 2;
constexpr int NIN_ = 8772;
constexpr int NZ_ = 8960;
constexpr float EPS_ = 1e-6f;

constexpr int C_QA = 0, C_CKV = 512, C_IQ = 768, C_IK = 1024, C_IW = 1088, C_QB = 1152, C_KB = 1664, C_VB = 2176,
              C_QC = 2688, C_KC = 3200, C_VC = 3712, C_GC = 4736, C_GATES = 5760, C_KA = 8832, C_VA = 8896;

constexpr size_t KiB = 1024, MiB = 1024 * 1024;
constexpr size_t OFF_CTL = 0;
constexpr size_t OFF_MOD = 64 * KiB;
constexpr size_t OFF_IW = 512 * KiB;
constexpr size_t OFF_CKVSS = 768 * KiB;
constexpr size_t OFF_AW = 1 * MiB;
constexpr size_t OFF_ROPE = 2 * MiB;
constexpr size_t OFF_LIST = 6 * MiB;
constexpr size_t OFF_MASKB = 10 * MiB;
constexpr size_t OFF_WB = 14 * MiB;
constexpr size_t WB_WIN = 0;
constexpr size_t WB_WOA = WB_WIN + (size_t)NZ_ * 1024;
constexpr size_t WB_WOB = WB_WOA + 1024 * 512;
constexpr size_t WB_WOC = WB_WOB + 1024 * 512;
constexpr size_t WB_WOUT = WB_WOC + 1024 * 1024;
constexpr size_t WB_WR = WB_WOUT + 1024 * 1024;
constexpr size_t WB_W13 = WB_WR + 128 * 1024;
constexpr size_t WB_W2 = WB_W13 + (size_t)65 * 512 * 1024;
constexpr size_t WB_END = WB_W2 + (size_t)65 * 1024 * 256;
constexpr size_t OFF_H = OFF_WB + ((WB_END * 2 + MiB - 1) / MiB) * MiB;
constexpr size_t OFF_R1 = OFF_H + 32 * MiB;
constexpr size_t R1_QA = 0;
constexpr size_t R1_IQ = R1_QA + 16 * MiB;
constexpr size_t R1_IK = R1_IQ + 8 * MiB;
constexpr size_t R1_KA = R1_IK + 2 * MiB;
constexpr size_t R1_VAT = R1_KA + 2 * MiB;
constexpr size_t R1_QB = R1_VAT + 2 * MiB;
constexpr size_t R1_KB = R1_QB + 16 * MiB;
constexpr size_t R1_VBT = R1_KB + 16 * MiB;
constexpr size_t R1_QC = R1_VBT + 16 * MiB;
constexpr size_t R1_KC = R1_QC + 16 * MiB;
constexpr size_t R1_KCT = R1_KC + 16 * MiB;
constexpr size_t R1_VCT = R1_KCT + 16 * MiB;
constexpr size_t R1_GC = R1_VCT + 32 * MiB;
constexpr size_t R1_GATES = R1_GC + 32 * MiB;
constexpr size_t R1_ZEND = R1_GATES + 96 * MiB;
constexpr size_t R1_SIZE = 288 * MiB;
constexpr size_t OFF_R3 = OFF_R1 + R1_SIZE;
constexpr size_t R3_SIZE = 78 * MiB;
constexpr size_t WS_TOTAL = OFF_R3 + R3_SIZE;
static_assert(R1_ZEND <= R1_SIZE, "r1");
constexpr size_t SC_PER_BATCH = 2162688;

__constant__ float INVF[32] = {
    1.000000000e+00f, 7.498942614e-01f, 5.623413324e-01f, 4.216965139e-01f, 3.162277639e-01f, 2.371373773e-01f, 1.778279394e-01f, 1.333521307e-01f,
    1.000000015e-01f, 7.498941571e-02f, 5.623413250e-02f, 4.216965288e-02f, 3.162277490e-02f, 2.371373773e-02f, 1.778279431e-02f, 1.333521493e-02f,
    9.999999776e-03f, 7.498941850e-03f, 5.623413250e-03f, 4.216964822e-03f, 3.162277630e-03f, 2.371373586e-03f, 1.778279431e-03f, 1.333521446e-03f,
    1.000000047e-03f, 7.498942432e-04f, 5.623413017e-04f, 4.216965172e-04f, 3.162277571e-04f, 2.371373703e-04f, 1.778279402e-04f, 1.333521504e-04f};

__constant__ float LOGG[8] = {-0.0317486983145803f, -0.015748356968139168f, -0.007843177461025893f, -0.003913899321136329f,
                               -0.0019550348358033506f, -0.0009770396478266127f, -0.0004884004981088745f, -0.0002441704321739145f};

__device__ __forceinline__ float bf2f(bf16_t u) { return __uint_as_float(((unsigned)u) << 16); }
__device__ __forceinline__ bf16_t f2bf(float f) {
    unsigned u = __float_as_uint(f);
    u += 0x7fffu + ((u >> 16) & 1u);
    return (bf16_t)(u >> 16);
}
__device__ __forceinline__ unsigned pack2(float a, float b) { return (unsigned)f2bf(a) | ((unsigned)f2bf(b) << 16); }
__device__ __forceinline__ float sigmoidf_(float x) { return 1.0f / (1.0f + __expf(-x)); }
__device__ __forceinline__ float siluf_(float x) { return x / (1.0f + __expf(-x)); }
__device__ __forceinline__ float wave_sum(float v) {
#pragma unroll
    for (int o = 32; o >= 1; o >>= 1) v += __shfl_xor(v, o);
    return v;
}
__device__ __forceinline__ int wave_sum_i(int v) {
#pragma unroll
    for (int o = 32; o >= 1; o >>= 1) v += __shfl_xor(v, o);
    return v;
}

struct Params {
    const float* x; const float* c; const int* positions; const float* ada_w; const float* ada_b;
    const float* g_pre_mix; const float* g_post_mix; const float* g_pre_ffn; const float* g_post_ffn;
    const float* w_in; const float* g_kv; const float* w_uk; const float* w_uv; const float* g_ret;
    const float* w_o_a; const float* w_o_b; const float* w_o_c; const float* w_out;
    const float* w_router; const float* router_bias; const float* w1; const float* w3; const float* w2;
    const float* ws1; const float* ws3; const float* ws2;
    float* out;
    unsigned char* ws;
};

__global__ void __launch_bounds__(256) k_rope(Params p) {
    int idx = blockIdx.x * 256 + threadIdx.x;
    if (idx >= T_ * 32) return;
    int t = idx >> 5, i = idx & 31;
    float ang = (float)p.positions[t] * INVF[i];
    double rev = (double)ang * 0.15915494309189535;
    double fr = rev - rint(rev);
    float r = (float)(fr * 6.283185307179586);
    f32x2 cs; cs.x = __cosf(r); cs.y = __sinf(r);
    ((f32x2*)(p.ws + OFF_ROPE))[idx] = cs;
}

__global__ void __launch_bounds__(256) k_mod(Params p) {
    __shared__ float sc[8 * 1024];
    __shared__ float part[4 * 8 * 64];
    const int tid = threadIdx.x;
    const int l = blockIdx.x / 96, jb = (blockIdx.x % 96) * 64;
    for (int i = tid; i < 8192; i += 256) sc[i] = siluf_(p.c[i]);
    __syncthreads();
    const int jj = tid & 63, kg = tid >> 6;
    float acc[8];
#pragma unroll
    for (int b = 0; b < 8; ++b) acc[b] = 0.f;
    const float* w = p.ada_w + (size_t)l * 1024 * 6144 + jb + jj;
    for (int k = kg * 256; k < kg * 256 + 256; ++k) {
        float wv = w[(size_t)k * 6144];
#pragma unroll
        for (int b = 0; b < 8; ++b) acc[b] += sc[b * 1024 + k] * wv;
    }
#pragma unroll
    for (int b = 0; b < 8; ++b) part[(kg * 8 + b) * 64 + jj] = acc[b];
    __syncthreads();
    if (tid < 64) {
        float* mod = (float*)(p.ws + OFF_MOD);
#pragma unroll
        for (int b = 0; b < 8; ++b) {
            float r = part[(0 * 8 + b) * 64 + jj] + part[(1 * 8 + b) * 64 + jj] + part[(2 * 8 + b) * 64 + jj] + part[(3 * 8 + b) * 64 + jj];
            mod[(size_t)(l * 8 + b) * 6144 + jb + jj] = r + p.ada_b[l * 6144 + jb + jj];
        }
    }
}

struct TJob {
    const float* src; bf16_t* dst;
    int K, NQ, src_ld, dst_ld, mode, p0, nbatch, pad;
    size_t src_bs, dst_bs;
};
__device__ __forceinline__ int tj_src_col(int mode, int p0, int q) {
    if (mode == 0) return q + p0;
    if (mode == 1) return q < 1092 ? q : (q < 1152 ? -1 : q - 60);
    if (mode == 2) return q;
    return q < 64 ? q : -1;
}
__device__ __forceinline__ int tj_dst_row(int mode, int p0, int q) {
    if (mode == 2) return (q >> 5) * 64 + p0 + (q & 31);
    return q;
}
__global__ void __launch_bounds__(256) k_tconv(TJob j) {
    __shared__ float tile[64][65];
    const int tid = threadIdx.x;
    const int nq = j.NQ / 64, nk = j.K / 64;
    const int per = nq * nk, total = per * j.nbatch;
    for (int it = blockIdx.x; it < total; it += gridDim.x) {
        const int b = it / per, r = it % per, qt = r / nk, kt = r % nk;
        const float* src = j.src + (size_t)b * j.src_bs;
        bf16_t* dst = j.dst + (size_t)b * j.dst_bs;
        const int q0 = qt * 64, k0 = kt * 64;
        {
            const int tx = tid & 63, ty = tid >> 6;
            const int sc = tj_src_col(j.mode, j.p0, q0 + tx);
#pragma unroll 4
            for (int kk = ty; kk < 64; kk += 4) tile[kk][tx] = sc >= 0 ? src[(size_t)(k0 + kk) * j.src_ld + sc] : 0.f;
        }
        __syncthreads();
        {
            const int nn = tid >> 2, kc = (tid & 3) * 16;
            const int dr = tj_dst_row(j.mode, j.p0, q0 + nn);
            unsigned w[8];
#pragma unroll
            for (int i = 0; i < 8; ++i) w[i] = pack2(tile[kc + 2 * i][nn], tile[kc + 2 * i + 1][nn]);
            u32x4* d = (u32x4*)(dst + (size_t)dr * j.dst_ld + k0 + kc);
            d[0] = (u32x4){w[0], w[1], w[2], w[3]};
            d[1] = (u32x4){w[4], w[5], w[6], w[7]};
        }
        __syncthreads();
    }
}

__global__ void __launch_bounds__(256) k_wcomp(Params p, int l) {
    __shared__ float row[2][256];
    const int tid = threadIdx.x;
    const int k0 = blockIdx.x * 2;
    {
        const int kk = tid >> 7, jj = tid & 127;
        const float* wi = p.w_in + ((size_t)l * 1024 + k0 + kk) * NIN_ + 512;
        row[kk][jj] = wi[jj] * p.g_kv[l * 256 + jj];
        row[kk][jj + 128] = wi[jj + 128] * p.g_kv[l * 256 + jj + 128];
    }
    __syncthreads();
    const int kk = tid >> 7, n = tid & 127;
    const float* wu = (n < 64) ? (p.w_uk + (size_t)l * 256 * 64 + n) : (p.w_uv + (size_t)l * 256 * 64 + (n - 64));
    float acc = 0.f;
    for (int jx = 0; jx < 256; ++jx) acc += row[kk][jx] * wu[jx * 64];
    bf16_t* WinT = (bf16_t*)(p.ws + OFF_WB) + WB_WIN;
    WinT[(size_t)(C_KA + n) * 1024 + k0 + kk] = f2bf(acc);
}

struct NormArgs {
    const float* xin; const bf16_t* Y; const bf16_t* slots;
    const float* gpost; const float* gt;
    const float* gpre; const float* sc; const float* sh;
    int mode;
};
__global__ void __launch_bounds__(256) k_norm(Params p, NormArgs a) {
    const int lane = threadIdx.x & 63;
    const int row = blockIdx.x * 4 + (threadIdx.x >> 6);
    if (row >= T_) return;
    const int b = row >> 11;
    float* xo = p.out + (size_t)row * 1024;
    f32x4 xv[4];
    if (a.mode == 0) {
#pragma unroll
        for (int i = 0; i < 4; ++i) xv[i] = *(const f32x4*)(a.xin + (size_t)row * 1024 + i * 256 + lane * 4);
    } else {
        f32x4 yv[4];
        if (a.mode == 1) {
#pragma unroll
            for (int i = 0; i < 4; ++i) {
                u32x2 u = *(const u32x2*)(a.Y + (size_t)row * 1024 + i * 256 + lane * 4);
                yv[i][0] = __uint_as_float(u.x << 16); yv[i][1] = __uint_as_float(u.x & 0xffff0000u);
                yv[i][2] = __uint_as_float(u.y << 16); yv[i][3] = __uint_as_float(u.y & 0xffff0000u);
            }
        } else {
#pragma unroll
            for (int i = 0; i < 4; ++i) yv[i] = (f32x4){0.f, 0.f, 0.f, 0.f};
#pragma unroll
            for (int k = 0; k < 9; ++k) {
                const bf16_t* sp = a.slots + (k < 8 ? ((size_t)row * 8 + k) : ((size_t)8 * T_ + row)) * 1024;
#pragma unroll
                for (int i = 0; i < 4; ++i) {
                    u32x2 u = *(const u32x2*)(sp + i * 256 + lane * 4);
                    yv[i][0] += __uint_as_float(u.x << 16); yv[i][1] += __uint_as_float(u.x & 0xffff0000u);
                    yv[i][2] += __uint_as_float(u.y << 16); yv[i][3] += __uint_as_float(u.y & 0xffff0000u);
                }
            }
        }
        float ss = 0.f;
#pragma unroll
        for (int i = 0; i < 4; ++i) ss += yv[i][0] * yv[i][0] + yv[i][1] * yv[i][1] + yv[i][2] * yv[i][2] + yv[i][3] * yv[i][3];
        ss = wave_sum(ss);
        const float rs = rsqrtf(ss * (1.0f / 1024.0f) + EPS_);
#pragma unroll
        for (int i = 0; i < 4; ++i) {
            const int col = i * 256 + lane * 4;
            f32x4 xo4 = *(const f32x4*)(xo + col);
            f32x4 g4 = *(const f32x4*)(a.gpost + col);
            f32x4 gt4 = *(const f32x4*)(a.gt + (size_t)b * 6144 + col);
            xv[i] = xo4 + gt4 * (yv[i] * rs * g4);
        }
    }
#pragma unroll
    for (int i = 0; i < 4; ++i) *(f32x4*)(xo + i * 256 + lane * 4) = xv[i];
    if (a.gpre) {
        float ss = 0.f;
#pragma unroll
        for (int i = 0; i < 4; ++i) ss += xv[i][0] * xv[i][0] + xv[i][1] * xv[i][1] + xv[i][2] * xv[i][2] + xv[i][3] * xv[i][3];
        ss = wave_sum(ss);
        const float rs = rsqrtf(ss * (1.0f / 1024.0f) + EPS_);
        bf16_t* H = (bf16_t*)(p.ws + OFF_H) + (size_t)row * 1024;
#pragma unroll
        for (int i = 0; i < 4; ++i) {
            const int col = i * 256 + lane * 4;
            f32x4 g4 = *(const f32x4*)(a.gpre + col);
            f32x4 sc4 = *(const f32x4*)(a.sc + (size_t)b * 6144 + col);
            f32x4 sh4 = *(const f32x4*)(a.sh + (size_t)b * 6144 + col);
            f32x4 h = (xv[i] * rs * g4) * (sc4 + 1.0f) + sh4;
            u32x2 u; u.x = pack2(h[0], h[1]); u.y = pack2(h[2], h[3]);
            *(u32x2*)(H + col) = u;
        }
    }
}

constexpr int LDT = 72;
struct __attribute__((aligned(16))) GemmLds { bf16_t A[128 * LDT]; bf16_t B[128 * LDT]; };

__device__ __forceinline__ void gemm_kloop(f32x4 (&acc)[4][4], const bf16_t* const (&ap)[4], const bf16_t* const (&bp)[4], int K,
                                           bf16_t* sA, bf16_t* sB, int tid) {
    const int lane = tid & 63, wid = tid >> 6, wr = wid >> 1, wc = wid & 1, fr = lane & 15, fq = lane >> 4;
    u32x4 ra[4], rb[4];
#pragma unroll
    for (int i = 0; i < 4; ++i) { ra[i] = *(const u32x4*)(ap[i]); rb[i] = *(const u32x4*)(bp[i]); }
    const int srow = tid >> 3, scol = (tid & 7) * 8;
    for (int k0 = 0; k0 < K; k0 += 64) {
        __syncthreads();
#pragma unroll
        for (int i = 0; i < 4; ++i) {
            *(u32x4*)(sA + (srow + 32 * i) * LDT + scol) = ra[i];
            *(u32x4*)(sB + (srow + 32 * i) * LDT + scol) = rb[i];
        }
        __syncthreads();
        if (k0 + 64 < K) {
#pragma unroll
            for (int i = 0; i < 4; ++i) { ra[i] = *(const u32x4*)(ap[i] + k0 + 64); rb[i] = *(const u32x4*)(bp[i] + k0 + 64); }
        }
#pragma unroll
        for (int ks = 0; ks < 2; ++ks) {
            bf16x8 af[4], bfv[4];
#pragma unroll
            for (int m = 0; m < 4; ++m) af[m] = *(const bf16x8*)(sA + (wr * 64 + m * 16 + fr) * LDT + ks * 32 + fq * 8);
#pragma unroll
            for (int n = 0; n < 4; ++n) bfv[n] = *(const bf16x8*)(sB + (wc * 64 + n * 16 + fr) * LDT + ks * 32 + fq * 8);
#pragma unroll
            for (int m = 0; m < 4; ++m)
#pragma unroll
                for (int n = 0; n < 4; ++n) acc[m][n] = __builtin_amdgcn_mfma_f32_16x16x32_bf16(af[m], bfv[n], acc[m][n], 0, 0, 0);
        }
    }
}
__device__ __forceinline__ void zero_acc(f32x4 (&acc)[4][4]) {
#pragma unroll
    for (int m = 0; m < 4; ++m)
#pragma unroll
        for (int n = 0; n < 4; ++n) acc[m][n] = (f32x4){0.f, 0.f, 0.f, 0.f};
}

__device__ __forceinline__ void store_rope(const f32x4 (&acc)[4][4], bf16_t* dst, int ld, int dcol, float scale, const f32x2* rope, int rowbase, int fr, int fq) {
#pragma unroll
    for (int m = 0; m < 4; ++m)
#pragma unroll
        for (int j = 0; j < 4; ++j) {
            const int t = rowbase + m * 16 + fq * 4 + j;
#pragma unroll
            for (int nn = 0; nn < 2; ++nn) {
                const f32x2 cs = rope[(size_t)t * 32 + nn * 16 + fr];
                const float x1 = acc[m][nn][j], x2 = acc[m][nn + 2][j];
                dst[(size_t)t * ld + dcol + nn * 16 + fr] = f2bf((x1 * cs.x - x2 * cs.y) * scale);
                dst[(size_t)t * ld + dcol + (nn + 2) * 16 + fr] = f2bf((x2 * cs.x + x1 * cs.y) * scale);
            }
        }
}
__device__ __forceinline__ void store_plain(const f32x4 (&acc)[4][4], bf16_t* dst, int ld, int dcol, float scale, int act, int rowbase, int fr, int fq) {
#pragma unroll
    for (int m = 0; m < 4; ++m)
#pragma unroll
        for (int j = 0; j < 4; ++j) {
            const int t = rowbase + m * 16 + fq * 4 + j;
#pragma unroll
            for (int n = 0; n < 4; ++n) {
                float v = acc[m][n][j] * scale;
                if (act == 1) v = sigmoidf_(v);
                else if (act == 2) v = siluf_(v);
                dst[(size_t)t * ld + dcol + n * 16 + fr] = f2bf(v);
            }
        }
}
__device__ __forceinline__ void store_trans(const f32x4 (&acc)[4][4], bf16_t* dstT, int rows_per_b, int rowoff, int rowbase, int fr, int fq) {
#pragma unroll
    for (int m = 0; m < 4; ++m) {
        const int t = rowbase + m * 16 + fq * 4;
        const int b = t >> 11, s = t & 2047;
#pragma unroll
        for (int n = 0; n < 4; ++n) {
            u32x2 u; u.x = pack2(acc[m][n][0], acc[m][n][1]); u.y = pack2(acc[m][n][2], acc[m][n][3]);
            *(u32x2*)(dstT + ((size_t)b * rows_per_b + rowoff + n * 16 + fr) * 2048 + s) = u;
        }
    }
}

__global__ void __launch_bounds__(256, 2) k_gemm_z(Params p) {
    __shared__ GemmLds sm;
    const int tid = threadIdx.x, lane = tid & 63, wid = tid >> 6, wr = wid >> 1, wc = wid & 1, fr = lane & 15, fq = lane >> 4;
    const bf16_t* H = (const bf16_t*)(p.ws + OFF_H);
    const bf16_t* WinT = (const bf16_t*)(p.ws + OFF_WB) + WB_WIN;
    unsigned char* r1 = p.ws + OFF_R1;
    const f32x2* rope = (const f32x2*)(p.ws + OFF_ROPE);
    const int ntiles = 128 * 70;
    for (int tile = blockIdx.x; tile < ntiles; tile += gridDim.x) {
        const int mt = tile / 70, nt = tile % 70;
        const int m0 = mt * 128, n0 = nt * 128;
        const bf16_t* ap[4]; const bf16_t* bp[4];
#pragma unroll
        for (int i = 0; i < 4; ++i) {
            ap[i] = H + (size_t)(m0 + (tid >> 3) + 32 * i) * 1024 + (tid & 7) * 8;
            bp[i] = WinT + (size_t)(n0 + (tid >> 3) + 32 * i) * 1024 + (tid & 7) * 8;
        }
        f32x4 acc[4][4];
        zero_acc(acc);
        gemm_kloop(acc, ap, bp, 1024, sm.A, sm.B, tid);
        const int c0 = n0 + wc * 64;
        const int rowbase = m0 + wr * 64;
        if (c0 < C_CKV) {
            store_rope(acc, (bf16_t*)(r1 + R1_QA), 512, c0 - C_QA, 0.125f, rope, rowbase, fr, fq);
        } else if (c0 < C_IQ) {
            float* ss = (float*)(p.ws + OFF_CKVSS);
            const int blk = (c0 - C_CKV) >> 6;
#pragma unroll
            for (int m = 0; m < 4; ++m)
#pragma unroll
                for (int j = 0; j < 4; ++j) {
                    float s = 0.f;
#pragma unroll
                    for (int n = 0; n < 4; ++n) s += acc[m][n][j] * acc[m][n][j];
                    s += __shfl_xor(s, 1); s += __shfl_xor(s, 2); s += __shfl_xor(s, 4); s += __shfl_xor(s, 8);
                    if (fr == 0) ss[(size_t)(rowbase + m * 16 + fq * 4 + j) * 4 + blk] = s;
                }
        } else if (c0 < C_IK) {
            store_rope(acc, (bf16_t*)(r1 + R1_IQ), 256, c0 - C_IQ, 1.0f, rope, rowbase, fr, fq);
        } else if (c0 < C_IW) {
            store_rope(acc, (bf16_t*)(r1 + R1_IK), 64, 0, 1.0f, rope, rowbase, fr, fq);
        } else if (c0 < C_QB) {
            float* iw = (float*)(p.ws + OFF_IW);
            if (fr < 4) {
#pragma unroll
                for (int m = 0; m < 4; ++m)
#pragma unroll
                    for (int j = 0; j < 4; ++j) iw[(size_t)(rowbase + m * 16 + fq * 4 + j) * 4 + fr] = acc[m][0][j] * 0.0625f;
            }
        } else if (c0 < C_KB) {
            store_plain(acc, (bf16_t*)(r1 + R1_QB), 512, c0 - C_QB, 0.125f, 0, rowbase, fr, fq);
        } else if (c0 < C_VB) {
            store_plain(acc, (bf16_t*)(r1 + R1_KB), 512, c0 - C_KB, 1.0f, 0, rowbase, fr, fq);
        } else if (c0 < C_QC) {
            store_trans(acc, (bf16_t*)(r1 + R1_VBT), 512, c0 - C_VB, rowbase, fr, fq);
        } else if (c0 < C_KC) {
            store_rope(acc, (bf16_t*)(r1 + R1_QC), 512, c0 - C_QC, 1.0f, rope, rowbase, fr, fq);
        } else if (c0 < C_VC) {
            store_rope(acc, (bf16_t*)(r1 + R1_KC), 512, c0 - C_KC, 0.125f, rope, rowbase, fr, fq);
            bf16_t* kct = (bf16_t*)(r1 + R1_KCT);
#pragma unroll
            for (int m = 0; m < 4; ++m) {
                const int t0 = rowbase + m * 16 + fq * 4;
                const int b = t0 >> 11, s = t0 & 2047;
#pragma unroll
                for (int nn = 0; nn < 2; ++nn) {
                    float o1[4], o2[4];
#pragma unroll
                    for (int j = 0; j < 4; ++j) {
                        const f32x2 cs = rope[(size_t)(t0 + j) * 32 + nn * 16 + fr];
                        const float x1 = acc[m][nn][j], x2 = acc[m][nn + 2][j];
                        o1[j] = (x1 * cs.x - x2 * cs.y) * 0.125f;
                        o2[j] = (x2 * cs.x + x1 * cs.y) * 0.125f;
                    }
                    u32x2 u1, u2;
                    u1.x = pack2(o1[0], o1[1]); u1.y = pack2(o1[2], o1[3]);
                    u2.x = pack2(o2[0], o2[1]); u2.y = pack2(o2[2], o2[3]);
                    *(u32x2*)(kct + ((size_t)b * 512 + (c0 - C_KC) + nn * 16 + fr) * 2048 + s) = u1;
                    *(u32x2*)(kct + ((size_t)b * 512 + (c0 - C_KC) + (nn + 2) * 16 + fr) * 2048 + s) = u2;
                }
            }
        } else if (c0 < C_GC) {
            store_trans(acc, (bf16_t*)(r1 + R1_VCT), 1024, c0 - C_VC, rowbase, fr, fq);
        } else if (c0 < C_GATES) {
            store_plain(acc, (bf16_t*)(r1 + R1_GC), 1024, c0 - C_GC, 1.0f, 2, rowbase, fr, fq);
        } else if (c0 < C_KA) {
            store_plain(acc, (bf16_t*)(r1 + R1_GATES), 3072, c0 - C_GATES, 1.0f, 1, rowbase, fr, fq);
        } else if (c0 < C_VA) {
            store_rope(acc, (bf16_t*)(r1 + R1_KA), 64, 0, 1.0f, rope, rowbase, fr, fq);
        } else {
            store_trans(acc, (bf16_t*)(r1 + R1_VAT), 64, 0, rowbase, fr, fq);
        }
    }
}

struct __attribute__((aligned(16))) AttnLds { bf16_t K[64 * LDT]; bf16_t Vt[64 * LDT]; float rs[64]; };

__device__ __forceinline__ void stage_tile64(bf16_t* dst, const bf16_t* src, size_t src_ld, int tid) {
#pragma unroll
    for (int i = 0; i < 2; ++i) {
        const int c = tid + 256 * i, row = c >> 3, col8 = (c & 7) * 8;
        *(u32x4*)(dst + row * LDT + col8) = *(const u32x4*)(src + (size_t)row * src_ld + col8);
    }
}

__global__ void __launch_bounds__(256) k_mix_b(Params p) {
    __shared__ AttnLds sm;
    const int tid = threadIdx.x, lane = tid & 63, w = tid >> 6, fr = lane & 15, fq = lane >> 4;
    unsigned char* r1 = p.ws + OFF_R1;
    bf16_t* QB = (bf16_t*)(r1 + R1_QB);
    const bf16_t* KB = (const bf16_t*)(r1 + R1_KB);
    const bf16_t* VBT = (const bf16_t*)(r1 + R1_VBT);
    for (int item = blockIdx.x; item < 2048; item += gridDim.x) {
        const int qt = 31 - (item >> 6), bh = item & 63, b = bh >> 3, h = bh & 7;
        const int tq = b * 2048 + qt * 64 + 16 * w + fr;
        const int tl = 16 * w + fr;
        bf16x8 qf[2];
#pragma unroll
        for (int ks = 0; ks < 2; ++ks) qf[ks] = *(const bf16x8*)(QB + (size_t)tq * 512 + h * 64 + ks * 32 + fq * 8);
        f32x4 O[4];
#pragma unroll
        for (int me = 0; me < 4; ++me) O[me] = (f32x4){0.f, 0.f, 0.f, 0.f};
        float R = 0.f;
        for (int kt = qt; kt >= 0; --kt) {
            __syncthreads();
            stage_tile64(sm.K, KB + (size_t)(b * 2048 + kt * 64) * 512 + h * 64, 512, tid);
            stage_tile64(sm.Vt, VBT + ((size_t)(b * 8 + h) * 64) * 2048 + kt * 64, 2048, tid);
            __syncthreads();
            f32x4 st[4];
#pragma unroll
            for (int mk = 0; mk < 4; ++mk) {
                st[mk] = (f32x4){0.f, 0.f, 0.f, 0.f};
#pragma unroll
                for (int ks = 0; ks < 2; ++ks) {
                    bf16x8 kf = *(const bf16x8*)(sm.K + (mk * 16 + fr) * LDT + ks * 32 + fq * 8);
                    st[mk] = __builtin_amdgcn_mfma_f32_16x16x32_bf16(kf, qf[ks], st[mk], 0, 0, 0);
                }
            }
            const bool diag = (kt == qt);
            float Lv[4][4], P[4];
#pragma unroll
            for (int mk = 0; mk < 4; ++mk) {
                P[mk] = 0.f;
#pragma unroll
                for (int r = 0; r < 4; ++r) {
                    const float z = st[mk][r];
                    const bool valid = !diag || (16 * mk + 4 * fq + r < tl);
                    const float sp = fmaxf(z, 0.f) + __logf(1.0f + __expf(-fabsf(z)));
                    Lv[mk][r] = valid ? -sp : 0.f;
                    P[mk] += Lv[mk][r];
                }
            }
            float tot[4], above[4];
#pragma unroll
            for (int mk = 0; mk < 4; ++mk) {
                const float p0 = __shfl(P[mk], fr), p1 = __shfl(P[mk], fr + 16), p2 = __shfl(P[mk], fr + 32), p3 = __shfl(P[mk], fr + 48);
                tot[mk] = (p0 + p1) + (p2 + p3);
                above[mk] = (fq < 1 ? p1 : 0.f) + (fq < 2 ? p2 : 0.f) + (fq < 3 ? p3 : 0.f);
            }
            float higher[4];
            higher[3] = 0.f; higher[2] = tot[3]; higher[1] = tot[3] + tot[2]; higher[0] = tot[3] + tot[2] + tot[1];
            float A[4][4];
#pragma unroll
            for (int mk = 0; mk < 4; ++mk) {
                float suf = above[mk] + higher[mk] + R;
#pragma unroll
                for (int r = 3; r >= 0; --r) {
                    suf += Lv[mk][r];
                    const bool valid = !diag || (16 * mk + 4 * fq + r < tl);
                    A[mk][r] = valid ? __expf(st[mk][r] + suf) : 0.f;
                }
            }
            R += (tot[0] + tot[1]) + (tot[2] + tot[3]);
#pragma unroll
            for (int ks = 0; ks < 2; ++ks) {
                bf16x8 pf;
                {
                    unsigned u0 = pack2(A[2 * ks][0], A[2 * ks][1]), u1 = pack2(A[2 * ks][2], A[2 * ks][3]);
                    unsigned u2 = pack2(A[2 * ks + 1][0], A[2 * ks + 1][1]), u3 = pack2(A[2 * ks + 1][2], A[2 * ks + 1][3]);
                    u32x4 uu = (u32x4){u0, u1, u2, u3};
                    pf = *(bf16x8*)&uu;
                }
#pragma unroll
                for (int me = 0; me < 4; ++me) {
                    const bf16_t* vp = sm.Vt + (me * 16 + fr) * LDT + ks * 32 + 4 * fq;
                    u32x2 lo = *(const u32x2*)vp, hi = *(const u32x2*)(vp + 16);
                    u32x4 vv = (u32x4){lo.x, lo.y, hi.x, hi.y};
                    O[me] = __builtin_amdgcn_mfma_f32_16x16x32_bf16(*(bf16x8*)&vv, pf, O[me], 0, 0, 0);
                }
            }
        }
#pragma unroll
        for (int me = 0; me < 4; ++me) {
            u32x2 u; u.x = pack2(O[me][0], O[me][1]); u.y = pack2(O[me][2], O[me][3]);
            *(u32x2*)(QB + (size_t)tq * 512 + h * 64 + me * 16 + 4 * fq) = u;
        }
    }
}

struct __attribute__((aligned(16))) RetLds { bf16_t Q[64 * LDT]; bf16_t K[64 * LDT]; bf16_t KT[64 * LDT]; bf16_t VT[128 * LDT]; bf16_t ST[128 * LDT]; };

__global__ void __launch_bounds__(256) k_mix_c(Params p, int l) {
    __shared__ RetLds sm;
    const int tid = threadIdx.x, lane = tid & 63, w = tid >> 6, fr = lane & 15, fq = lane >> 4;
    unsigned char* r1 = p.ws + OFF_R1;
    const bf16_t* QC = (const bf16_t*)(r1 + R1_QC);
    const bf16_t* KC = (const bf16_t*)(r1 + R1_KC);
    const bf16_t* KCT = (const bf16_t*)(r1 + R1_KCT);
    const bf16_t* VCT = (const bf16_t*)(r1 + R1_VCT);
    bf16_t* GC = (bf16_t*)(r1 + R1_GC);
    for (int item = blockIdx.x; item < 64; item += gridDim.x) {
        const int b = item >> 3, h = item & 7;
        const float lg = LOGG[h];
        const float g64 = __expf(lg * 64.0f);
        const int al = 16 * w + fr;
        const float xi = __expf(lg * (float)(al + 1));
        f32x4 sacc[4][2];
#pragma unroll
        for (int md = 0; md < 4; ++md)
#pragma unroll
            for (int ne = 0; ne < 2; ++ne) sacc[md][ne] = (f32x4){0.f, 0.f, 0.f, 0.f};
        __syncthreads();
        for (int i = tid; i < 128 * LDT / 2; i += 256) ((unsigned*)sm.ST)[i] = 0u;
        for (int n = 0; n < 32; ++n) {
            const int tok0 = b * 2048 + n * 64;
            __syncthreads();
            stage_tile64(sm.Q, QC + (size_t)tok0 * 512 + h * 64, 512, tid);
            stage_tile64(sm.K, KC + (size_t)tok0 * 512 + h * 64, 512, tid);
#pragma unroll
            for (int i = 0; i < 2; ++i) {
                const int c = tid + 256 * i, row = c >> 3, col8 = (c & 7) * 8;
                u32x4 u = *(const u32x4*)(KCT + ((size_t)(b * 8 + h) * 64 + row) * 2048 + n * 64 + col8);
                unsigned uu[4] = {u.x, u.y, u.z, u.w};
#pragma unroll
                for (int q = 0; q < 4; ++q) {
                    const float z0 = __expf(lg * (float)(63 - (col8 + 2 * q))), z1 = __expf(lg * (float)(63 - (col8 + 2 * q + 1)));
                    uu[q] = pack2(__uint_as_float(uu[q] << 16) * z0, __uint_as_float(uu[q] & 0xffff0000u) * z1);
                }
                *(u32x4*)(sm.KT + row * LDT + col8) = (u32x4){uu[0], uu[1], uu[2], uu[3]};
            }
#pragma unroll
            for (int i = 0; i < 4; ++i) {
                const int c = tid + 256 * i, row = c >> 3, col8 = (c & 7) * 8;
                *(u32x4*)(sm.VT + row * LDT + col8) = *(const u32x4*)(VCT + ((size_t)(b * 8 + h) * 128 + row) * 2048 + n * 64 + col8);
            }
            __syncthreads();
            bf16x8 qf[2];
#pragma unroll
            for (int ks = 0; ks < 2; ++ks) qf[ks] = *(const bf16x8*)(sm.Q + (16 * w + fr) * LDT + ks * 32 + fq * 8);
            f32x4 st[4];
#pragma unroll
            for (int mc = 0; mc < 4; ++mc) {
                st[mc] = (f32x4){0.f, 0.f, 0.f, 0.f};
#pragma unroll
                for (int ks = 0; ks < 2; ++ks) {
                    bf16x8 kf = *(const bf16x8*)(sm.K + (mc * 16 + fr) * LDT + ks * 32 + fq * 8);
                    st[mc] = __builtin_amdgcn_mfma_f32_16x16x32_bf16(kf, qf[ks], st[mc], 0, 0, 0);
                }
#pragma unroll
                for (int r = 0; r < 4; ++r) {
                    const int cc = 16 * mc + 4 * fq + r;
                    st[mc][r] *= __expf(lg * fabsf((float)(al - cc)));
                }
            }
            f32x4 o[8];
#pragma unroll
            for (int me = 0; me < 8; ++me) {
                o[me] = (f32x4){0.f, 0.f, 0.f, 0.f};
#pragma unroll
                for (int ks = 0; ks < 2; ++ks) {
                    bf16x8 sf = *(const bf16x8*)(sm.ST + (me * 16 + fr) * LDT + ks * 32 + fq * 8);
                    o[me] = __builtin_amdgcn_mfma_f32_16x16x32_bf16(sf, qf[ks], o[me], 0, 0, 0);
                }
                o[me] *= xi;
            }
#pragma unroll
            for (int ks = 0; ks < 2; ++ks) {
                bf16x8 pf;
                {
                    u32x4 uu = (u32x4){pack2(st[2 * ks][0], st[2 * ks][1]), pack2(st[2 * ks][2], st[2 * ks][3]),
                                          pack2(st[2 * ks + 1][0], st[2 * ks + 1][1]), pack2(st[2 * ks + 1][2], st[2 * ks + 1][3])};
                    pf = *(bf16x8*)&uu;
                }
#pragma unroll
                for (int me = 0; me < 8; ++me) {
                    const bf16_t* vp = sm.VT + (me * 16 + fr) * LDT + ks * 32 + 4 * fq;
                    u32x2 lo = *(const u32x2*)vp, hi = *(const u32x2*)(vp + 16);
                    u32x4 vv = (u32x4){lo.x, lo.y, hi.x, hi.y};
                    o[me] = __builtin_amdgcn_mfma_f32_16x16x32_bf16(*(bf16x8*)&vv, pf, o[me], 0, 0, 0);
                }
            }
            {
                float s1 = 0.f;
#pragma unroll
                for (int me = 0; me < 8; ++me) s1 += (o[me][0] + o[me][1]) + (o[me][2] + o[me][3]);
                s1 += __shfl_xor(s1, 16); s1 += __shfl_xor(s1, 32);
                const float mu = s1 * (1.0f / 128.0f);
                float s2 = 0.f;
#pragma unroll
                for (int me = 0; me < 8; ++me)
#pragma unroll
                    for (int r = 0; r < 4; ++r) { const float d = o[me][r] - mu; s2 += d * d; }
                s2 += __shfl_xor(s2, 16); s2 += __shfl_xor(s2, 32);
                const float rstd = rsqrtf(s2 * (1.0f / 128.0f) + EPS_);
                bf16_t* gp = GC + (size_t)(tok0 + al) * 1024 + h * 128;
                const float* gr = p.g_ret + (size_t)l * 1024 + h * 128;
#pragma unroll
                for (int me = 0; me < 8; ++me) {
                    const int e0 = me * 16 + 4 * fq;
                    u32x2 gu = *(const u32x2*)(gp + e0);
                    f32x4 g4 = *(const f32x4*)(gr + e0);
                    const float y0 = (o[me][0] - mu) * rstd * g4[0] * __uint_as_float(gu.x << 16);
                    const float y1 = (o[me][1] - mu) * rstd * g4[1] * __uint_as_float(gu.x & 0xffff0000u);
                    const float y2 = (o[me][2] - mu) * rstd * g4[2] * __uint_as_float(gu.y << 16);
                    const float y3 = (o[me][3] - mu) * rstd * g4[3] * __uint_as_float(gu.y & 0xffff0000u);
                    u32x2 ou; ou.x = pack2(y0, y1); ou.y = pack2(y2, y3);
                    *(u32x2*)(gp + e0) = ou;
                }
            }
            __syncthreads();
#pragma unroll
            for (int md = 0; md < 4; ++md)
#pragma unroll
                for (int ne = 0; ne < 2; ++ne) sacc[md][ne] *= g64;
#pragma unroll
            for (int ks = 0; ks < 2; ++ks) {
                bf16x8 vf[2];
#pragma unroll
                for (int ne = 0; ne < 2; ++ne) vf[ne] = *(const bf16x8*)(sm.VT + (32 * w + ne * 16 + fr) * LDT + ks * 32 + fq * 8);
#pragma unroll
                for (int md = 0; md < 4; ++md) {
                    bf16x8 kf = *(const bf16x8*)(sm.KT + (md * 16 + fr) * LDT + ks * 32 + fq * 8);
#pragma unroll
                    for (int ne = 0; ne < 2; ++ne) sacc[md][ne] = __builtin_amdgcn_mfma_f32_16x16x32_bf16(kf, vf[ne], sacc[md][ne], 0, 0, 0);
                }
            }
#pragma unroll
            for (int md = 0; md < 4; ++md)
#pragma unroll
                for (int ne = 0; ne < 2; ++ne) {
                    u32x2 u; u.x = pack2(sacc[md][ne][0], sacc[md][ne][1]); u.y = pack2(sacc[md][ne][2], sacc[md][ne][3]);
                    *(u32x2*)(sm.ST + (32 * w + ne * 16 + fr) * LDT + md * 16 + 4 * fq) = u;
                }
        }
    }
}

__global__ void __launch_bounds__(256) k_mix_a1(Params p) {
    __shared__ float tau_s[16];
    __shared__ int stau_s[16];
    const int tid = threadIdx.x, lane = tid & 63, w = tid >> 6, fr = lane & 15, fq = lane >> 4;
    unsigned char* r1 = p.ws + OFF_R1;
    const bf16_t* IQ = (const bf16_t*)(r1 + R1_IQ);
    const bf16_t* IK = (const bf16_t*)(r1 + R1_IK);
    const float* IW = (const float*)(p.ws + OFF_IW);
    float* SC = (float*)(p.ws + OFF_R3);
    unsigned long long* MASKB = (unsigned long long*)(p.ws + OFF_MASKB);
    for (int item = blockIdx.x; item < 1024; item += gridDim.x) {
        const int c = 31 - (item >> 5), b = (item >> 2) & 7, qq = item & 3;
        const int nj = c + 1, n = 64 * nj;
        const int tq = b * 2048 + c * 64 + 16 * qq + fr;
        float* scrow = SC + (size_t)b * SC_PER_BATCH + (size_t)2048 * c * (c + 1) + (size_t)(16 * qq + fr) * n;
        bf16x8 iqf[4][2];
        float iw[4];
#pragma unroll
        for (int hh = 0; hh < 4; ++hh) {
            iw[hh] = IW[(size_t)tq * 4 + hh];
#pragma unroll
            for (int ks = 0; ks < 2; ++ks) iqf[hh][ks] = *(const bf16x8*)(IQ + (size_t)tq * 256 + hh * 64 + ks * 32 + fq * 8);
        }
        for (int kt = w; kt < nj; kt += 4) {
            bf16x8 ikf[4][2];
#pragma unroll
            for (int mk = 0; mk < 4; ++mk)
#pragma unroll
                for (int ks = 0; ks < 2; ++ks) ikf[mk][ks] = *(const bf16x8*)(IK + (size_t)(b * 2048 + kt * 64 + mk * 16 + fr) * 64 + ks * 32 + fq * 8);
            f32x4 sc[4];
#pragma unroll
            for (int mk = 0; mk < 4; ++mk) sc[mk] = (f32x4){0.f, 0.f, 0.f, 0.f};
#pragma unroll
            for (int hh = 0; hh < 4; ++hh) {
#pragma unroll
                for (int mk = 0; mk < 4; ++mk) {
                    f32x4 a = (f32x4){0.f, 0.f, 0.f, 0.f};
#pragma unroll
                    for (int ks = 0; ks < 2; ++ks) a = __builtin_amdgcn_mfma_f32_16x16x32_bf16(ikf[mk][ks], iqf[hh][ks], a, 0, 0, 0);
#pragma unroll
                    for (int r = 0; r < 4; ++r) sc[mk][r] = __fmaf_rn(iw[hh], fmaxf(a[r], 0.f), sc[mk][r]);
                }
            }
#pragma unroll
            for (int mk = 0; mk < 4; ++mk) *(f32x4*)(scrow + kt * 64 + 16 * mk + 4 * fq) = sc[mk];
        }
        __syncthreads();
        for (int i = 0; i < 4; ++i) {
            const int r16 = 4 * w + i;
            float tau = -__builtin_inff();
            int stau = 1 << 30;
            if (nj > 4) {
                const float* rowp = SC + (size_t)b * SC_PER_BATCH + (size_t)2048 * c * (c + 1) + (size_t)(16 * qq + r16) * n;
                unsigned key[32];
#pragma unroll
                for (int j = 0; j < 32; ++j) {
                    if (j < nj) {
                        const unsigned u = __float_as_uint(rowp[j * 64 + lane]);
                        key[j] = (u & 0x80000000u) ? ~u : (u | 0x80000000u);
                    } else key[j] = 0u;
                }
                unsigned X = 0u;
                for (int bit = 31; bit >= 0; --bit) {
                    const unsigned cand = X | (1u << bit);
                    int cnt = 0;
#pragma unroll
                    for (int j = 0; j < 32; ++j) cnt += (key[j] >= cand) ? 1 : 0;
                    cnt = wave_sum_i(cnt);
                    if (cnt >= 256) X = cand;
                }
                int cgt = 0;
#pragma unroll
                for (int j = 0; j < 32; ++j) cgt += (key[j] > X) ? 1 : 0;
                cgt = wave_sum_i(cgt);
                const int need = 256 - cgt;
                int seen = 0; stau = -1;
#pragma unroll
                for (int j = 0; j < 32; ++j) {
                    unsigned long long mk = __ballot(key[j] == X);
                    const int cj = __popcll(mk);
                    if (stau < 0 && seen + cj >= need) {
                        int kth = need - seen;
                        for (int q = 1; q < kth; ++q) mk &= mk - 1;
                        stau = j * 64 + (__ffsll((long long)mk) - 1);
                    }
                    seen += cj;
                }
                const unsigned ux = (X & 0x80000000u) ? (X & 0x7fffffffu) : ~X;
                tau = __uint_as_float(ux);
            }
            if (lane == 0) { tau_s[r16] = tau; stau_s[r16] = stau; }
        }
        __syncthreads();
        {
            const float tau = tau_s[fr];
            const int stau = stau_s[fr];
            for (int kt = w; kt < nj; kt += 4) {
                unsigned lo = 0u, hi = 0u;
#pragma unroll
                for (int mk = 0; mk < 4; ++mk) {
                    const f32x4 v = *(const f32x4*)(scrow + kt * 64 + 16 * mk + 4 * fq);
#pragma unroll
                    for (int r = 0; r < 4; ++r) {
                        const int kl = 16 * mk + 4 * fq + r;
                        const bool sel = (v[r] > tau) || (v[r] == tau && (kt * 64 + kl) <= stau);
                        if (sel) { if (mk < 2) lo |= 1u << kl; else hi |= 1u << (kl - 32); }
                    }
                }
                lo |= __shfl_xor(lo, 16); lo |= __shfl_xor(lo, 32);
                hi |= __shfl_xor(hi, 16); hi |= __shfl_xor(hi, 32);
                if (fq == 0) MASKB[(size_t)tq * 32 + kt] = ((unsigned long long)hi << 32) | lo;
            }
        }
        __syncthreads();
    }
}

__global__ void __launch_bounds__(256) k_mix_a2(Params p) {
    __shared__ AttnLds sm;
    const int tid = threadIdx.x, lane = tid & 63, w = tid >> 6, fr = lane & 15, fq = lane >> 4;
    unsigned char* r1 = p.ws + OFF_R1;
    bf16_t* QA = (bf16_t*)(r1 + R1_QA);
    const bf16_t* KA = (const bf16_t*)(r1 + R1_KA);
    const bf16_t* VAT = (const bf16_t*)(r1 + R1_VAT);
    const float* CKVSS = (const float*)(p.ws + OFF_CKVSS);
    const unsigned long long* MASKB = (const unsigned long long*)(p.ws + OFF_MASKB);
    for (int item = blockIdx.x; item < 2048; item += gridDim.x) {
        const int c = 31 - (item >> 6), b = (item >> 3) & 7, h = item & 7;
        const int tq = b * 2048 + c * 64 + 16 * w + fr;
        bf16x8 qf[2];
#pragma unroll
        for (int ks = 0; ks < 2; ++ks) qf[ks] = *(const bf16x8*)(QA + (size_t)tq * 512 + h * 64 + ks * 32 + fq * 8);
        f32x4 O[4];
#pragma unroll
        for (int me = 0; me < 4; ++me) O[me] = (f32x4){0.f, 0.f, 0.f, 0.f};
        float mrun = -1e30f, lrun = 0.f;
        for (int kt = 0; kt <= c; ++kt) {
            __syncthreads();
            stage_tile64(sm.K, KA + (size_t)(b * 2048 + kt * 64) * 64, 64, tid);
            stage_tile64(sm.Vt, VAT + ((size_t)b * 64) * 2048 + kt * 64, 2048, tid);
            if (tid < 64) {
                const f32x4 s4 = *(const f32x4*)(CKVSS + (size_t)(b * 2048 + kt * 64 + tid) * 4);
                sm.rs[tid] = rsqrtf(((s4[0] + s4[1]) + (s4[2] + s4[3])) * (1.0f / 256.0f) + EPS_);
            }
            __syncthreads();
            const unsigned long long W = MASKB[(size_t)tq * 32 + kt];
            f32x4 st[4];
            float mx = -1e30f;
            f32x4 rsv[4];
#pragma unroll
            for (int mk = 0; mk < 4; ++mk) {
                st[mk] = (f32x4){0.f, 0.f, 0.f, 0.f};
#pragma unroll
                for (int ks = 0; ks < 2; ++ks) {
                    bf16x8 kf = *(const bf16x8*)(sm.K + (mk * 16 + fr) * LDT + ks * 32 + fq * 8);
                    st[mk] = __builtin_amdgcn_mfma_f32_16x16x32_bf16(kf, qf[ks], st[mk], 0, 0, 0);
                }
                rsv[mk] = *(const f32x4*)(sm.rs + 16 * mk + 4 * fq);
                const unsigned nib = (unsigned)(W >> (16 * mk + 4 * fq)) & 0xfu;
#pragma unroll
                for (int r = 0; r < 4; ++r) {
                    st[mk][r] *= rsv[mk][r];
                    if ((nib >> r) & 1u) mx = fmaxf(mx, st[mk][r]);
                }
            }
            mx = fmaxf(mx, __shfl_xor(mx, 16)); mx = fmaxf(mx, __shfl_xor(mx, 32));
            const float mnew = fmaxf(mrun, mx);
            const float alpha = __expf(mrun - mnew);
            float ps = 0.f;
            float P[4][4];
#pragma unroll
            for (int mk = 0; mk < 4; ++mk) {
                const unsigned nib = (unsigned)(W >> (16 * mk + 4 * fq)) & 0xfu;
#pragma unroll
                for (int r = 0; r < 4; ++r) {
                    const float pv = ((nib >> r) & 1u) ? __expf(st[mk][r] - mnew) : 0.f;
                    ps += pv;
                    P[mk][r] = pv * rsv[mk][r];
                }
            }
            ps += __shfl_xor(ps, 16); ps += __shfl_xor(ps, 32);
            lrun = lrun * alpha + ps;
            mrun = mnew;
#pragma unroll
            for (int me = 0; me < 4; ++me) O[me] *= alpha;
#pragma unroll
            for (int ks = 0; ks < 2; ++ks) {
                u32x4 uu = (u32x4){pack2(P[2 * ks][0], P[2 * ks][1]), pack2(P[2 * ks][2], P[2 * ks][3]),
                                   pack2(P[2 * ks + 1][0], P[2 * ks + 1][1]), pack2(P[2 * ks + 1][2], P[2 * ks + 1][3])};
                bf16x8 pf = *(bf16x8*)&uu;
#pragma unroll
                for (int me = 0; me < 4; ++me) {
                    const bf16_t* vp = sm.Vt + (me * 16 + fr) * LDT + ks * 32 + 4 * fq;
                    u32x2 lo = *(const u32x2*)vp, hi = *(const u32x2*)(vp + 16);
                    u32x4 vv = (u32x4){lo.x, lo.y, hi.x, hi.y};
                    O[me] = __builtin_amdgcn_mfma_f32_16x16x32_bf16(*(bf16x8*)&vv, pf, O[me], 0, 0, 0);
                }
            }
        }
        const float inv = 1.0f / lrun;
#pragma unroll
        for (int me = 0; me < 4; ++me) {
            u32x2 u; u.x = pack2(O[me][0] * inv, O[me][1] * inv); u.y = pack2(O[me][2] * inv, O[me][3] * inv);
            *(u32x2*)(QA + (size_t)tq * 512 + h * 64 + me * 16 + 4 * fq) = u;
        }
    }
}

__global__ void __launch_bounds__(256) k_merge(Params p) {
    __shared__ GemmLds sm;
    const int tid = threadIdx.x, lane = tid & 63, wid = tid >> 6, wr = wid >> 1, wc = wid & 1, fr = lane & 15, fq = lane >> 4;
    unsigned char* r1 = p.ws + OFF_R1;
    const bf16_t* WB = (const bf16_t*)(p.ws + OFF_WB);
    const bf16_t* GATES = (const bf16_t*)(r1 + R1_GATES);
    bf16_t* MG = (bf16_t*)(p.ws + OFF_H);
    for (int tile = blockIdx.x; tile < 128 * 8; tile += gridDim.x) {
        const int mt = tile >> 3, nt = tile & 7, m0 = mt * 128, n0 = nt * 128;
        f32x4 macc[4][4];
        zero_acc(macc);
#pragma unroll 1
        for (int br = 0; br < 3; ++br) {
            const bf16_t* A = (const bf16_t*)(r1 + (br == 0 ? R1_QA : (br == 1 ? R1_QB : R1_GC)));
            const int K = (br == 2) ? 1024 : 512;
            const bf16_t* Bt = WB + (br == 0 ? WB_WOA : (br == 1 ? WB_WOB : WB_WOC));
            const bf16_t* ap[4]; const bf16_t* bp[4];
#pragma unroll
            for (int i = 0; i < 4; ++i) {
                ap[i] = A + (size_t)(m0 + (tid >> 3) + 32 * i) * K + (tid & 7) * 8;
                bp[i] = Bt + (size_t)(n0 + (tid >> 3) + 32 * i) * K + (tid & 7) * 8;
            }
            f32x4 acc[4][4];
            zero_acc(acc);
            gemm_kloop(acc, ap, bp, K, sm.A, sm.B, tid);
#pragma unroll
            for (int m = 0; m < 4; ++m)
#pragma unroll
                for (int j = 0; j < 4; ++j) {
                    const int t = m0 + wr * 64 + m * 16 + fq * 4 + j;
#pragma unroll
                    for (int n = 0; n < 4; ++n) {
                        const float g = bf2f(GATES[(size_t)t * 3072 + br * 1024 + n0 + wc * 64 + n * 16 + fr]);
                        macc[m][n][j] += g * acc[m][n][j];
                    }
                }
        }
#pragma unroll
        for (int m = 0; m < 4; ++m)
#pragma unroll
            for (int j = 0; j < 4; ++j) {
                const int t = m0 + wr * 64 + m * 16 + fq * 4 + j;
#pragma unroll
                for (int n = 0; n < 4; ++n) MG[(size_t)t * 1024 + n0 + wc * 64 + n * 16 + fr] = f2bf(macc[m][n][j]);
            }
    }
}

__global__ void __launch_bounds__(256, 2) k_outproj(Params p) {
    __shared__ GemmLds sm;
    const int tid = threadIdx.x, lane = tid & 63, wid = tid >> 6, wr = wid >> 1, wc = wid & 1, fr = lane & 15, fq = lane >> 4;
    const bf16_t* MG = (const bf16_t*)(p.ws + OFF_H);
    const bf16_t* Bt = (const bf16_t*)(p.ws + OFF_WB) + WB_WOUT;
    bf16_t* Y = (bf16_t*)(p.ws + OFF_R1 + R1_QC);
    for (int tile = blockIdx.x; tile < 128 * 8; tile += gridDim.x) {
        const int mt = tile >> 3, nt = tile & 7, m0 = mt * 128, n0 = nt * 128;
        const bf16_t* ap[4]; const bf16_t* bp[4];
#pragma unroll
        for (int i = 0; i < 4; ++i) {
            ap[i] = MG + (size_t)(m0 + (tid >> 3) + 32 * i) * 1024 + (tid & 7) * 8;
            bp[i] = Bt + (size_t)(n0 + (tid >> 3) + 32 * i) * 1024 + (tid & 7) * 8;
        }
        f32x4 acc[4][4];
        zero_acc(acc);
        gemm_kloop(acc, ap, bp, 1024, sm.A, sm.B, tid);
#pragma unroll
        for (int m = 0; m < 4; ++m)
#pragma unroll
            for (int j = 0; j < 4; ++j) {
                const int t = m0 + wr * 64 + m * 16 + fq * 4 + j;
#pragma unroll
                for (int n = 0; n < 4; ++n) Y[(size_t)t * 1024 + n0 + wc * 64 + n * 16 + fr] = f2bf(acc[m][n][j]);
            }
    }
}

__global__ void __launch_bounds__(256, 2) k_router(Params p, int l) {
    __shared__ GemmLds sm;
    const int tid = threadIdx.x, lane = tid & 63, wid = tid >> 6, wr = wid >> 1, wc = wid & 1, fr = lane & 15, fq = lane >> 4;
    const bf16_t* H = (const bf16_t*)(p.ws + OFF_H);
    const bf16_t* Bt = (const bf16_t*)(p.ws + OFF_WB) + WB_WR;
    int* cnt = (int*)(p.ws + OFF_CTL);
    int* LIST = (int*)(p.ws + OFF_LIST);
    float* AW = (float*)(p.ws + OFF_AW);
    const float* bias = p.router_bias + l * 64;
    float* lg = (float*)&sm;
    for (int mt = blockIdx.x; mt < 128; mt += gridDim.x) {
        const int m0 = mt * 128;
        const bf16_t* ap[4]; const bf16_t* bp[4];
#pragma unroll
        for (int i = 0; i < 4; ++i) {
            ap[i] = H + (size_t)(m0 + (tid >> 3) + 32 * i) * 1024 + (tid & 7) * 8;
            bp[i] = Bt + (size_t)((tid >> 3) + 32 * i) * 1024 + (tid & 7) * 8;
        }
        f32x4 acc[4][4];
        zero_acc(acc);
        gemm_kloop(acc, ap, bp, 1024, sm.A, sm.B, tid);
        __syncthreads();
        if (wc == 0) {
#pragma unroll
            for (int m = 0; m < 4; ++m)
#pragma unroll
                for (int j = 0; j < 4; ++j)
#pragma unroll
                    for (int n = 0; n < 4; ++n) lg[(wr * 64 + m * 16 + fq * 4 + j) * 65 + n * 16 + fr] = acc[m][n][j];
        }
        __syncthreads();
        if (tid < 128) {
            const float* row = lg + tid * 65;
            const int t = m0 + tid;
            float gs[8];
#pragma unroll
            for (int g = 0; g < 8; ++g) {
                float m1 = -__builtin_inff(), m2 = -__builtin_inff();
#pragma unroll
                for (int e = 0; e < 8; ++e) {
                    const float v = sigmoidf_(row[g * 8 + e]) + bias[g * 8 + e];
                    if (v > m1) { m2 = m1; m1 = v; } else if (v > m2) m2 = v;
                }
                gs[g] = m1 + m2;
            }
            unsigned gmask = 0u;
#pragma unroll
            for (int g = 0; g < 8; ++g) {
                int rank = 0;
#pragma unroll
                for (int g2 = 0; g2 < 8; ++g2) rank += (gs[g2] > gs[g] || (gs[g2] == gs[g] && g2 < g)) ? 1 : 0;
                if (rank < 4) gmask |= 1u << g;
            }
            unsigned long long taken = 0ull;
            int eidx[8]; float esc[8];
            float ssum = 0.f;
#pragma unroll
            for (int k = 0; k < 8; ++k) {
                float best = -__builtin_inff(); int bi = 0;
                for (int e = 0; e < 64; ++e) {
                    if (!((gmask >> (e >> 3)) & 1u) || ((taken >> e) & 1ull)) continue;
                    const float v = sigmoidf_(row[e]) + bias[e];
                    if (v > best) { best = v; bi = e; }
                }
                taken |= 1ull << bi;
                eidx[k] = bi;
                esc[k] = sigmoidf_(row[bi]);
                ssum += esc[k];
            }
            const float scale = 2.5f / ssum;
#pragma unroll
            for (int k = 0; k < 8; ++k) {
                const int e = eidx[k];
                const int slot = atomicAdd(&cnt[e], 1);
                LIST[(size_t)e * T_ + slot] = t * 8 + k;
                AW[(size_t)t * 8 + k] = esc[k] * scale;
            }
        }
        __syncthreads();
    }
}

struct __attribute__((aligned(16))) MoeLds { GemmLds g; int tstart[66]; int hbase[66]; int rowid[128]; };
__device__ __forceinline__ void moe_setup(MoeLds& sm, const int* cnt, int tid) {
    if (tid == 0) {
        int ts = 0, hb = 0;
        for (int e = 0; e < 65; ++e) {
            const int ce = (e < 64) ? cnt[e] : T_;
            sm.tstart[e] = ts; sm.hbase[e] = hb;
            ts += (ce + 127) >> 7; hb += ce;
        }
        sm.tstart[65] = ts; sm.hbase[65] = hb;
    }
    __syncthreads();
}

__global__ void __launch_bounds__(256, 2) k_moe1(Params p) {
    __shared__ MoeLds sm;
    const int tid = threadIdx.x, lane = tid & 63, wid = tid >> 6, wr = wid >> 1, wc = wid & 1, fr = lane & 15, fq = lane >> 4;
    const bf16_t* H = (const bf16_t*)(p.ws + OFF_H);
    const bf16_t* W13 = (const bf16_t*)(p.ws + OFF_WB) + WB_W13;
    const int* cnt = (const int*)(p.ws + OFF_CTL);
    const int* LIST = (const int*)(p.ws + OFF_LIST);
    bf16_t* HID = (bf16_t*)(p.ws + OFF_R3);
    moe_setup(sm, cnt, tid);
    const int nitems = sm.tstart[65] * 4;
    for (int item = blockIdx.x; item < nitems; item += gridDim.x) {
        const int rt = item >> 2, nt = item & 3;
        int e = 0;
        while (sm.tstart[e + 1] <= rt) ++e;
        const int mtl = rt - sm.tstart[e];
        const int ce = (e < 64) ? cnt[e] : T_;
        __syncthreads();
        if (tid < 128) {
            const int slot = mtl * 128 + tid;
            int tok = 0;
            if (slot < ce) tok = (e < 64) ? (LIST[(size_t)e * T_ + slot] >> 3) : slot;
            sm.rowid[tid] = tok;
        }
        __syncthreads();
        const bf16_t* ap[4]; const bf16_t* bp[4];
#pragma unroll
        for (int i = 0; i < 4; ++i) {
            ap[i] = H + (size_t)sm.rowid[(tid >> 3) + 32 * i] * 1024 + (tid & 7) * 8;
            bp[i] = W13 + ((size_t)e * 512 + nt * 128 + (tid >> 3) + 32 * i) * 1024 + (tid & 7) * 8;
        }
        f32x4 acc[4][4];
        zero_acc(acc);
        gemm_kloop(acc, ap, bp, 1024, sm.g.A, sm.g.B, tid);
        const int hb = sm.hbase[e] + mtl * 128;
#pragma unroll
        for (int m = 0; m < 4; ++m)
#pragma unroll
            for (int j = 0; j < 4; ++j) {
                const int r = wr * 64 + m * 16 + fq * 4 + j;
                if (mtl * 128 + r < ce) {
#pragma unroll
                    for (int nn = 0; nn < 2; ++nn) {
                        const float a1 = acc[m][nn][j], a3 = acc[m][nn + 2][j];
                        HID[(size_t)(hb + r) * 256 + (nt * 2 + wc) * 32 + nn * 16 + fr] = f2bf(siluf_(a1) * a3);
                    }
                }
            }
    }
}

__global__ void __launch_bounds__(256, 2) k_moe2(Params p) {
    __shared__ MoeLds sm;
    const int tid = threadIdx.x, lane = tid & 63, wid = tid >> 6, wr = wid >> 1, wc = wid & 1, fr = lane & 15, fq = lane >> 4;
    const bf16_t* W2 = (const bf16_t*)(p.ws + OFF_WB) + WB_W2;
    const int* cnt = (const int*)(p.ws + OFF_CTL);
    const int* LIST = (const int*)(p.ws + OFF_LIST);
    const float* AW = (const float*)(p.ws + OFF_AW);
    const bf16_t* HID = (const bf16_t*)(p.ws + OFF_R3);
    bf16_t* SLOTS = (bf16_t*)(p.ws + OFF_R1);
    moe_setup(sm, cnt, tid);
    const int nitems = sm.tstart[65] * 8;
    for (int item = blockIdx.x; item < nitems; item += gridDim.x) {
        const int rt = item >> 3, nt = item & 7;
        int e = 0;
        while (sm.tstart[e + 1] <= rt) ++e;
        const int mtl = rt - sm.tstart[e];
        const int ce = (e < 64) ? cnt[e] : T_;
        __syncthreads();
        if (tid < 128) {
            const int slot = mtl * 128 + tid;
            int aid = -1;
            if (slot < ce) aid = (e < 64) ? LIST[(size_t)e * T_ + slot] : (8 * T_ + slot);
            sm.rowid[tid] = aid;
        }
        __syncthreads();
        const int hb = sm.hbase[e] + mtl * 128;
        const bf16_t* ap[4]; const bf16_t* bp[4];
#pragma unroll
        for (int i = 0; i < 4; ++i) {
            ap[i] = HID + (size_t)(hb + (tid >> 3) + 32 * i) * 256 + (tid & 7) * 8;
            bp[i] = W2 + ((size_t)e * 1024 + nt * 128 + (tid >> 3) + 32 * i) * 256 + (tid & 7) * 8;
        }
        f32x4 acc[4][4];
        zero_acc(acc);
        gemm_kloop(acc, ap, bp, 256, sm.g.A, sm.g.B, tid);
#pragma unroll
        for (int m = 0; m < 4; ++m)
#pragma unroll
            for (int j = 0; j < 4; ++j) {
                const int r = wr * 64 + m * 16 + fq * 4 + j;
                const int aid = sm.rowid[r];
                if (aid >= 0) {
                    const float wt = (e < 64) ? AW[aid] : 1.0f;
#pragma unroll
                    for (int n = 0; n < 4; ++n) SLOTS[(size_t)aid * 1024 + nt * 128 + wc * 64 + n * 16 + fr] = f2bf(acc[m][n][j] * wt);
                }
            }
    }
}

static void launch_tconv(hipStream_t st, const float* src, bf16_t* dst, int K, int NQ, int src_ld, int dst_ld, int mode, int p0, int nbatch, size_t src_bs, size_t dst_bs) {
    TJob j;
    j.src = src; j.dst = dst; j.K = K; j.NQ = NQ; j.src_ld = src_ld; j.dst_ld = dst_ld; j.mode = mode; j.p0 = p0; j.nbatch = nbatch; j.pad = 0;
    j.src_bs = src_bs; j.dst_bs = dst_bs;
    int total = (NQ / 64) * (K / 64) * nbatch;
    int grid = total < 4096 ? total : 4096;
    hipLaunchKernelGGL(k_tconv, dim3(grid), dim3(256), 0, st, j);
}

extern "C" void kernel_launch(void* const* d_in, const int* in_sizes, int n_in, void* d_out, int out_size, void* d_ws, size_t ws_size, hipStream_t stream) {
    if (n_in < 26 || ws_size < WS_TOTAL) { fprintf(stderr, "kernel_launch: bad inputs / workspace too small (%zu < %zu)\n", ws_size, (size_t)WS_TOTAL); return; }
    Params p;
    memset(&p, 0, sizeof(p));
    p.x = (const float*)d_in[0]; p.c = (const float*)d_in[1]; p.positions = (const int*)d_in[2]; p.ada_w = (const float*)d_in[3]; p.ada_b = (const float*)d_in[4];
    p.g_pre_mix = (const float*)d_in[5]; p.g_post_mix = (const float*)d_in[6]; p.g_pre_ffn = (const float*)d_in[7]; p.g_post_ffn = (const float*)d_in[8];
    p.w_in = (const float*)d_in[9]; p.g_kv = (const float*)d_in[10]; p.w_uk = (const float*)d_in[11]; p.w_uv = (const float*)d_in[12]; p.g_ret = (const float*)d_in[13];
    p.w_o_a = (const float*)d_in[14]; p.w_o_b = (const float*)d_in[15]; p.w_o_c = (const float*)d_in[16]; p.w_out = (const float*)d_in[17];
    p.w_router = (const float*)d_in[18]; p.router_bias = (const float*)d_in[19]; p.w1 = (const float*)d_in[20]; p.w3 = (const float*)d_in[21]; p.w2 = (const float*)d_in[22];
    p.ws1 = (const float*)d_in[23]; p.ws3 = (const float*)d_in[24]; p.ws2 = (const float*)d_in[25];
    p.out = (float*)d_out; p.ws = (unsigned char*)d_ws;
    unsigned char* ws = p.ws;
    bf16_t* WB = (bf16_t*)(ws + OFF_WB);
    const float* mod = (const float*)(ws + OFF_MOD);

    hipLaunchKernelGGL(k_rope, dim3(T_ * 32 / 256), dim3(256), 0, stream, p);
    hipLaunchKernelGGL(k_mod, dim3(192), dim3(256), 0, stream, p);
    for (int l = 0; l < DEPTH_; ++l) {
        launch_tconv(stream, p.w_in + (size_t)l * 1024 * NIN_, WB + WB_WIN, 1024, 8832, NIN_, 1024, 1, 0, 1, 0, 0);
        hipLaunchKernelGGL(k_wcomp, dim3(512), dim3(256), 0, stream, p, l);
        launch_tconv(stream, p.w_o_a + (size_t)l * 512 * 1024, WB + WB_WOA, 512, 1024, 1024, 512, 0, 0, 1, 0, 0);
        launch_tconv(stream, p.w_o_b + (size_t)l * 512 * 1024, WB + WB_WOB, 512, 1024, 1024, 512, 0, 0, 1, 0, 0);
        launch_tconv(stream, p.w_o_c + (size_t)l * 1024 * 1024, WB + WB_WOC, 1024, 1024, 1024, 1024, 0, 0, 1, 0, 0);
        launch_tconv(stream, p.w_out + (size_t)l * 1024 * 1024, WB + WB_WOUT, 1024, 1024, 1024, 1024, 0, 0, 1, 0, 0);
        launch_tconv(stream, p.w_router + (size_t)l * 1024 * 64, WB + WB_WR, 1024, 128, 64, 1024, 3, 0, 1, 0, 0);
        launch_tconv(stream, p.w1 + (size_t)l * 64 * 1024 * 256, WB + WB_W13, 1024, 256, 256, 1024, 2, 0, 64, (size_t)1024 * 256, (size_t)512 * 1024);
        launch_tconv(stream, p.w3 + (size_t)l * 64 * 1024 * 256, WB + WB_W13, 1024, 256, 256, 1024, 2, 32, 64, (size_t)1024 * 256, (size_t)512 * 1024);
        launch_tconv(stream, p.ws1 + (size_t)l * 1024 * 256, WB + WB_W13 + (size_t)64 * 512 * 1024, 1024, 256, 256, 1024, 2, 0, 1, 0, 0);
        launch_tconv(stream, p.ws3 + (size_t)l * 1024 * 256, WB + WB_W13 + (size_t)64 * 512 * 1024, 1024, 256, 256, 1024, 2, 32, 1, 0, 0);
        launch_tconv(stream, p.w2 + (size_t)l * 64 * 256 * 1024, WB + WB_W2, 256, 1024, 1024, 256, 0, 0, 64, (size_t)256 * 1024, (size_t)1024 * 256);
        launch_tconv(stream, p.ws2 + (size_t)l * 256 * 1024, WB + WB_W2 + (size_t)64 * 1024 * 256, 256, 1024, 1024, 256, 0, 0, 1, 0, 0);
        if (l == 0) {
            NormArgs a; memset(&a, 0, sizeof(a));
            a.xin = p.x; a.mode = 0; a.gpre = p.g_pre_mix; a.sc = mod + 1024; a.sh = mod + 0;
            hipLaunchKernelGGL(k_norm, dim3(T_ / 4), dim3(256), 0, stream, p, a);
        }
        hipLaunchKernelGGL(k_gemm_z, dim3(128 * 70), dim3(256), 0, stream, p);
        hipLaunchKernelGGL(k_mix_a1, dim3(1024), dim3(256), 0, stream, p);
        hipLaunchKernelGGL(k_mix_c, dim3(64), dim3(256), 0, stream, p, l);
        hipLaunchKernelGGL(k_mix_b, dim3(2048), dim3(256), 0, stream, p);
        hipLaunchKernelGGL(k_mix_a2, dim3(2048), dim3(256), 0, stream, p);
        hipLaunchKernelGGL(k_merge, dim3(1024), dim3(256), 0, stream, p);
        hipLaunchKernelGGL(k_outproj, dim3(1024), dim3(256), 0, stream, p);
        {
            NormArgs a; memset(&a, 0, sizeof(a));
            a.mode = 1; a.Y = (const bf16_t*)(ws + OFF_R1 + R1_QC);
            a.gpost = p.g_post_mix + l * 1024; a.gt = mod + (size_t)l * 8 * 6144 + 2048;
            a.gpre = p.g_pre_ffn + l * 1024; a.sc = mod + (size_t)l * 8 * 6144 + 4096; a.sh = mod + (size_t)l * 8 * 6144 + 3072;
            hipLaunchKernelGGL(k_norm, dim3(T_ / 4), dim3(256), 0, stream, p, a);
        }
        (void)hipMemsetAsync(ws + OFF_CTL, 0, 1024, stream);
        hipLaunchKernelGGL(k_router, dim3(128), dim3(256), 0, stream, p, l);
        hipLaunchKernelGGL(k_moe1, dim3(2048), dim3(256), 0, stream, p);
        hipLaunchKernelGGL(k_moe2, dim3(2048), dim3(256), 0, stream, p);
        {
            NormArgs a; memset(&a, 0, sizeof(a));
            a.mode = 2; a.slots = (const bf16_t*)(ws + OFF_R1);
            a.gpost = p.g_post_ffn + l * 1024; a.gt = mod + (size_t)l * 8 * 6144 + 5120;
            if (l + 1 < DEPTH_) { a.gpre = p.g_pre_mix + (l + 1) * 1024; a.sc = mod + (size_t)(l + 1) * 8 * 6144 + 1024; a.sh = mod + (size_t)(l + 1) * 8 * 6144 + 0; }
            hipLaunchKernelGGL(k_norm, dim3(T_ / 4), dim3(256), 0, stream, p, a);
        }
    }
}
```

```cpp
#include <hip/hip_runtime.h>
#include <hip/hip_cooperative_groups.h>
namespace cg = cooperative_groups;
#include <stdint.h>
#include <stdio.h>
#include <string.h>

typedef unsigned short bf16_t;
typedef short bf16x8 __attribute__((ext_vector_type(8)));
typedef short bf16x4 __attribute__((ext_vector_type(4)));
typedef float f32x4 __attribute__((ext_vector_type(4)));
typedef float f32x2 __attribute__((ext_vector_type(2)));
typedef unsigned u32x4 __attribute__((ext_vector_type(4)));
typedef unsigned u32x2 __attribute__((ext_vector_type(2)));

constexpr int T_ = 16384, S_ = 2048, NB_ = 8, D_ = 1024, DEPTH_ = 2;
constexpr int NIN_ = 8772;
constexpr int NZ_ = 8960;
constexpr float EPS_ = 1e-6f;

constexpr int C_QA = 0, C_CKV = 512, C_IQ = 768, C_IK = 1024, C_IW = 1088, C_QB = 1152, C_KB = 1664, C_VB = 2176,
              C_QC = 2688, C_KC = 3200, C_VC = 3712, C_GC = 4736, C_GATES = 5760, C_KA = 8832, C_VA = 8896;

constexpr size_t KiB = 1024, MiB = 1024 * 1024;
constexpr size_t OFF_CTL = 0;
constexpr size_t OFF_MOD = 64 * KiB;
constexpr size_t OFF_IW = 512 * KiB;
constexpr size_t OFF_CKVSS = 768 * KiB;
constexpr size_t OFF_AW = 1 * MiB;
constexpr size_t OFF_ROPE = 2 * MiB;
constexpr size_t OFF_LIST = 6 * MiB;
constexpr size_t OFF_MASKB = 10 * MiB;
constexpr size_t OFF_WB = 14 * MiB;
constexpr size_t WB_WIN = 0;
constexpr size_t WB_WOA = WB_WIN + (size_t)NZ_ * 1024;
constexpr size_t WB_WOB = WB_WOA + 1024 * 512;
constexpr size_t WB_WOC = WB_WOB + 1024 * 512;
constexpr size_t WB_WOUT = WB_WOC + 1024 * 1024;
constexpr size_t WB_WR = WB_WOUT + 1024 * 1024;
constexpr size_t WB_W13 = WB_WR + 128 * 1024;
constexpr size_t WB_W2 = WB_W13 + (size_t)65 * 512 * 1024;
constexpr size_t WB_END = WB_W2 + (size_t)65 * 1024 * 256;
constexpr size_t OFF_H = OFF_WB + ((WB_END * 2 + MiB - 1) / MiB) * MiB;
constexpr size_t OFF_R1 = OFF_H + 32 * MiB;
constexpr size_t R1_QA = 0;
constexpr size_t R1_IQ = R1_QA + 16 * MiB;
constexpr size_t R1_IK = R1_IQ + 8 * MiB;
constexpr size_t R1_KA = R1_IK + 2 * MiB;
constexpr size_t R1_VAT = R1_KA + 2 * MiB;
constexpr size_t R1_QB = R1_VAT + 2 * MiB;
constexpr size_t R1_KB = R1_QB + 16 * MiB;
constexpr size_t R1_VBT = R1_KB + 16 * MiB;
constexpr size_t R1_QC = R1_VBT + 16 * MiB;
constexpr size_t R1_KC = R1_QC + 16 * MiB;
constexpr size_t R1_KCT = R1_KC + 16 * MiB;
constexpr size_t R1_VCT = R1_KCT + 16 * MiB;
constexpr size_t R1_GC = R1_VCT + 32 * MiB;
constexpr size_t R1_GATES = R1_GC + 32 * MiB;
constexpr size_t R1_ZEND = R1_GATES + 96 * MiB;
constexpr size_t R1_SIZE = 288 * MiB;
constexpr size_t OFF_R3 = OFF_R1 + R1_SIZE;
constexpr size_t R3_SIZE = 78 * MiB;
constexpr size_t WS_TOTAL = OFF_R3 + R3_SIZE;
static_assert(R1_ZEND <= R1_SIZE, "r1");
constexpr size_t SC_PER_BATCH = 2162688;

__constant__ float INVF[32] = {
    1.000000000e+00f, 7.498942614e-01f, 5.623413324e-01f, 4.216965139e-01f, 3.162277639e-01f, 2.371373773e-01f, 1.778279394e-01f, 1.333521307e-01f,
    1.000000015e-01f, 7.498941571e-02f, 5.623413250e-02f, 4.216965288e-02f, 3.162277490e-02f, 2.371373773e-02f, 1.778279431e-02f, 1.333521493e-02f,
    9.999999776e-03f, 7.498941850e-03f, 5.623413250e-03f, 4.216964822e-03f, 3.162277630e-03f, 2.371373586e-03f, 1.778279431e-03f, 1.333521446e-03f,
    1.000000047e-03f, 7.498942432e-04f, 5.623413017e-04f, 4.216965172e-04f, 3.162277571e-04f, 2.371373703e-04f, 1.778279402e-04f, 1.333521504e-04f};

__constant__ float LOGG[8] = {-0.0317486983145803f, -0.015748356968139168f, -0.007843177461025893f, -0.003913899321136329f,
                               -0.0019550348358033506f, -0.0009770396478266127f, -0.0004884004981088745f, -0.0002441704321739145f};

__device__ __forceinline__ float bf2f(bf16_t u) { return __uint_as_float(((unsigned)u) << 16); }
__device__ __forceinline__ bf16_t f2bf(float f) {
    unsigned u = __float_as_uint(f);
    u += 0x7fffu + ((u >> 16) & 1u);
    return (bf16_t)(u >> 16);
}
__device__ __forceinline__ unsigned pack2(float a, float b) { return (unsigned)f2bf(a) | ((unsigned)f2bf(b) << 16); }
__device__ __forceinline__ float sigmoidf_(float x) { return __builtin_amdgcn_rcpf(1.0f + __expf(-x)); }
__device__ __forceinline__ float siluf_(float x) { return x * __builtin_amdgcn_rcpf(1.0f + __expf(-x)); }
__device__ __forceinline__ float wave_sum(float v) {
#pragma unroll
    for (int o = 32; o >= 1; o >>= 1) v += __shfl_xor(v, o);
    return v;
}
__device__ __forceinline__ int wave_sum_i(int v) {
#pragma unroll
    for (int o = 32; o >= 1; o >>= 1) v += __shfl_xor(v, o);
    return v;
}

struct Params {
    const float* x; const float* c; const int* positions; const float* ada_w; const float* ada_b;
    const float* g_pre_mix; const float* g_post_mix; const float* g_pre_ffn; const float* g_post_ffn;
    const float* w_in; const float* g_kv; const float* w_uk; const float* w_uv; const float* g_ret;
    const float* w_o_a; const float* w_o_b; const float* w_o_c; const float* w_out;
    const float* w_router; const float* router_bias; const float* w1; const float* w3; const float* w2;
    const float* ws1; const float* ws3; const float* ws2;
    float* out;
    unsigned char* ws;
};

__device__ __forceinline__ int cnt_ge(int cnt, unsigned key, unsigned cand) {
    asm volatile("v_cmp_ge_u32 vcc, %1, %2\n\tv_addc_co_u32 %0, vcc, 0, %0, vcc" : "+v"(cnt) : "v"(key), "v"(cand) : "vcc");
    return cnt;
}
__device__ __forceinline__ int cnt_ge_s(int cnt, unsigned key, unsigned cand) {
    asm volatile("v_cmp_ge_u32 vcc, %1, %2\n\ts_bcnt1_i32_b64 vcc_lo, vcc\n\ts_add_i32 %0, %0, vcc_lo" : "+s"(cnt) : "v"(key), "v"(cand) : "vcc", "scc");
    return cnt;
}
__device__ __forceinline__ int wave_total6(int c) {
    int t = 0;
#pragma unroll
    for (int b = 0; b < 6; ++b) t += __builtin_popcountll(__ballot((c >> b) & 1)) << b;
    return t;
}
__device__ __forceinline__ float xrow16_max(float x) {
    auto s = __builtin_amdgcn_permlane16_swap(__float_as_uint(x), __float_as_uint(x), false, false);
    x = fmaxf(__uint_as_float(s[0]), __uint_as_float(s[1]));
    auto t = __builtin_amdgcn_permlane32_swap(__float_as_uint(x), __float_as_uint(x), false, false);
    return fmaxf(__uint_as_float(t[0]), __uint_as_float(t[1]));
}
__device__ __forceinline__ float xrow16_sum(float x) {
    auto s = __builtin_amdgcn_permlane16_swap(__float_as_uint(x), __float_as_uint(x), false, false);
    x = __uint_as_float(s[0]) + __uint_as_float(s[1]);
    auto t = __builtin_amdgcn_permlane32_swap(__float_as_uint(x), __float_as_uint(x), false, false);
    return __uint_as_float(t[0]) + __uint_as_float(t[1]);
}
__device__ __forceinline__ int ltid() { int t = threadIdx.x; asm volatile("" : "+v"(t)); return t; }
typedef const Params __attribute__((address_space(4))) * KParamsPtr;
__device__ __forceinline__ const Params& getp() {
    KParamsPtr kp = (KParamsPtr)__builtin_amdgcn_kernarg_segment_ptr();
    asm volatile("" : "+s"(kp));
    return *(const Params*)kp;
}
__device__ __forceinline__ void ph_rope(const Params& p) {
    for (int idx = blockIdx.x * 256 + ltid(); idx < T_ * 32; idx += gridDim.x * 256) {
        int t = idx >> 5, i = idx & 31;
        float ang = (float)p.positions[t] * INVF[i];
        double rev = (double)ang * 0.15915494309189535;
        double fr = rev - rint(rev);
        float r = (float)(fr * 6.283185307179586);
        f32x2 cs; cs.x = __cosf(r); cs.y = __sinf(r);
        ((f32x2*)(p.ws + OFF_ROPE))[idx] = cs;
    }
}

__device__ __forceinline__ void ph_mod(const Params& p, unsigned char* smem) {
    float* sc = (float*)smem;
    float* part = sc + 8 * 1024;
    const int tid = ltid();
    if ((int)blockIdx.x >= 192) return;
    __syncthreads();
    for (int i = tid; i < 8192; i += 256) sc[i] = siluf_(p.c[i]);
    __syncthreads();
    for (int it = blockIdx.x; it < 192; it += gridDim.x) {
        const int l = it / 96, jb = (it % 96) * 64;
        const int c4 = (tid & 15) * 4, kg = tid >> 4;
        f32x4 acc[8];
#pragma unroll
        for (int b = 0; b < 8; ++b) acc[b] = (f32x4){0.f, 0.f, 0.f, 0.f};
        const float* w = p.ada_w + (size_t)l * 1024 * 6144 + jb + c4;
#pragma unroll 4
        for (int k = kg * 64; k < kg * 64 + 64; ++k) {
            const f32x4 wv = *(const f32x4*)(w + (size_t)k * 6144);
#pragma unroll
            for (int b = 0; b < 8; ++b) acc[b] += wv * sc[b * 1024 + k];
        }
        if (kg >= 8) {
#pragma unroll
            for (int b = 0; b < 8; ++b) *(f32x4*)(part + ((kg - 8) * 8 + b) * 64 + c4) = acc[b];
        }
        __syncthreads();
        if (kg < 8) {
#pragma unroll
            for (int b = 0; b < 8; ++b) { f32x4* q = (f32x4*)(part + (kg * 8 + b) * 64 + c4); *q = *q + acc[b]; }
        }
        __syncthreads();
        {
            float* mod = (float*)(p.ws + OFF_MOD);
#pragma unroll
            for (int o = 0; o < 2; ++o) {
                const int idx = tid + 256 * o, b = idx >> 6, jj = idx & 63;
                float r = 0.f;
#pragma unroll
                for (int g = 0; g < 8; ++g) r += part[(g * 8 + b) * 64 + jj];
                mod[(size_t)(l * 8 + b) * 6144 + jb + jj] = r + p.ada_b[l * 6144 + jb + jj];
            }
        }
        __syncthreads();
    }
}

struct TJob {
    const float* src; bf16_t* dst;
    int K, NQ, src_ld, dst_ld, mode, p0, nbatch, pad;
    size_t src_bs, dst_bs;
};
__device__ __forceinline__ int tj_src_col(int mode, int p0, int q) {
    if (mode == 0) return q + p0;
    if (mode == 1) return q < 1092 ? q : (q < 1152 ? -1 : q - 60);
    if (mode == 2) return q;
    return q < 64 ? q : -1;
}
__device__ __forceinline__ int tj_dst_row(int mode, int p0, int q) {
    if (mode == 2) return (q >> 5) * 64 + p0 + (q & 31);
    return q;
}
__device__ __forceinline__ void tconv_load(const TJob& j, int it, int tid, f32x4 (&r)[4]) {
    const int nk = j.K / 64;
    const int per = (j.NQ / 64) * nk;
    const int b = it / per, rr = it % per, qt = rr / nk, kt = rr % nk;
    const float* src = j.src + (size_t)b * j.src_bs;
    const int tx4 = (tid & 15) * 4, ty = tid >> 4;
    const int sc = tj_src_col(j.mode, j.p0, qt * 64 + tx4);
#pragma unroll
    for (int i = 0; i < 4; ++i) {
        if (sc >= 0) r[i] = *(const f32x4*)(src + (size_t)(kt * 64 + ty + 16 * i) * j.src_ld + sc);
        else r[i] = (f32x4){0.f, 0.f, 0.f, 0.f};
    }
}
constexpr int TCS = 68;
__device__ __forceinline__ void tconv_put(int tid, const f32x4 (&r)[4], float* tile) {
    const int tx4 = (tid & 15) * 4, ty = tid >> 4;
#pragma unroll
    for (int i = 0; i < 4; ++i) {
        const int k = ty + 16 * i;
        *(f32x4*)(tile + k * TCS + (tx4 ^ (((k >> 4) & 1) * 16))) = r[i];
    }
}
__device__ __forceinline__ void tconv_emit(const TJob& j, int it, int tid, const float* tile) {
    const int nk = j.K / 64;
    const int per = (j.NQ / 64) * nk;
    const int b = it / per, rr = it % per, qt = rr / nk, kt = rr % nk;
    bf16_t* dst = j.dst + (size_t)b * j.dst_bs;
    const int nn = tid >> 2, kc = (tid & 3) * 16;
    const int dr = tj_dst_row(j.mode, j.p0, qt * 64 + nn);
    const int col = nn ^ (((kc >> 4) & 1) * 16);
    unsigned w[8];
#pragma unroll
    for (int i = 0; i < 8; ++i) w[i] = pack2(tile[(kc + 2 * i) * TCS + col], tile[(kc + 2 * i + 1) * TCS + col]);
    u32x4* d = (u32x4*)(dst + (size_t)dr * j.dst_ld + kt * 64 + kc);
    d[0] = (u32x4){w[0], w[1], w[2], w[3]};
    d[1] = (u32x4){w[4], w[5], w[6], w[7]};
}

__device__ __forceinline__ void ph_wcomp(const Params& p, int l, unsigned char* smem) {
    float (*row)[256] = (float (*)[256])smem;
    const int tid = ltid();
    for (int it = blockIdx.x; it < 512; it += gridDim.x) {
    const int k0 = it * 2;
    __syncthreads();
    {
        const int kk = tid >> 7, jj = tid & 127;
        const float* wi = p.w_in + ((size_t)l * 1024 + k0 + kk) * NIN_ + 512;
        row[kk][jj] = wi[jj] * p.g_kv[l * 256 + jj];
        row[kk][jj + 128] = wi[jj + 128] * p.g_kv[l * 256 + jj + 128];
    }
    __syncthreads();
    const int kk = tid >> 7, n = tid & 127;
    const float* wu = (n < 64) ? (p.w_uk + (size_t)l * 256 * 64 + n) : (p.w_uv + (size_t)l * 256 * 64 + (n - 64));
    float acc = 0.f;
    for (int jx = 0; jx < 256; ++jx) acc += row[kk][jx] * wu[jx * 64];
    bf16_t* WinT = (bf16_t*)(p.ws + OFF_WB) + WB_WIN;
    WinT[(size_t)(C_KA + n) * 1024 + k0 + kk] = f2bf(acc);
    }
}

struct NormArgs {
    const float* xin; const bf16_t* Y; const bf16_t* slots;
    const float* gpost; const float* gt;
    const float* gpre; const float* sc; const float* sh;
    int mode;
};
__device__ __forceinline__ void ph_norm(const Params& p, const NormArgs& a) {
    const int lane = ltid() & 63;
    for (int row = blockIdx.x * 4 + (ltid() >> 6); row < T_; row += gridDim.x * 4) {
    const int b = row >> 11;
    float* xo = p.out + (size_t)row * 1024;
    f32x4 xv[4];
    if (a.mode == 0) {
#pragma unroll
        for (int i = 0; i < 4; ++i) xv[i] = *(const f32x4*)(a.xin + (size_t)row * 1024 + i * 256 + lane * 4);
    } else {
        f32x4 yv[4];
        if (a.mode == 1) {
#pragma unroll
            for (int i = 0; i < 4; ++i) {
                u32x2 u = *(const u32x2*)(a.Y + (size_t)row * 1024 + i * 256 + lane * 4);
                yv[i][0] = __uint_as_float(u.x << 16); yv[i][1] = __uint_as_float(u.x & 0xffff0000u);
                yv[i][2] = __uint_as_float(u.y << 16); yv[i][3] = __uint_as_float(u.y & 0xffff0000u);
            }
        } else {
#pragma unroll
            for (int i = 0; i < 4; ++i) yv[i] = (f32x4){0.f, 0.f, 0.f, 0.f};
#pragma unroll
            for (int k = 0; k < 9; ++k) {
                const bf16_t* sp = a.slots + (k < 8 ? ((size_t)row * 8 + k) : ((size_t)8 * T_ + row)) * 1024;
#pragma unroll
                for (int i = 0; i < 4; ++i) {
                    u32x2 u = *(const u32x2*)(sp + i * 256 + lane * 4);
                    yv[i][0] += __uint_as_float(u.x << 16); yv[i][1] += __uint_as_float(u.x & 0xffff0000u);
                    yv[i][2] += __uint_as_float(u.y << 16); yv[i][3] += __uint_as_float(u.y & 0xffff0000u);
                }
            }
        }
        float ss = 0.f;
#pragma unroll
        for (int i = 0; i < 4; ++i) ss += yv[i][0] * yv[i][0] + yv[i][1] * yv[i][1] + yv[i][2] * yv[i][2] + yv[i][3] * yv[i][3];
        ss = wave_sum(ss);
        const float rs = rsqrtf(ss * (1.0f / 1024.0f) + EPS_);
#pragma unroll
        for (int i = 0; i < 4; ++i) {
            const int col = i * 256 + lane * 4;
            f32x4 xo4 = *(const f32x4*)(xo + col);
            f32x4 g4 = *(const f32x4*)(a.gpost + col);
            f32x4 gt4 = *(const f32x4*)(a.gt + (size_t)b * 6144 + col);
            xv[i] = xo4 + gt4 * (yv[i] * rs * g4);
        }
    }
#pragma unroll
    for (int i = 0; i < 4; ++i) *(f32x4*)(xo + i * 256 + lane * 4) = xv[i];
    if (a.gpre) {
        float ss = 0.f;
#pragma unroll
        for (int i = 0; i < 4; ++i) ss += xv[i][0] * xv[i][0] + xv[i][1] * xv[i][1] + xv[i][2] * xv[i][2] + xv[i][3] * xv[i][3];
        ss = wave_sum(ss);
        const float rs = rsqrtf(ss * (1.0f / 1024.0f) + EPS_);
        bf16_t* H = (bf16_t*)(p.ws + OFF_H) + (size_t)row * 1024;
#pragma unroll
        for (int i = 0; i < 4; ++i) {
            const int col = i * 256 + lane * 4;
            f32x4 g4 = *(const f32x4*)(a.gpre + col);
            f32x4 sc4 = *(const f32x4*)(a.sc + (size_t)b * 6144 + col);
            f32x4 sh4 = *(const f32x4*)(a.sh + (size_t)b * 6144 + col);
            f32x4 h = (xv[i] * rs * g4) * (sc4 + 1.0f) + sh4;
            u32x2 u; u.x = pack2(h[0], h[1]); u.y = pack2(h[2], h[3]);
            *(u32x2*)(H + col) = u;
        }
    }
    }
}

#define LAS __attribute__((address_space(3)))
constexpr int STG = 32768;
constexpr int MISC = 49152;
constexpr int DYN_LDS = 49152 + 1280;
__device__ __forceinline__ int stg_row(int tid, int i, int pieces) { return ((tid >> 6) * pieces + i) * 8 + ((tid & 63) >> 3); }
__device__ __forceinline__ int stg_chunk(int tid, int i) { return (tid & 7) ^ ((4 * i + ((tid & 63) >> 4)) & 7); }
template <int NW>
__device__ __forceinline__ void gemm_kloop2(f32x4 (&acc)[4][NW], const bf16_t* abase, const unsigned (&aoff)[4], const bf16_t* bbase, const unsigned (&boff)[NW], int K, unsigned char* smem, int tid) {
    const int lane = tid & 63, wid = __builtin_amdgcn_readfirstlane(tid >> 6), wr = wid >> 1, wc = wid & 1, fr = lane & 15, fq = lane >> 4;
    LAS unsigned char* lds = (LAS unsigned char*)smem;
    const int nt = K >> 6;
    const int offA = (wr * 64 + fr) * 128, offB = 16384 + (wc * (16 * NW) + fr) * 128;
    const int sw = fr >> 1;
    for (int t = 0; t < nt; ++t) {
        __syncthreads();
#pragma unroll
        for (int i = 0; i < 4; ++i) __builtin_amdgcn_global_load_lds((const unsigned*)(abase + aoff[i] + t * 64), (LAS unsigned*)(lds + (wid * 4 + i) * 1024), 16, 0, 0);
#pragma unroll
        for (int i = 0; i < NW; ++i) __builtin_amdgcn_global_load_lds((const unsigned*)(bbase + boff[i] + t * 64), (LAS unsigned*)(lds + 16384 + (wid * NW + i) * 1024), 16, 0, 0);
        asm volatile("s_waitcnt vmcnt(0)" ::: "memory");
        __syncthreads();
#pragma unroll
        for (int ks = 0; ks < 2; ++ks) {
            const int ch = ((ks * 4 + fq) ^ sw) << 4;
            bf16x8 af[4], bfv[NW];
#pragma unroll
            for (int m = 0; m < 4; ++m) af[m] = *(const LAS bf16x8*)(lds + offA + m * 2048 + ch);
#pragma unroll
            for (int n = 0; n < NW; ++n) bfv[n] = *(const LAS bf16x8*)(lds + offB + n * 2048 + ch);
            __builtin_amdgcn_s_setprio(1);
#pragma unroll
            for (int m = 0; m < 4; ++m)
#pragma unroll
                for (int n = 0; n < NW; ++n) acc[m][n] = __builtin_amdgcn_mfma_f32_16x16x32_bf16(af[m], bfv[n], acc[m][n], 0, 0, 0);
            __builtin_amdgcn_s_setprio(0);
        }
    }
}

constexpr int LDT = 72;
struct __attribute__((aligned(16))) GemmLds { bf16_t A[128 * LDT]; bf16_t B[128 * LDT]; };

template <int NW>
__device__ __forceinline__ void gemm_kloop(f32x4 (&acc)[4][NW], const bf16_t* const (&ap)[4], const bf16_t* const (&bp)[NW], int K,
                                           bf16_t* sA, bf16_t* sB, int tid) {
    const int lane = tid & 63, wid = __builtin_amdgcn_readfirstlane(tid >> 6), wr = wid >> 1, wc = wid & 1, fr = lane & 15, fq = lane >> 4;
    u32x4 ra[4], rb[NW];
#pragma unroll
    for (int i = 0; i < 4; ++i) ra[i] = *(const u32x4*)(ap[i]);
#pragma unroll
    for (int i = 0; i < NW; ++i) rb[i] = *(const u32x4*)(bp[i]);
    const int srow = tid >> 3, scol = (tid & 7) * 8;
    for (int k0 = 0; k0 < K; k0 += 64) {
        __syncthreads();
#pragma unroll
        for (int i = 0; i < 4; ++i) *(u32x4*)(sA + (srow + 32 * i) * LDT + scol) = ra[i];
#pragma unroll
        for (int i = 0; i < NW; ++i) *(u32x4*)(sB + (srow + 32 * i) * LDT + scol) = rb[i];
        __syncthreads();
        if (k0 + 64 < K) {
#pragma unroll
            for (int i = 0; i < 4; ++i) ra[i] = *(const u32x4*)(ap[i] + k0 + 64);
#pragma unroll
            for (int i = 0; i < NW; ++i) rb[i] = *(const u32x4*)(bp[i] + k0 + 64);
        }
#pragma unroll
        for (int ks = 0; ks < 2; ++ks) {
            bf16x8 af[4], bfv[NW];
#pragma unroll
            for (int m = 0; m < 4; ++m) af[m] = *(const bf16x8*)(sA + (wr * 64 + m * 16 + fr) * LDT + ks * 32 + fq * 8);
#pragma unroll
            for (int n = 0; n < NW; ++n) bfv[n] = *(const bf16x8*)(sB + (wc * (16 * NW) + n * 16 + fr) * LDT + ks * 32 + fq * 8);
#pragma unroll
            for (int m = 0; m < 4; ++m)
#pragma unroll
                for (int n = 0; n < NW; ++n) acc[m][n] = __builtin_amdgcn_mfma_f32_16x16x32_bf16(af[m], bfv[n], acc[m][n], 0, 0, 0);
        }
    }
}
template <int NW>
__device__ __forceinline__ void zero_acc(f32x4 (&acc)[4][NW]) {
#pragma unroll
    for (int m = 0; m < 4; ++m)
#pragma unroll
        for (int n = 0; n < NW; ++n) acc[m][n] = (f32x4){0.f, 0.f, 0.f, 0.f};
}

__device__ __forceinline__ void store_rope(const f32x4 (&acc)[4][4], bf16_t* dst, int ld, int dcol, float scale, const f32x2* rope, int rowbase, int fr, int fq) {
#pragma unroll
    for (int m = 0; m < 4; ++m)
#pragma unroll
        for (int j = 0; j < 4; ++j) {
            const int t = rowbase + m * 16 + fq * 4 + j;
#pragma unroll
            for (int nn = 0; nn < 2; ++nn) {
                const f32x2 cs = rope[(size_t)t * 32 + nn * 16 + fr];
                const float x1 = acc[m][nn][j], x2 = acc[m][nn + 2][j];
                dst[(size_t)t * ld + dcol + nn * 16 + fr] = f2bf((x1 * cs.x - x2 * cs.y) * scale);
                dst[(size_t)t * ld + dcol + (nn + 2) * 16 + fr] = f2bf((x2 * cs.x + x1 * cs.y) * scale);
            }
        }
}
__device__ __forceinline__ void store_plain(const f32x4 (&acc)[4][4], bf16_t* dst, int ld, int dcol, float scale, int act, int rowbase, int fr, int fq) {
#pragma unroll
    for (int m = 0; m < 4; ++m)
#pragma unroll
        for (int j = 0; j < 4; ++j) {
            const int t = rowbase + m * 16 + fq * 4 + j;
#pragma unroll
            for (int n = 0; n < 4; ++n) {
                float v = acc[m][n][j] * scale;
                if (act == 1) v = sigmoidf_(v);
                else if (act == 2) v = siluf_(v);
                dst[(size_t)t * ld + dcol + n * 16 + fr] = f2bf(v);
            }
        }
}
__device__ __forceinline__ void store_trans(const f32x4 (&acc)[4][4], bf16_t* dstT, int rows_per_b, int rowoff, int rowbase, int fr, int fq) {
#pragma unroll
    for (int m = 0; m < 4; ++m) {
        const int t = rowbase + m * 16 + fq * 4;
        const int b = t >> 11, s = t & 2047;
#pragma unroll
        for (int n = 0; n < 4; ++n) {
            u32x2 u; u.x = pack2(acc[m][n][0], acc[m][n][1]); u.y = pack2(acc[m][n][2], acc[m][n][3]);
            *(u32x2*)(dstT + ((size_t)b * rows_per_b + rowoff + n * 16 + fr) * 2048 + s) = u;
        }
    }
}

constexpr int LDE = 136;
template <int NW>
__device__ __forceinline__ void lds_put_tile(bf16_t* sT, const f32x4 (&acc)[4][NW], int wr, int wc, int fr, int fq) {
#pragma unroll
    for (int m = 0; m < 4; ++m)
#pragma unroll
        for (int j = 0; j < 4; ++j)
#pragma unroll
            for (int n = 0; n < NW; ++n) sT[(wr * 64 + m * 16 + fq * 4 + j) * LDE + wc * (16 * NW) + n * 16 + fr] = f2bf(acc[m][n][j]);
}
__device__ __forceinline__ void lds_put_tile_t(bf16_t* sT, const f32x4 (&acc)[4][4], int wr, int wc, int fr, int fq) {
#pragma unroll
    for (int m = 0; m < 4; ++m)
#pragma unroll
        for (int n = 0; n < 4; ++n) {
            u32x2 u; u.x = pack2(acc[m][n][0], acc[m][n][1]); u.y = pack2(acc[m][n][2], acc[m][n][3]);
            *(u32x2*)(sT + (wc * 64 + n * 16 + fr) * LDE + wr * 64 + m * 16 + fq * 4) = u;
        }
}
__device__ __forceinline__ void rope_acc(f32x4 (&acc)[4][4], float scale, const f32x2* rope, int rowbase, int fr, int fq) {
    const f32x2* rp = rope + (size_t)(rowbase + fq * 4) * 32 + fr;
#pragma unroll
    for (int m = 0; m < 4; ++m) {
#pragma unroll
        for (int j = 0; j < 4; ++j) {
#pragma unroll
            for (int nn = 0; nn < 2; ++nn) {
                const f32x2 cs = rp[(m * 16 + j) * 32 + nn * 16];
                const float cc = cs.x * scale, sn = cs.y * scale;
                const float x1 = acc[m][nn][j], x2 = acc[m][nn + 2][j];
                acc[m][nn][j] = __fmaf_rn(x1, cc, -(x2 * sn));
                acc[m][nn + 2][j] = __fmaf_rn(x2, cc, x1 * sn);
            }
            if (j & 1) __builtin_amdgcn_sched_barrier(0);
        }
    }
}
__device__ __forceinline__ void scale_act_acc(f32x4 (&acc)[4][4], float scale, int act) {
#pragma unroll
    for (int m = 0; m < 4; ++m)
#pragma unroll
        for (int n = 0; n < 4; ++n)
#pragma unroll
            for (int j = 0; j < 4; ++j) {
                float v = acc[m][n][j] * scale;
                if (act == 1) v = sigmoidf_(v);
                else if (act == 2) v = siluf_(v);
                acc[m][n][j] = v;
            }
}
struct SegDst { bf16_t* rm; int ld; int dcol; bf16_t* tr; int tr_rows; int tr_off; int kind; };
__device__ __forceinline__ SegDst seg_dst(unsigned char* r1, int c0) {
    SegDst d; d.rm = nullptr; d.ld = 0; d.dcol = 0; d.tr = nullptr; d.tr_rows = 0; d.tr_off = 0; d.kind = 0;
    if (c0 < C_CKV) { d.rm = (bf16_t*)(r1 + R1_QA); d.ld = 512; d.dcol = c0 - C_QA; d.kind = 1; }
    else if (c0 < C_IQ) { d.kind = 0; }
    else if (c0 < C_IK) { d.rm = (bf16_t*)(r1 + R1_IQ); d.ld = 256; d.dcol = c0 - C_IQ; d.kind = 1; }
    else if (c0 < C_IW) { d.rm = (bf16_t*)(r1 + R1_IK); d.ld = 64; d.dcol = 0; d.kind = 1; }
    else if (c0 < C_QB) { d.kind = 0; }
    else if (c0 < C_KB) { d.rm = (bf16_t*)(r1 + R1_QB); d.ld = 512; d.dcol = c0 - C_QB; d.kind = 1; }
    else if (c0 < C_VB) { d.rm = (bf16_t*)(r1 + R1_KB); d.ld = 512; d.dcol = c0 - C_KB; d.kind = 1; }
    else if (c0 < C_QC) { d.tr = (bf16_t*)(r1 + R1_VBT); d.tr_rows = 512; d.tr_off = c0 - C_VB; d.kind = 2; }
    else if (c0 < C_KC) { d.rm = (bf16_t*)(r1 + R1_QC); d.ld = 512; d.dcol = c0 - C_QC; d.kind = 1; }
    else if (c0 < C_VC) { d.rm = (bf16_t*)(r1 + R1_KC); d.ld = 512; d.dcol = c0 - C_KC; d.tr = (bf16_t*)(r1 + R1_KCT); d.tr_rows = 512; d.tr_off = c0 - C_KC; d.kind = 3; }
    else if (c0 < C_GC) { d.tr = (bf16_t*)(r1 + R1_VCT); d.tr_rows = 1024; d.tr_off = c0 - C_VC; d.kind = 2; }
    else if (c0 < C_GATES) { d.rm = (bf16_t*)(r1 + R1_GC); d.ld = 1024; d.dcol = c0 - C_GC; d.kind = 1; }
    else if (c0 < C_KA) { d.tr = (bf16_t*)(r1 + R1_GATES); d.tr_rows = 3072; d.tr_off = c0 - C_GATES; d.kind = 2; }
    else if (c0 < C_VA) { d.rm = (bf16_t*)(r1 + R1_KA); d.ld = 64; d.dcol = 0; d.kind = 1; }
    else { d.tr = (bf16_t*)(r1 + R1_VAT); d.tr_rows = 64; d.tr_off = 0; d.kind = 2; }
    return d;
}

__device__ __forceinline__ void ph_gemm_z(const Params& p, unsigned char* smem) {
    bf16_t* sT = (bf16_t*)smem;
    const int tid = ltid(), lane = tid & 63, wid = __builtin_amdgcn_readfirstlane(tid >> 6), wr = wid >> 1, wc = wid & 1, fr = lane & 15, fq = lane >> 4;
    const bf16_t* H = (const bf16_t*)(p.ws + OFF_H);
    const bf16_t* WinT = (const bf16_t*)(p.ws + OFF_WB) + WB_WIN;
    const int xcd = blockIdx.x & 7, jb = blockIdx.x >> 3, nper = gridDim.x >> 3;
    for (int q = jb; q < 1120; q += nper) {
        const int half = q / 560, rem = q % 560, nt = rem >> 3, mtl = rem & 7;
        const int mt = 16 * xcd + 8 * half + mtl;
        const int m0 = mt * 128, n0 = nt * 128;
        unsigned ao[4], bo[4];
#pragma unroll
        for (int i = 0; i < 4; ++i) {
            const int R = stg_row(tid, i, 4), g = stg_chunk(tid, i);
            ao[i] = (unsigned)(m0 + R) * 1024u + g * 8;
            bo[i] = (unsigned)(n0 + R) * 1024u + g * 8;
        }
        f32x4 acc[4][4];
        zero_acc<4>(acc);
        gemm_kloop2<4>(acc, H, ao, WinT, bo, 1024, smem, tid);
        int te = tid; asm volatile("" : "+v"(te));
        const int fre = te & 15, fqe = (te & 63) >> 4;
        const Params& pe = getp();
        unsigned char* r1 = pe.ws + OFF_R1;
        const f32x2* rope = (const f32x2*)(pe.ws + OFF_ROPE);
        const int c0 = n0 + wc * 64;
        const int rowbase = m0 + wr * 64;
        if (c0 < C_CKV) rope_acc(acc, 0.125f, rope, rowbase, fre, fqe);
        else if (c0 < C_IQ) {
            float* ss = (float*)(pe.ws + OFF_CKVSS);
            const int blk = (c0 - C_CKV) >> 6;
#pragma unroll
            for (int m = 0; m < 4; ++m)
#pragma unroll
                for (int j = 0; j < 4; ++j) {
                    float sq = 0.f;
#pragma unroll
                    for (int n = 0; n < 4; ++n) sq += acc[m][n][j] * acc[m][n][j];
                    sq += __shfl_xor(sq, 1); sq += __shfl_xor(sq, 2); sq += __shfl_xor(sq, 4); sq += __shfl_xor(sq, 8);
                    if (fre == 0) ss[(size_t)(rowbase + m * 16 + fqe * 4 + j) * 4 + blk] = sq;
                }
        }
        else if (c0 < C_IK) rope_acc(acc, 1.0f, rope, rowbase, fre, fqe);
        else if (c0 < C_IW) rope_acc(acc, 1.0f, rope, rowbase, fre, fqe);
        else if (c0 < C_QB) {
            float* iw = (float*)(pe.ws + OFF_IW);
            if (fre < 4) {
#pragma unroll
                for (int m = 0; m < 4; ++m)
#pragma unroll
                    for (int j = 0; j < 4; ++j) iw[(size_t)(rowbase + m * 16 + fqe * 4 + j) * 4 + fre] = acc[m][0][j] * 0.0625f;
            }
        }
        else if (c0 < C_KB) scale_act_acc(acc, 0.125f, 0);
        else if (c0 < C_QC) { }
        else if (c0 < C_KC) rope_acc(acc, 1.0f, rope, rowbase, fre, fqe);
        else if (c0 < C_VC) rope_acc(acc, 0.125f, rope, rowbase, fre, fqe);
        else if (c0 < C_GC) { }
        else if (c0 < C_GATES) scale_act_acc(acc, 1.0f, 2);
        else if (c0 < C_KA) scale_act_acc(acc, 1.0f, 1);
        else if (c0 < C_VA) rope_acc(acc, 1.0f, rope, rowbase, fre, fqe);
        const SegDst dw = seg_dst(r1, c0);
        const SegDst d0 = seg_dst(r1, n0), d1 = seg_dst(r1, n0 + 64);
        const int anyrm = (d0.kind | d1.kind) & 1, anytr = (d0.kind | d1.kind) & 2;
        __syncthreads();
        if (anyrm) {
            if (dw.kind & 1) lds_put_tile<4>(sT, acc, wr, wc, fre, fqe);
            __syncthreads();
#pragma unroll
            for (int hh = 0; hh < 2; ++hh) {
                const SegDst& d = hh ? d1 : d0;
                if (d.kind & 1) {
#pragma unroll
                    for (int i = 0; i < 4; ++i) {
                        const int c = te + 256 * i, row = c >> 3, ch = c & 7;
                        *(u32x4*)(d.rm + (size_t)(m0 + row) * d.ld + d.dcol + ch * 8) = *(const u32x4*)(sT + row * LDE + hh * 64 + ch * 8);
                    }
                }
            }
        }
        if (anytr) {
            __syncthreads();
            if (dw.kind & 2) lds_put_tile_t(sT, acc, wr, wc, fre, fqe);
            __syncthreads();
            const int b = m0 >> 11, s0 = m0 & 2047;
#pragma unroll
            for (int hh = 0; hh < 2; ++hh) {
                const SegDst& d = hh ? d1 : d0;
                if (d.kind & 2) {
#pragma unroll
                    for (int i = 0; i < 4; ++i) {
                        const int c = te + 256 * i, erow = c >> 4, ch = c & 15;
                        *(u32x4*)(d.tr + ((size_t)b * d.tr_rows + d.tr_off + erow) * 2048 + s0 + ch * 8) = *(const u32x4*)(sT + (hh * 64 + erow) * LDE + ch * 8);
                    }
                }
            }
        }
    }
}

struct __attribute__((aligned(16))) AttnLds { bf16_t K[64 * LDT]; bf16_t Vt[64 * LDT]; float rs[64]; };

__device__ __forceinline__ void tile64_load(u32x4 (&r)[2], const bf16_t* src, size_t src_ld, int tid) {
#pragma unroll
    for (int i = 0; i < 2; ++i) {
        const int c = tid + 256 * i, row = c >> 3, col8 = (c & 7) * 8;
        r[i] = *(const u32x4*)(src + (size_t)row * src_ld + col8);
    }
}
__device__ __forceinline__ void tile64_put(bf16_t* dst, const u32x4 (&r)[2], int tid) {
#pragma unroll
    for (int i = 0; i < 2; ++i) {
        const int c = tid + 256 * i, row = c >> 3, col8 = (c & 7) * 8;
        *(u32x4*)(dst + row * LDT + col8) = r[i];
    }
}
__device__ __forceinline__ void stage_tile64(bf16_t* dst, const bf16_t* src, size_t src_ld, int tid) {
#pragma unroll
    for (int i = 0; i < 2; ++i) {
        const int c = tid + 256 * i, row = c >> 3, col8 = (c & 7) * 8;
        *(u32x4*)(dst + row * LDT + col8) = *(const u32x4*)(src + (size_t)row * src_ld + col8);
    }
}

__device__ __forceinline__ void sb_tile(const AttnLds& sm, const bf16x8 (&qf)[2], f32x4 (&O)[4], float& R, bool diag, int tl, int fr, int fq) {
    f32x4 st[4];
#pragma unroll
    for (int mk = 0; mk < 4; ++mk) {
        st[mk] = (f32x4){0.f, 0.f, 0.f, 0.f};
#pragma unroll
        for (int ks = 0; ks < 2; ++ks) {
            bf16x8 kf = *(const bf16x8*)(sm.K + (mk * 16 + fr) * LDT + ks * 32 + fq * 8);
            st[mk] = __builtin_amdgcn_mfma_f32_16x16x32_bf16(kf, qf[ks], st[mk], 0, 0, 0);
        }
    }
    float Bv[4][4], Om[4][4], P[4];
#pragma unroll
    for (int mk = 0; mk < 4; ++mk) {
        P[mk] = 1.f;
#pragma unroll
        for (int r = 0; r < 4; ++r) {
            const float z = st[mk][r];
            const bool valid = !diag || (16 * mk + 4 * fq + r < tl);
            const float e = __expf(-fabsf(z));
            const float sg = __builtin_amdgcn_rcpf(1.0f + e);
            const float es = e * sg;
            const float beta = (z >= 0.f) ? sg : es, om = (z >= 0.f) ? es : sg;
            Bv[mk][r] = valid ? beta : 0.f;
            Om[mk][r] = valid ? om : 1.f;
            P[mk] *= Om[mk][r];
        }
    }
    float tot[4], above[4];
#pragma unroll
    for (int mk = 0; mk < 4; ++mk) {
        auto sw = __builtin_amdgcn_permlane16_swap(__float_as_uint(P[mk]), __float_as_uint(P[mk]), false, false);
        const float po = __uint_as_float(sw[1]);
        const float pair = __uint_as_float(sw[0]) * po;
        auto tw = __builtin_amdgcn_permlane32_swap(__float_as_uint(pair), __float_as_uint(pair), false, false);
        const float hi = __uint_as_float(tw[1]);
        tot[mk] = __uint_as_float(tw[0]) * hi;
        above[mk] = ((fq & 1) ? 1.f : po) * ((fq < 2) ? hi : 1.f);
    }
    float higher[4];
    higher[3] = 1.f; higher[2] = tot[3]; higher[1] = tot[3] * tot[2]; higher[0] = tot[3] * tot[2] * tot[1];
    float A[4][4];
#pragma unroll
    for (int mk = 0; mk < 4; ++mk) {
        float suf = above[mk] * higher[mk] * R;
#pragma unroll
        for (int r = 3; r >= 0; --r) {
            A[mk][r] = Bv[mk][r] * suf;
            suf *= Om[mk][r];
        }
    }
    R *= (tot[0] * tot[1]) * (tot[2] * tot[3]);
#pragma unroll
    for (int ks = 0; ks < 2; ++ks) {
        u32x4 uu = (u32x4){pack2(A[2 * ks][0], A[2 * ks][1]), pack2(A[2 * ks][2], A[2 * ks][3]),
                           pack2(A[2 * ks + 1][0], A[2 * ks + 1][1]), pack2(A[2 * ks + 1][2], A[2 * ks + 1][3])};
        bf16x8 pf = *(bf16x8*)&uu;
#pragma unroll
        for (int me = 0; me < 4; ++me) {
            const bf16_t* vp = sm.Vt + (me * 16 + fr) * LDT + ks * 32 + 4 * fq;
            u32x2 lo = *(const u32x2*)vp, hi = *(const u32x2*)(vp + 16);
            u32x4 vv = (u32x4){lo.x, lo.y, hi.x, hi.y};
            O[me] = __builtin_amdgcn_mfma_f32_16x16x32_bf16(*(bf16x8*)&vv, pf, O[me], 0, 0, 0);
        }
    }
}
__device__ __forceinline__ void mixb_item(const Params& p, int item, unsigned char* smem) {
    AttnLds& sm = *(AttnLds*)smem;
    const int tid = ltid(), lane = tid & 63, w = __builtin_amdgcn_readfirstlane(tid >> 6), fr = lane & 15, fq = lane >> 4;
    unsigned char* r1 = p.ws + OFF_R1;
    bf16_t* QB = (bf16_t*)(r1 + R1_QB);
    const bf16_t* KB = (const bf16_t*)(r1 + R1_KB);
    const bf16_t* VBT = (const bf16_t*)(r1 + R1_VBT);
    {
        const int qt2 = 15 - (item >> 6), bh = item & 63, b = bh >> 3, h = bh & 7;
        const int tl = 16 * w + fr;
        const int tq0 = b * 2048 + qt2 * 128 + tl, tq1 = tq0 + 64;
        bf16x8 qf0[2], qf1[2];
#pragma unroll
        for (int ks = 0; ks < 2; ++ks) {
            qf0[ks] = *(const bf16x8*)(QB + (size_t)tq0 * 512 + h * 64 + ks * 32 + fq * 8);
            qf1[ks] = *(const bf16x8*)(QB + (size_t)tq1 * 512 + h * 64 + ks * 32 + fq * 8);
        }
        f32x4 O0[4], O1[4];
#pragma unroll
        for (int me = 0; me < 4; ++me) { O0[me] = (f32x4){0.f, 0.f, 0.f, 0.f}; O1[me] = (f32x4){0.f, 0.f, 0.f, 0.f}; }
        float R0 = 1.f, R1 = 1.f;
        const int ktop = 2 * qt2 + 1;
        for (int kt = ktop; kt >= 0; --kt) {
            __syncthreads();
            stage_tile64(sm.K, KB + (size_t)(b * 2048 + kt * 64) * 512 + h * 64, 512, tid);
            stage_tile64(sm.Vt, VBT + ((size_t)(b * 8 + h) * 64) * 2048 + kt * 64, 2048, tid);
            __syncthreads();
            sb_tile(sm, qf1, O1, R1, kt == ktop, tl, fr, fq);
            if (kt < ktop) sb_tile(sm, qf0, O0, R0, kt == ktop - 1, tl, fr, fq);
        }
        const int ts = ltid();
        const int fqs = (ts & 63) >> 4;
        const int tqs0 = b * 2048 + qt2 * 128 + 16 * (ts >> 6) + (ts & 15), tqs1 = tqs0 + 64;
#pragma unroll
        for (int me = 0; me < 4; ++me) {
            u32x2 u; u.x = pack2(O0[me][0], O0[me][1]); u.y = pack2(O0[me][2], O0[me][3]);
            *(u32x2*)(QB + (size_t)tqs0 * 512 + h * 64 + me * 16 + 4 * fqs) = u;
            u32x2 v; v.x = pack2(O1[me][0], O1[me][1]); v.y = pack2(O1[me][2], O1[me][3]);
            *(u32x2*)(QB + (size_t)tqs1 * 512 + h * 64 + me * 16 + 4 * fqs) = v;
        }
    }
}

struct __attribute__((aligned(16))) RetLds { bf16_t K[64 * LDT]; bf16_t KT[64 * LDT]; bf16_t VT[128 * LDT]; bf16_t ST[128 * LDT]; };
struct __attribute__((aligned(16))) RetLds3 { bf16_t K[64 * LDT]; bf16_t VT[128 * LDT]; bf16_t ST[128 * LDT]; };

__device__ __forceinline__ void mixc1_item(const Params& p, int item, unsigned char* smem) {
    RetLds& sm = *(RetLds*)smem;
    const int tid = ltid(), lane = tid & 63, w = __builtin_amdgcn_readfirstlane(tid >> 6), fr = lane & 15, fq = lane >> 4;
    unsigned char* r1 = p.ws + OFF_R1;
    const bf16_t* KCT = (const bf16_t*)(r1 + R1_KCT);
    const bf16_t* VCT = (const bf16_t*)(r1 + R1_VCT);
    bf16_t* KVT = (bf16_t*)(p.ws + OFF_H);
    const int bh = item >> 5, n = item & 31, h = bh & 7;
    const float lg = LOGG[h];
    u32x4 rkt[2], rvt[4];
#pragma unroll
    for (int i = 0; i < 2; ++i) {
        const int c = tid + 256 * i, row = c >> 3, col8 = (c & 7) * 8;
        rkt[i] = *(const u32x4*)(KCT + ((size_t)bh * 64 + row) * 2048 + n * 64 + col8);
    }
#pragma unroll
    for (int i = 0; i < 4; ++i) {
        const int c = tid + 256 * i, row = c >> 3, col8 = (c & 7) * 8;
        rvt[i] = *(const u32x4*)(VCT + ((size_t)bh * 128 + row) * 2048 + n * 64 + col8);
    }
    __syncthreads();
#pragma unroll
    for (int i = 0; i < 2; ++i) {
        const int c = tid + 256 * i, row = c >> 3, col8 = (c & 7) * 8;
        unsigned uu[4] = {rkt[i].x, rkt[i].y, rkt[i].z, rkt[i].w};
#pragma unroll
        for (int q = 0; q < 4; ++q) {
            const float z0 = __expf(lg * (float)(63 - (col8 + 2 * q))), z1 = __expf(lg * (float)(63 - (col8 + 2 * q + 1)));
            uu[q] = pack2(__uint_as_float(uu[q] << 16) * z0, __uint_as_float(uu[q] & 0xffff0000u) * z1);
        }
        *(u32x4*)(sm.KT + row * LDT + col8) = (u32x4){uu[0], uu[1], uu[2], uu[3]};
    }
#pragma unroll
    for (int i = 0; i < 4; ++i) {
        const int c = tid + 256 * i, row = c >> 3, col8 = (c & 7) * 8;
        *(u32x4*)(sm.VT + row * LDT + col8) = rvt[i];
    }
    __syncthreads();
    f32x4 sacc[4][2];
#pragma unroll
    for (int md = 0; md < 4; ++md)
#pragma unroll
        for (int ne = 0; ne < 2; ++ne) sacc[md][ne] = (f32x4){0.f, 0.f, 0.f, 0.f};
#pragma unroll
    for (int ks = 0; ks < 2; ++ks) {
        bf16x8 vf[2];
#pragma unroll
        for (int ne = 0; ne < 2; ++ne) vf[ne] = *(const bf16x8*)(sm.VT + (32 * w + ne * 16 + fr) * LDT + ks * 32 + fq * 8);
#pragma unroll
        for (int md = 0; md < 4; ++md) {
            bf16x8 kf = *(const bf16x8*)(sm.KT + (md * 16 + fr) * LDT + ks * 32 + fq * 8);
#pragma unroll
            for (int ne = 0; ne < 2; ++ne) sacc[md][ne] = __builtin_amdgcn_mfma_f32_16x16x32_bf16(kf, vf[ne], sacc[md][ne], 0, 0, 0);
        }
    }
    bf16_t* dst = KVT + (size_t)item * 128 * 64;
#pragma unroll
    for (int md = 0; md < 4; ++md)
#pragma unroll
        for (int ne = 0; ne < 2; ++ne) {
            u32x2 u; u.x = pack2(sacc[md][ne][0], sacc[md][ne][1]); u.y = pack2(sacc[md][ne][2], sacc[md][ne][3]);
            *(u32x2*)(dst + (32 * w + ne * 16 + fr) * 64 + md * 16 + 4 * fq) = u;
        }
}
__device__ __forceinline__ void ph_mixc2(const Params& p) {
    bf16_t* KVT = (bf16_t*)(p.ws + OFF_H);
    for (int idx = blockIdx.x * 256 + ltid(); idx < 64 * 128 * 16; idx += gridDim.x * 256) {
        const int bh = idx >> 11, ed = idx & 2047;
        const float g64 = __expf(LOGG[bh & 7] * 64.0f);
        bf16_t* pp = KVT + (size_t)bh * 32 * 8192 + (size_t)ed * 4;
        float s0 = 0.f, s1 = 0.f, s2 = 0.f, s3 = 0.f;
#pragma unroll 4
        for (int n = 0; n < 32; ++n) {
            u32x2 kv = *(const u32x2*)(pp + (size_t)n * 8192);
            u32x2 o; o.x = pack2(s0, s1); o.y = pack2(s2, s3);
            *(u32x2*)(pp + (size_t)n * 8192) = o;
            s0 = s0 * g64 + __uint_as_float(kv.x << 16); s1 = s1 * g64 + __uint_as_float(kv.x & 0xffff0000u);
            s2 = s2 * g64 + __uint_as_float(kv.y << 16); s3 = s3 * g64 + __uint_as_float(kv.y & 0xffff0000u);
        }
    }
}
__device__ __forceinline__ void mixc3_item(const Params& p, int l, int item, unsigned char* smem) {
    RetLds3& sm = *(RetLds3*)smem;
    const int tid = ltid(), lane = tid & 63, w = __builtin_amdgcn_readfirstlane(tid >> 6), fr = lane & 15, fq = lane >> 4;
    unsigned char* r1 = p.ws + OFF_R1;
    const bf16_t* QC = (const bf16_t*)(r1 + R1_QC);
    const bf16_t* KC = (const bf16_t*)(r1 + R1_KC);
    const bf16_t* VCT = (const bf16_t*)(r1 + R1_VCT);
    const bf16_t* KVT = (const bf16_t*)(p.ws + OFF_H);
    bf16_t* GC = (bf16_t*)(r1 + R1_GC);
    {
        const int bh = item >> 5, n = item & 31, b = bh >> 3, h = bh & 7;
        const float lg = LOGG[h];
        const int al = 16 * w + fr;
        const float xi = __expf(lg * (float)(al + 1));
        {
            const int tok0 = b * 2048 + n * 64;
            u32x4 rk[2], rvt[4], rst[4];
            bf16x8 qf[2];
#pragma unroll
            for (int ks = 0; ks < 2; ++ks) qf[ks] = *(const bf16x8*)(QC + (size_t)(tok0 + 16 * w + fr) * 512 + h * 64 + ks * 32 + fq * 8);
            tile64_load(rk, KC + (size_t)tok0 * 512 + h * 64, 512, tid);
#pragma unroll
            for (int i = 0; i < 4; ++i) {
                const int c = tid + 256 * i, row = c >> 3, col8 = (c & 7) * 8;
                rvt[i] = *(const u32x4*)(VCT + ((size_t)bh * 128 + row) * 2048 + n * 64 + col8);
                rst[i] = *(const u32x4*)(KVT + (size_t)item * 8192 + row * 64 + col8);
            }
            __syncthreads();
            tile64_put(sm.K, rk, tid);
#pragma unroll
            for (int i = 0; i < 4; ++i) {
                const int c = tid + 256 * i, row = c >> 3, col8 = (c & 7) * 8;
                *(u32x4*)(sm.VT + row * LDT + col8) = rvt[i];
                *(u32x4*)(sm.ST + row * LDT + col8) = rst[i];
            }
            __syncthreads();
            f32x4 st[4];
#pragma unroll
            for (int mc = 0; mc < 4; ++mc) {
                st[mc] = (f32x4){0.f, 0.f, 0.f, 0.f};
#pragma unroll
                for (int ks = 0; ks < 2; ++ks) {
                    bf16x8 kf = *(const bf16x8*)(sm.K + (mc * 16 + fr) * LDT + ks * 32 + fq * 8);
                    st[mc] = __builtin_amdgcn_mfma_f32_16x16x32_bf16(kf, qf[ks], st[mc], 0, 0, 0);
                }
#pragma unroll
                for (int r = 0; r < 4; ++r) {
                    const int cc = 16 * mc + 4 * fq + r;
                    st[mc][r] *= __expf(lg * fabsf((float)(al - cc)));
                }
            }
            f32x4 o[8];
#pragma unroll
            for (int me = 0; me < 8; ++me) {
                o[me] = (f32x4){0.f, 0.f, 0.f, 0.f};
#pragma unroll
                for (int ks = 0; ks < 2; ++ks) {
                    bf16x8 sf = *(const bf16x8*)(sm.ST + (me * 16 + fr) * LDT + ks * 32 + fq * 8);
                    o[me] = __builtin_amdgcn_mfma_f32_16x16x32_bf16(sf, qf[ks], o[me], 0, 0, 0);
                }
                o[me] *= xi;
            }
#pragma unroll
            for (int ks = 0; ks < 2; ++ks) {
                bf16x8 pf;
                {
                    u32x4 uu = (u32x4){pack2(st[2 * ks][0], st[2 * ks][1]), pack2(st[2 * ks][2], st[2 * ks][3]),
                                          pack2(st[2 * ks + 1][0], st[2 * ks + 1][1]), pack2(st[2 * ks + 1][2], st[2 * ks + 1][3])};
                    pf = *(bf16x8*)&uu;
                }
#pragma unroll
                for (int me = 0; me < 8; ++me) {
                    const bf16_t* vp = sm.VT + (me * 16 + fr) * LDT + ks * 32 + 4 * fq;
                    u32x2 lo = *(const u32x2*)vp, hi = *(const u32x2*)(vp + 16);
                    u32x4 vv = (u32x4){lo.x, lo.y, hi.x, hi.y};
                    o[me] = __builtin_amdgcn_mfma_f32_16x16x32_bf16(*(bf16x8*)&vv, pf, o[me], 0, 0, 0);
                }
            }
            {
                float s1 = 0.f;
#pragma unroll
                for (int me = 0; me < 8; ++me) s1 += (o[me][0] + o[me][1]) + (o[me][2] + o[me][3]);
                s1 = xrow16_sum(s1);
                const float mu = s1 * (1.0f / 128.0f);
                float s2 = 0.f;
#pragma unroll
                for (int me = 0; me < 8; ++me)
#pragma unroll
                    for (int r = 0; r < 4; ++r) { const float d = o[me][r] - mu; s2 += d * d; }
                s2 = xrow16_sum(s2);
                const float rstd = rsqrtf(s2 * (1.0f / 128.0f) + EPS_);
                bf16_t* gp = GC + (size_t)(tok0 + al) * 1024 + h * 128;
                const float* gr = p.g_ret + (size_t)l * 1024 + h * 128;
#pragma unroll
                for (int me = 0; me < 8; ++me) {
                    const int e0 = me * 16 + 4 * fq;
                    u32x2 gu = *(const u32x2*)(gp + e0);
                    f32x4 g4 = *(const f32x4*)(gr + e0);
                    const float y0 = (o[me][0] - mu) * rstd * g4[0] * __uint_as_float(gu.x << 16);
                    const float y1 = (o[me][1] - mu) * rstd * g4[1] * __uint_as_float(gu.x & 0xffff0000u);
                    const float y2 = (o[me][2] - mu) * rstd * g4[2] * __uint_as_float(gu.y << 16);
                    const float y3 = (o[me][3] - mu) * rstd * g4[3] * __uint_as_float(gu.y & 0xffff0000u);
                    u32x2 ou; ou.x = pack2(y0, y1); ou.y = pack2(y2, y3);
                    *(u32x2*)(gp + e0) = ou;
                }
            }
        }
    }
}

__device__ __forceinline__ void mixa1_item(const Params& p, int item, unsigned char* smem) {
    float* tau_s = (float*)smem;
    int* stau_s = (int*)(smem + 64);
    const int tid = ltid(), lane = tid & 63, w = __builtin_amdgcn_readfirstlane(tid >> 6), fr = lane & 15, fq = lane >> 4;
    unsigned char* r1 = p.ws + OFF_R1;
    const bf16_t* IQ = (const bf16_t*)(r1 + R1_IQ);
    const bf16_t* IK = (const bf16_t*)(r1 + R1_IK);
    const float* IW = (const float*)(p.ws + OFF_IW);
    float* SC = (float*)(p.ws + OFF_R3);
    unsigned long long* MASKB = (unsigned long long*)(p.ws + OFF_MASKB);
    {
        const int c = 31 - (item >> 5), b = (item >> 2) & 7, qq = item & 3;
        __syncthreads();
        const int nj = c + 1, n = 64 * nj;
        const int tq = b * 2048 + c * 64 + 16 * qq + fr;
        float* scrow = SC + (size_t)b * SC_PER_BATCH + (size_t)2048 * c * (c + 1) + (size_t)(16 * qq + fr) * n;
        bf16x8 iqf[4][2];
        float iw[4];
#pragma unroll
        for (int hh = 0; hh < 4; ++hh) {
            iw[hh] = IW[(size_t)tq * 4 + hh];
#pragma unroll
            for (int ks = 0; ks < 2; ++ks) iqf[hh][ks] = *(const bf16x8*)(IQ + (size_t)tq * 256 + hh * 64 + ks * 32 + fq * 8);
        }
        for (int kt = w; kt < nj; kt += 4) {
            bf16x8 ikf[4][2];
#pragma unroll
            for (int mk = 0; mk < 4; ++mk)
#pragma unroll
                for (int ks = 0; ks < 2; ++ks) ikf[mk][ks] = *(const bf16x8*)(IK + (size_t)(b * 2048 + kt * 64 + mk * 16 + fr) * 64 + ks * 32 + fq * 8);
            f32x4 sc[4];
#pragma unroll
            for (int mk = 0; mk < 4; ++mk) sc[mk] = (f32x4){0.f, 0.f, 0.f, 0.f};
#pragma unroll
            for (int hh = 0; hh < 4; ++hh) {
#pragma unroll
                for (int mk = 0; mk < 4; ++mk) {
                    f32x4 a = (f32x4){0.f, 0.f, 0.f, 0.f};
#pragma unroll
                    for (int ks = 0; ks < 2; ++ks) a = __builtin_amdgcn_mfma_f32_16x16x32_bf16(ikf[mk][ks], iqf[hh][ks], a, 0, 0, 0);
#pragma unroll
                    for (int r = 0; r < 4; ++r) sc[mk][r] = __fmaf_rn(iw[hh], fmaxf(a[r], 0.f), sc[mk][r]);
                }
            }
#pragma unroll
            for (int mk = 0; mk < 4; ++mk) *(f32x4*)(scrow + kt * 64 + 16 * mk + 4 * fq) = sc[mk];
        }
        __syncthreads();
        for (int i = 0; i < 4; ++i) {
            const int r16 = 4 * w + i;
            float tau = -__builtin_inff();
            int stau = 1 << 30;
            if (nj > 4) {
                const float* rowp = SC + (size_t)b * SC_PER_BATCH + (size_t)2048 * c * (c + 1) + (size_t)(16 * qq + r16) * n;
                unsigned key[32];
#pragma unroll
                for (int j = 0; j < 32; ++j) key[j] = __float_as_uint(rowp[j * 64 + lane]);
#pragma unroll
                for (int j = 0; j < 32; ++j) {
                    const unsigned u = key[j];
                    const unsigned k = u ^ ((unsigned)((int)u >> 31) | 0x80000000u);
                    key[j] = (j < nj) ? k : 0u;
                }
                unsigned X = 0u;
                for (int bit = 31; bit >= 0; --bit) {
                    const unsigned cand = X | (1u << bit);
                    int cnt = 0;
                    int c0 = 0, c1 = 0;
#pragma unroll
                    for (int j = 0; j < 32; j += 2) { c0 = cnt_ge(c0, key[j], cand); c1 = cnt_ge(c1, key[j + 1], cand); }
                    cnt = wave_total6(c0 + c1);
                    if (cnt >= 256) X = cand;
                }
                int cgt = 0;
                {
                    const unsigned candp = X + 1u;
                    int c0 = 0, c1 = 0;
#pragma unroll
                    for (int j = 0; j < 32; j += 2) { c0 = cnt_ge(c0, key[j], candp); c1 = cnt_ge(c1, key[j + 1], candp); }
                    cgt = wave_total6(c0 + c1);
                }
                const int need = 256 - cgt;
                unsigned eqbits = 0u;
#pragma unroll
                for (int j = 0; j < 32; ++j) {
                    const unsigned ne = min(key[j] ^ X, 1u);
                    eqbits |= (1u - ne) << j;
                }
                const int teq = wave_sum_i(__popc(eqbits));
                if (teq == need) {
                    stau = 1 << 30;
                } else {
                    int lo = 0, hi = n - 1;
                    while (lo < hi) {
                        const int mid = (lo + hi) >> 1;
                        const int jmax = (mid - lane) >> 6;
                        const unsigned msk = jmax < 0 ? 0u : (jmax >= 31 ? 0xffffffffu : ((2u << jmax) - 1u));
                        const int cc = wave_sum_i(__popc(eqbits & msk));
                        if (cc >= need) hi = mid; else lo = mid + 1;
                    }
                    stau = lo;
                }
                const unsigned ux = (X & 0x80000000u) ? (X & 0x7fffffffu) : ~X;
                tau = __uint_as_float(ux);
            }
            if (lane == 0) { tau_s[r16] = tau; stau_s[r16] = stau; }
        }
        __syncthreads();
        {
            const float tau = tau_s[fr];
            const int stau = stau_s[fr];
            for (int kt = w; kt < nj; kt += 4) {
                unsigned lo = 0u, hi = 0u;
#pragma unroll
                for (int mk = 0; mk < 4; ++mk) {
                    const f32x4 v = *(const f32x4*)(scrow + kt * 64 + 16 * mk + 4 * fq);
#pragma unroll
                    for (int r = 0; r < 4; ++r) {
                        const int kl = 16 * mk + 4 * fq + r;
                        const bool sel = (v[r] > tau) || (v[r] == tau && (kt * 64 + kl) <= stau);
                        if (sel) { if (mk < 2) lo |= 1u << kl; else hi |= 1u << (kl - 32); }
                    }
                }
                lo |= __shfl_xor(lo, 16); lo |= __shfl_xor(lo, 32);
                hi |= __shfl_xor(hi, 16); hi |= __shfl_xor(hi, 32);
                if (fq == 0) MASKB[(size_t)tq * 32 + kt] = ((unsigned long long)hi << 32) | lo;
            }
        }
        __syncthreads();
    }
}

__device__ __forceinline__ void a2_tile(const AttnLds& sm, const bf16x8 (&qf)[2], f32x4 (&O)[4], float& mrun, float& lrun, unsigned long long W, int fr, int fq) {
    f32x4 st[4];
    float mx = -1e30f;
    f32x4 rsv[4];
#pragma unroll
    for (int mk = 0; mk < 4; ++mk) {
        st[mk] = (f32x4){0.f, 0.f, 0.f, 0.f};
#pragma unroll
        for (int ks = 0; ks < 2; ++ks) {
            bf16x8 kf = *(const bf16x8*)(sm.K + (mk * 16 + fr) * LDT + ks * 32 + fq * 8);
            st[mk] = __builtin_amdgcn_mfma_f32_16x16x32_bf16(kf, qf[ks], st[mk], 0, 0, 0);
        }
        rsv[mk] = *(const f32x4*)(sm.rs + 16 * mk + 4 * fq);
        const unsigned nib = (unsigned)(W >> (16 * mk + 4 * fq)) & 0xfu;
#pragma unroll
        for (int r = 0; r < 4; ++r) {
            st[mk][r] *= rsv[mk][r];
            if ((nib >> r) & 1u) mx = fmaxf(mx, st[mk][r]);
        }
    }
    mx = xrow16_max(mx);
    const float mnew = fmaxf(mrun, mx);
    const float alpha = __expf(mrun - mnew);
    float ps = 0.f;
    float P[4][4];
#pragma unroll
    for (int mk = 0; mk < 4; ++mk) {
        const unsigned nib = (unsigned)(W >> (16 * mk + 4 * fq)) & 0xfu;
#pragma unroll
        for (int r = 0; r < 4; ++r) {
            const float pv = ((nib >> r) & 1u) ? __expf(st[mk][r] - mnew) : 0.f;
            ps += pv;
            P[mk][r] = pv * rsv[mk][r];
        }
    }
    ps = xrow16_sum(ps);
    lrun = lrun * alpha + ps;
    mrun = mnew;
#pragma unroll
    for (int me = 0; me < 4; ++me) O[me] *= alpha;
#pragma unroll
    for (int ks = 0; ks < 2; ++ks) {
        u32x4 uu = (u32x4){pack2(P[2 * ks][0], P[2 * ks][1]), pack2(P[2 * ks][2], P[2 * ks][3]),
                           pack2(P[2 * ks + 1][0], P[2 * ks + 1][1]), pack2(P[2 * ks + 1][2], P[2 * ks + 1][3])};
        bf16x8 pf = *(bf16x8*)&uu;
#pragma unroll
        for (int me = 0; me < 4; ++me) {
            const bf16_t* vp = sm.Vt + (me * 16 + fr) * LDT + ks * 32 + 4 * fq;
            u32x2 lo = *(const u32x2*)vp, hi = *(const u32x2*)(vp + 16);
            u32x4 vv = (u32x4){lo.x, lo.y, hi.x, hi.y};
            O[me] = __builtin_amdgcn_mfma_f32_16x16x32_bf16(*(bf16x8*)&vv, pf, O[me], 0, 0, 0);
        }
    }
}
__device__ __forceinline__ void ph_mix_a2(const Params& p, unsigned char* smem) {
    AttnLds& sm = *(AttnLds*)smem;
    const int tid = ltid(), lane = tid & 63, w = __builtin_amdgcn_readfirstlane(tid >> 6), fr = lane & 15, fq = lane >> 4;
    unsigned char* r1 = p.ws + OFF_R1;
    bf16_t* QA = (bf16_t*)(r1 + R1_QA);
    const bf16_t* KA = (const bf16_t*)(r1 + R1_KA);
    const bf16_t* VAT = (const bf16_t*)(r1 + R1_VAT);
    const float* CKVSS = (const float*)(p.ws + OFF_CKVSS);
    const unsigned long long* MASKB = (const unsigned long long*)(p.ws + OFF_MASKB);
    for (int item = blockIdx.x; item < 1024; item += gridDim.x) {
        const int c = 31 - (item >> 5), b = (item >> 2) & 7, h0 = (item & 3) * 2;
        const int tq = b * 2048 + c * 64 + 16 * w + fr;
        bf16x8 qf0[2], qf1[2];
#pragma unroll
        for (int ks = 0; ks < 2; ++ks) {
            qf0[ks] = *(const bf16x8*)(QA + (size_t)tq * 512 + h0 * 64 + ks * 32 + fq * 8);
            qf1[ks] = *(const bf16x8*)(QA + (size_t)tq * 512 + (h0 + 1) * 64 + ks * 32 + fq * 8);
        }
        f32x4 O0[4], O1[4];
#pragma unroll
        for (int me = 0; me < 4; ++me) { O0[me] = (f32x4){0.f, 0.f, 0.f, 0.f}; O1[me] = (f32x4){0.f, 0.f, 0.f, 0.f}; }
        float m0r = -1e30f, l0r = 0.f, m1r = -1e30f, l1r = 0.f;
        for (int kt = 0; kt <= c; ++kt) {
            __syncthreads();
            stage_tile64(sm.K, KA + (size_t)(b * 2048 + kt * 64) * 64, 64, tid);
            stage_tile64(sm.Vt, VAT + ((size_t)b * 64) * 2048 + kt * 64, 2048, tid);
            if (tid < 64) {
                const f32x4 s4 = *(const f32x4*)(CKVSS + (size_t)(b * 2048 + kt * 64 + tid) * 4);
                sm.rs[tid] = rsqrtf(((s4[0] + s4[1]) + (s4[2] + s4[3])) * (1.0f / 256.0f) + EPS_);
            }
            const unsigned long long W = MASKB[(size_t)tq * 32 + kt];
            __syncthreads();
            a2_tile(sm, qf0, O0, m0r, l0r, W, fr, fq);
            __builtin_amdgcn_sched_barrier(0);
            a2_tile(sm, qf1, O1, m1r, l1r, W, fr, fq);
        }
        const float inv0 = 1.0f / l0r, inv1 = 1.0f / l1r;
        const int ts = ltid();
        const int fqs = (ts & 63) >> 4;
        const int tqs = b * 2048 + c * 64 + 16 * (ts >> 6) + (ts & 15);
#pragma unroll
        for (int me = 0; me < 4; ++me) {
            u32x2 u; u.x = pack2(O0[me][0] * inv0, O0[me][1] * inv0); u.y = pack2(O0[me][2] * inv0, O0[me][3] * inv0);
            *(u32x2*)(QA + (size_t)tqs * 512 + h0 * 64 + me * 16 + 4 * fqs) = u;
            u32x2 v; v.x = pack2(O1[me][0] * inv1, O1[me][1] * inv1); v.y = pack2(O1[me][2] * inv1, O1[me][3] * inv1);
            *(u32x2*)(QA + (size_t)tqs * 512 + (h0 + 1) * 64 + me * 16 + 4 * fqs) = v;
        }
    }
}

__device__ __forceinline__ void ph_merge(const Params& p, unsigned char* smem) {
    bf16_t* sT = (bf16_t*)smem;
    const int tid = ltid(), lane = tid & 63, wid = __builtin_amdgcn_readfirstlane(tid >> 6), wr = wid >> 1, wc = wid & 1, fr = lane & 15, fq = lane >> 4;
    unsigned char* r1 = p.ws + OFF_R1;
    const bf16_t* WB = (const bf16_t*)(p.ws + OFF_WB);
    const bf16_t* GATES = (const bf16_t*)(r1 + R1_GATES);
    bf16_t* MG = (bf16_t*)(p.ws + OFF_H);
    const int xcd = blockIdx.x & 7, jb = blockIdx.x >> 3, nper = gridDim.x >> 3;
    for (int q = jb; q < 256; q += nper) {
        const int nt = q >> 4, mtl = q & 15;
        const int mt = 16 * xcd + mtl, m0 = mt * 128, n0 = nt * 64;
        f32x4 macc[4][2];
        zero_acc<2>(macc);
#pragma unroll 1
        for (int br = 0; br < 3; ++br) {
            const bf16_t* A = (const bf16_t*)(r1 + (br == 0 ? R1_QA : (br == 1 ? R1_QB : R1_GC)));
            const int K = (br == 2) ? 1024 : 512;
            const bf16_t* Bt = WB + (br == 0 ? WB_WOA : (br == 1 ? WB_WOB : WB_WOC));
            unsigned ao[4], bo[2];
#pragma unroll
            for (int i = 0; i < 4; ++i) ao[i] = (unsigned)(m0 + stg_row(tid, i, 4)) * (unsigned)K + stg_chunk(tid, i) * 8;
#pragma unroll
            for (int i = 0; i < 2; ++i) bo[i] = (unsigned)(n0 + stg_row(tid, i, 2)) * (unsigned)K + stg_chunk(tid, i) * 8;
            f32x4 acc[4][2];
            zero_acc<2>(acc);
            gemm_kloop2<2>(acc, A, ao, Bt, bo, K, smem, tid);
            {
                const int bb = m0 >> 11, s0 = (m0 & 2047) + wr * 64 + fq * 4;
#pragma unroll
                for (int n = 0; n < 2; ++n) {
                    const bf16_t* gp = GATES + ((size_t)bb * 3072 + br * 1024 + n0 + wc * 32 + n * 16 + fr) * 2048 + s0;
#pragma unroll
                    for (int m = 0; m < 4; ++m) {
                        const u32x2 gu = *(const u32x2*)(gp + m * 16);
                        macc[m][n][0] += __uint_as_float(gu.x << 16) * acc[m][n][0];
                        macc[m][n][1] += __uint_as_float(gu.x & 0xffff0000u) * acc[m][n][1];
                        macc[m][n][2] += __uint_as_float(gu.y << 16) * acc[m][n][2];
                        macc[m][n][3] += __uint_as_float(gu.y & 0xffff0000u) * acc[m][n][3];
                    }
                }
            }
        }
        __syncthreads();
        lds_put_tile<2>(sT, macc, wr, wc, fr, fq);
        __syncthreads();
#pragma unroll
        for (int i = 0; i < 4; ++i) {
            const int c = tid + 256 * i, row = c >> 3, ch = c & 7;
            *(u32x4*)(MG + (size_t)(m0 + row) * 1024 + n0 + ch * 8) = *(const u32x4*)(sT + row * LDE + ch * 8);
        }
    }
}

__device__ __forceinline__ void ph_outproj(const Params& p, unsigned char* smem) {
    bf16_t* sT = (bf16_t*)smem;
    const int tid = ltid(), lane = tid & 63, wid = __builtin_amdgcn_readfirstlane(tid >> 6), wr = wid >> 1, wc = wid & 1, fr = lane & 15, fq = lane >> 4;
    const bf16_t* MG = (const bf16_t*)(p.ws + OFF_H);
    const bf16_t* Bt = (const bf16_t*)(p.ws + OFF_WB) + WB_WOUT;
    bf16_t* Y = (bf16_t*)(p.ws + OFF_R1 + R1_QC);
    for (int tile = blockIdx.x; tile < 128 * 8; tile += gridDim.x) {
        const int mt = tile >> 3, nt = tile & 7, m0 = mt * 128, n0 = nt * 128;
        unsigned ao[4], bo[4];
#pragma unroll
        for (int i = 0; i < 4; ++i) {
            const int R = stg_row(tid, i, 4), g = stg_chunk(tid, i);
            ao[i] = (unsigned)(m0 + R) * 1024u + g * 8;
            bo[i] = (unsigned)(n0 + R) * 1024u + g * 8;
        }
        f32x4 acc[4][4];
        zero_acc<4>(acc);
        gemm_kloop2<4>(acc, MG, ao, Bt, bo, 1024, smem, tid);
        __syncthreads();
        lds_put_tile<4>(sT, acc, wr, wc, fr, fq);
        __syncthreads();
#pragma unroll
        for (int i = 0; i < 8; ++i) {
            const int c = tid + 256 * i, row = c >> 4, ch = c & 15;
            *(u32x4*)(Y + (size_t)(m0 + row) * 1024 + n0 + ch * 8) = *(const u32x4*)(sT + row * LDE + ch * 8);
        }
    }
}

__device__ __forceinline__ void ph_router(const Params& p, int l, unsigned char* smem) {
    const int tid = ltid(), lane = tid & 63, wid = __builtin_amdgcn_readfirstlane(tid >> 6), wr = wid >> 1, wc = wid & 1, fr = lane & 15, fq = lane >> 4;
    const bf16_t* H = (const bf16_t*)(p.ws + OFF_H);
    const bf16_t* Bt = (const bf16_t*)(p.ws + OFF_WB) + WB_WR;
    int* cnt = (int*)(p.ws + OFF_CTL) + l * 64;
    int* LIST = (int*)(p.ws + OFF_LIST);
    float* AW = (float*)(p.ws + OFF_AW);
    const float* bias = p.router_bias + l * 64;
    float* lg = (float*)smem;
    for (int mt = blockIdx.x; mt < 128; mt += gridDim.x) {
        const int m0 = mt * 128;
        unsigned ao[4], bo[4];
#pragma unroll
        for (int i = 0; i < 4; ++i) {
            const int R = stg_row(tid, i, 4), g = stg_chunk(tid, i);
            ao[i] = (unsigned)(m0 + R) * 1024u + g * 8;
            bo[i] = (unsigned)R * 1024u + g * 8;
        }
        f32x4 acc[4][4];
        zero_acc<4>(acc);
        gemm_kloop2<4>(acc, H, ao, Bt, bo, 1024, smem, tid);
        __syncthreads();
        if (wc == 0) {
#pragma unroll
            for (int m = 0; m < 4; ++m)
#pragma unroll
                for (int j = 0; j < 4; ++j)
#pragma unroll
                    for (int n = 0; n < 4; ++n) lg[(wr * 64 + m * 16 + fq * 4 + j) * 65 + n * 16 + fr] = acc[m][n][j];
        }
        __syncthreads();
        if (tid < 128) {
            float* row = lg + tid * 65;
            const int t = m0 + tid;
            float gs[8];
#pragma unroll
            for (int g = 0; g < 8; ++g) {
                float m1 = -__builtin_inff(), m2 = -__builtin_inff();
#pragma unroll
                for (int e = 0; e < 8; ++e) {
                    const float v = sigmoidf_(row[g * 8 + e]) + bias[g * 8 + e];
                    row[g * 8 + e] = v;
                    if (v > m1) { m2 = m1; m1 = v; } else if (v > m2) m2 = v;
                }
                gs[g] = m1 + m2;
            }
            unsigned gmask = 0u;
#pragma unroll
            for (int g = 0; g < 8; ++g) {
                int rank = 0;
#pragma unroll
                for (int g2 = 0; g2 < 8; ++g2) rank += (gs[g2] > gs[g] || (gs[g2] == gs[g] && g2 < g)) ? 1 : 0;
                if (rank < 4) gmask |= 1u << g;
            }
            unsigned long long taken = 0ull;
            int eidx[8]; float esc[8];
            float ssum = 0.f;
#pragma unroll
            for (int k = 0; k < 8; ++k) {
                float best = -__builtin_inff(); int bi = 0;
                for (int e = 0; e < 64; ++e) {
                    if (!((gmask >> (e >> 3)) & 1u) || ((taken >> e) & 1ull)) continue;
                    const float v = row[e];
                    if (v > best) { best = v; bi = e; }
                }
                taken |= 1ull << bi;
                eidx[k] = bi;
                esc[k] = best - bias[bi];
                ssum += esc[k];
            }
            const float scale = 2.5f / ssum;
            int slot[8];
#pragma unroll
            for (int k = 0; k < 8; ++k) slot[k] = atomicAdd(&cnt[eidx[k]], 1);
#pragma unroll
            for (int k = 0; k < 8; ++k) {
                LIST[(size_t)eidx[k] * T_ + slot[k]] = t * 8 + k;
                AW[(size_t)t * 8 + k] = esc[k] * scale;
            }
        }
        __syncthreads();
    }
}

struct __attribute__((aligned(16))) MoeLds { int tstart[66]; int xs[10]; int pad0[20]; int hbase[66]; int pad1[14]; int rowid[128]; };
__device__ __forceinline__ void moe_setup(MoeLds& sm, const int* cnt, int tid) {
    __syncthreads();
    if (tid == 0) {
        int ts = 0, hb = 0;
        for (int e = 0; e < 65; ++e) {
            const int ce = (e < 64) ? cnt[e] : T_;
            sm.tstart[e] = ts; sm.hbase[e] = hb;
            ts += (ce + 127) >> 7; hb += ce;
        }
        sm.tstart[65] = ts; sm.hbase[65] = hb;
        const int xcd = blockIdx.x & 7;
        int acc = 0;
        for (int k = 0; k < 8; ++k) { sm.xs[k] = acc; acc += sm.tstart[k * 8 + xcd + 1] - sm.tstart[k * 8 + xcd]; }
        sm.xs[8] = acc; acc += 16; sm.xs[9] = acc;
    }
    __syncthreads();
}

__device__ __forceinline__ void ph_moe1(const Params& p, int l, unsigned char* smem) {
    MoeLds& sm = *(MoeLds*)(smem + MISC + 64);
    const int tid = ltid(), lane = tid & 63, wid = __builtin_amdgcn_readfirstlane(tid >> 6), wr = wid >> 1, wc = wid & 1, fr = lane & 15, fq = lane >> 4;
    const bf16_t* H = (const bf16_t*)(p.ws + OFF_H);
    const bf16_t* W13 = (const bf16_t*)(p.ws + OFF_WB) + WB_W13;
    const int* cnt = (const int*)(p.ws + OFF_CTL) + l * 64;
    const int* LIST = (const int*)(p.ws + OFF_LIST);
    bf16_t* HID = (bf16_t*)(p.ws + OFF_R3);
    moe_setup(sm, cnt, tid);
    const int xcd = blockIdx.x & 7, jb = blockIdx.x >> 3, nper = gridDim.x >> 3;
    const int nitems = sm.xs[9] * 4;
    for (int item = jb; item < nitems; item += nper) {
        const int rtl = item >> 2, nt = item & 3;
        int k = 0;
        while (sm.xs[k + 1] <= rtl) ++k;
        const int e = (k < 8) ? (k * 8 + xcd) : 64;
        const int mtl = rtl - sm.xs[k] + ((k == 8) ? 16 * xcd : 0);
        const int ce = (e < 64) ? cnt[e] : T_;
        __syncthreads();
        if (tid < 128) {
            const int slot = mtl * 128 + tid;
            int tok = 0;
            if (slot < ce) tok = (e < 64) ? (LIST[(size_t)e * T_ + slot] >> 3) : slot;
            sm.rowid[tid] = tok;
        }
        __syncthreads();
        unsigned ao[4], bo[4];
#pragma unroll
        for (int i = 0; i < 4; ++i) {
            const int R = stg_row(tid, i, 4), g = stg_chunk(tid, i);
            ao[i] = (unsigned)sm.rowid[R] * 1024u + g * 8;
            bo[i] = (unsigned)(e * 512 + nt * 128 + R) * 1024u + g * 8;
        }
        f32x4 acc[4][4];
        zero_acc<4>(acc);
        gemm_kloop2<4>(acc, H, ao, W13, bo, 1024, smem, tid);
        const int hb = sm.hbase[e] + mtl * 128;
        f32x4 hacc[4][2];
#pragma unroll
        for (int m = 0; m < 4; ++m)
#pragma unroll
            for (int nn = 0; nn < 2; ++nn)
#pragma unroll
                for (int j = 0; j < 4; ++j) hacc[m][nn][j] = siluf_(acc[m][nn][j]) * acc[m][nn + 2][j];
        bf16_t* sT = (bf16_t*)smem;
        __syncthreads();
        lds_put_tile<2>(sT, hacc, wr, wc, fr, fq);
        __syncthreads();
        const int ts = ltid();
#pragma unroll
        for (int i = 0; i < 4; ++i) {
            const int c = ts + 256 * i, row = c >> 3, ch = c & 7;
            if (mtl * 128 + row < ce)
                *(u32x4*)(HID + (size_t)(hb + row) * 256 + nt * 64 + ch * 8) = *(const u32x4*)(sT + row * LDE + ch * 8);
        }
    }
}

__device__ __forceinline__ void ph_moe2(const Params& p, int l, unsigned char* smem) {
    MoeLds& sm = *(MoeLds*)(smem + MISC + 64);
    const int tid = ltid(), lane = tid & 63, wid = __builtin_amdgcn_readfirstlane(tid >> 6), wr = wid >> 1, wc = wid & 1, fr = lane & 15, fq = lane >> 4;
    const bf16_t* W2 = (const bf16_t*)(p.ws + OFF_WB) + WB_W2;
    const int* cnt = (const int*)(p.ws + OFF_CTL) + l * 64;
    const int* LIST = (const int*)(p.ws + OFF_LIST);
    const float* AW = (const float*)(p.ws + OFF_AW);
    const bf16_t* HID = (const bf16_t*)(p.ws + OFF_R3);
    bf16_t* SLOTS = (bf16_t*)(p.ws + OFF_R1);
    moe_setup(sm, cnt, tid);
    const int xcd = blockIdx.x & 7, jb = blockIdx.x >> 3, nper = gridDim.x >> 3;
    const int nitems = sm.xs[9] * 8;
    for (int item = jb; item < nitems; item += nper) {
        const int rtl = item >> 3, nt = item & 7;
        int k = 0;
        while (sm.xs[k + 1] <= rtl) ++k;
        const int e = (k < 8) ? (k * 8 + xcd) : 64;
        const int mtl = rtl - sm.xs[k] + ((k == 8) ? 16 * xcd : 0);
        const int ce = (e < 64) ? cnt[e] : T_;
        __syncthreads();
        if (tid < 128) {
            const int slot = mtl * 128 + tid;
            int aid = -1;
            if (slot < ce) aid = (e < 64) ? LIST[(size_t)e * T_ + slot] : (8 * T_ + slot);
            sm.rowid[tid] = aid;
        }
        __syncthreads();
        const int hb = sm.hbase[e] + mtl * 128;
        unsigned ao[4], bo[4];
#pragma unroll
        for (int i = 0; i < 4; ++i) {
            const int R = stg_row(tid, i, 4), g = stg_chunk(tid, i);
            ao[i] = (unsigned)(hb + R) * 256u + g * 8;
            bo[i] = (unsigned)(e * 1024 + nt * 128 + R) * 256u + g * 8;
        }
        f32x4 acc[4][4];
        zero_acc<4>(acc);
        gemm_kloop2<4>(acc, HID, ao, W2, bo, 256, smem, tid);
        const int ts = ltid();
        const int fqs = (ts & 63) >> 4;
#pragma unroll
        for (int m = 0; m < 4; ++m)
#pragma unroll
            for (int j = 0; j < 4; ++j) {
                const int r = wr * 64 + m * 16 + fqs * 4 + j;
                const int aid = sm.rowid[r];
                const float wt = (aid >= 0 && e < 64) ? AW[aid] : 1.0f;
#pragma unroll
                for (int n = 0; n < 4; ++n) acc[m][n][j] *= wt;
            }
        bf16_t* sT = (bf16_t*)smem;
        __syncthreads();
        lds_put_tile<4>(sT, acc, wr, wc, fr, fq);
        __syncthreads();
#pragma unroll
        for (int i = 0; i < 8; ++i) {
            const int c = ts + 256 * i, row = c >> 4, ch = c & 15;
            const int aid = sm.rowid[row];
            if (aid >= 0)
                __builtin_nontemporal_store(*(const u32x4*)(sT + row * LDE + ch * 8), (u32x4*)(SLOTS + (size_t)aid * 1024 + nt * 128 + ch * 8));
        }
    }
}

struct JobDesc { int K, NQ, src_ld, dst_ld, mode, p0, nbatch, which; unsigned src_lstride, src_bs, dst_bs, dst_off; };
constexpr int NJOBS = 12;
__constant__ JobDesc JOBS[NJOBS] = {
    {1024, 8832, NIN_, 1024, 1, 0, 1, 9, 1024u * NIN_, 0u, 0u, (unsigned)WB_WIN},
    {512, 1024, 1024, 512, 0, 0, 1, 14, 512u * 1024u, 0u, 0u, (unsigned)WB_WOA},
    {512, 1024, 1024, 512, 0, 0, 1, 15, 512u * 1024u, 0u, 0u, (unsigned)WB_WOB},
    {1024, 1024, 1024, 1024, 0, 0, 1, 16, 1024u * 1024u, 0u, 0u, (unsigned)WB_WOC},
    {1024, 1024, 1024, 1024, 0, 0, 1, 17, 1024u * 1024u, 0u, 0u, (unsigned)WB_WOUT},
    {1024, 128, 64, 1024, 3, 0, 1, 18, 1024u * 64u, 0u, 0u, (unsigned)WB_WR},
    {1024, 256, 256, 1024, 2, 0, 64, 20, 64u * 1024u * 256u, 1024u * 256u, 512u * 1024u, (unsigned)WB_W13},
    {1024, 256, 256, 1024, 2, 32, 64, 21, 64u * 1024u * 256u, 1024u * 256u, 512u * 1024u, (unsigned)WB_W13},
    {1024, 256, 256, 1024, 2, 0, 1, 23, 1024u * 256u, 0u, 0u, (unsigned)(WB_W13 + (size_t)64 * 512 * 1024)},
    {1024, 256, 256, 1024, 2, 32, 1, 24, 1024u * 256u, 0u, 0u, (unsigned)(WB_W13 + (size_t)64 * 512 * 1024)},
    {256, 1024, 1024, 256, 0, 0, 64, 22, 64u * 256u * 1024u, 256u * 1024u, 1024u * 256u, (unsigned)WB_W2},
    {256, 1024, 1024, 256, 0, 0, 1, 25, 256u * 1024u, 0u, 0u, (unsigned)(WB_W2 + (size_t)64 * 1024 * 256)},
};
__constant__ int JOBPRE[NJOBS + 1] = {0, 2208, 2336, 2464, 2720, 2976, 3008, 7104, 11200, 11264, 11328, 15424, 15488};
__device__ __forceinline__ TJob make_job(const Params& p, int l, int it, int& base) {
    int j = 0;
    while (JOBPRE[j + 1] <= it) ++j;
    const JobDesc d = JOBS[j];
    TJob tj;
    tj.src = ((const float* const*)&p)[d.which] + (size_t)l * d.src_lstride;
    tj.dst = (bf16_t*)(p.ws + OFF_WB) + d.dst_off;
    tj.K = d.K; tj.NQ = d.NQ; tj.src_ld = d.src_ld; tj.dst_ld = d.dst_ld; tj.mode = d.mode; tj.p0 = d.p0; tj.nbatch = d.nbatch; tj.pad = 0;
    tj.src_bs = d.src_bs; tj.dst_bs = d.dst_bs;
    base = JOBPRE[j];
    return tj;
}
__device__ __forceinline__ void tconv_range(const Params& p, int l, unsigned char* smem, int first, int stride, int it0, int it1) {
    float* tile = (float*)smem;
    const int tid = ltid();
    const int total = it1;
    __syncthreads();
    int it = it0 + first;
    f32x4 r[4];
    if (it < total) { int base; const TJob tj = make_job(p, l, it, base); tconv_load(tj, it - base, tid, r); }
    while (it < total) {
        const int nxt = it + stride;
        tconv_put(tid, r, tile);
        __syncthreads();
        if (nxt < total) { int base; const TJob tj = make_job(p, l, nxt, base); tconv_load(tj, nxt - base, tid, r); }
        { int base; const TJob tj = make_job(p, l, it, base); tconv_emit(tj, it - base, tid, tile); }
        __syncthreads();
        it = nxt;
    }
}

constexpr int TC_MIX_END = 3008;
__device__ __forceinline__ void ph_tconv_mix(const Params& p, int l, unsigned char* smem) { tconv_range(p, l, smem, blockIdx.x, gridDim.x, 0, TC_MIX_END); }
constexpr int SMEM_BYTES = DYN_LDS;
__device__ __forceinline__ int next_item(int* ctr, unsigned char* smem) {
    int* s_item = (int*)(smem + MISC);
    __syncthreads();
    if (ltid() == 0) *s_item = atomicAdd(ctr, 1);
    __syncthreads();
    return *s_item;
}
__device__ __forceinline__ void ph_mix1(const Params& p, int l, unsigned char* smem) {
    int* ctr = (int*)(p.ws + OFF_CTL) + 256 + l * 4;
    const bool tc_first = (int)blockIdx.x >= (int)(gridDim.x >> 1);
    if (tc_first)
        for (;;) { const int it = next_item(ctr + 3, smem); if (it >= 390) break;
            const int a0 = TC_MIX_END + it * 32; tconv_range(p, l, smem, 0, 1, a0, (a0 + 32 < JOBPRE[NJOBS]) ? a0 + 32 : JOBPRE[NJOBS]); }
    for (;;) { const int it = next_item(ctr + 0, smem); if (it >= 2048) break; mixc1_item(p, it, smem); }
    for (;;) { const int it = next_item(ctr + 1, smem); if (it >= 1024) break; mixb_item(p, it, smem); }
    for (;;) { const int it = next_item(ctr + 2, smem); if (it >= 1024) break; mixa1_item(p, it, smem); }
    if (!tc_first)
        for (;;) { const int it = next_item(ctr + 3, smem); if (it >= 390) break;
            const int a0 = TC_MIX_END + it * 32; tconv_range(p, l, smem, 0, 1, a0, (a0 + 32 < JOBPRE[NJOBS]) ? a0 + 32 : JOBPRE[NJOBS]); }
}


constexpr size_t OFF_BAR = 16 * KiB;
#define XB_TMO      128
#define XB_XCNT(j)  (256  + 64 * (j))
#define XB_XSUB(j)  (1280 + 64 * (j))
#define XB_XGEN(j)  (2304 + 64 * (j))
#define XB_TOP      3328
#define XB_TOPGEN   3392
#define XCD_BAR_WORDS 3456
#define XB_SPIN_CAP (1u << 18)
__device__ __forceinline__ unsigned xb_ld(unsigned* p)              { return __hip_atomic_load(p, __ATOMIC_RELAXED, __HIP_MEMORY_SCOPE_AGENT); }
__device__ __forceinline__ unsigned xb_add(unsigned* p, unsigned v) { return __hip_atomic_fetch_add(p, v, __ATOMIC_RELAXED, __HIP_MEMORY_SCOPE_AGENT); }
__device__ __forceinline__ unsigned xb_xcc_id() { return (unsigned)__builtin_amdgcn_s_getreg((3 << 11) | 20) & 0xFu; }
#define XB_SPIN(cond, bar) do { unsigned _sp = 0; while (cond) { __builtin_amdgcn_s_sleep(1); \
    if ((++_sp & 255u) == 0u) { if (xb_ld(&(bar)[XB_TMO])) break; if (_sp > XB_SPIN_CAP) { atomicAdd(&(bar)[XB_TMO], 1u); break; } } } } while (0)
__device__ __forceinline__ void xcd_barrier_post(unsigned* bar) {
    if (threadIdx.x == 0) (void)xb_add(&bar[XB_XCNT(xb_xcc_id())], 1u);
}
__device__ __forceinline__ void xcd_barrier_complete(unsigned* bar, unsigned x, unsigned& nloc, unsigned& nx) {
    const unsigned G = gridDim.x * gridDim.y * gridDim.z;
    unsigned sum, cnt, mine, sp = 0u;
    for (;;) {
        sum = 0u; cnt = 0u; mine = 0u;
#pragma unroll
        for (unsigned j = 0; j < 16; ++j) { const unsigned c = xb_ld(&bar[XB_XCNT(j)]); sum += c; cnt += (c > 0u) ? 1u : 0u; mine = (j == x) ? c : mine; }
        if (sum == G) break;
        __builtin_amdgcn_s_sleep(1);
        if ((++sp & 255u) == 0u) { if (xb_ld(&bar[XB_TMO])) break; if (sp > XB_SPIN_CAP) { atomicAdd(&bar[XB_TMO], 1u); break; } }
    }
    nloc = mine > 0u ? mine : 1u; nx = cnt > 0u ? cnt : 1u;
}
__device__ __forceinline__ void xcd_barrier(unsigned* bar, volatile LAS unsigned* st) {
    asm volatile("s_waitcnt vmcnt(0)" ::: "memory");
    __syncthreads();
    if (threadIdx.x == 0) {
        const unsigned x = xb_xcc_id();
        __builtin_amdgcn_s_waitcnt(0);
        unsigned nloc = st[0], nx = st[1];
        if (nloc == 0u) { xcd_barrier_complete(bar, x, nloc, nx); st[0] = nloc; st[1] = nx; }
        const unsigned old = xb_add(&bar[XB_XSUB(x)], 1u);
        const unsigned gen = old / nloc;
        if (old + 1u == (gen + 1u) * nloc) {
            __builtin_amdgcn_fence(__ATOMIC_RELEASE, "agent");
            asm volatile("s_waitcnt vmcnt(0)" ::: "memory");
            const unsigned og = xb_add(&bar[XB_TOP], 1u);
            const unsigned tg = og / nx;
            if (og + 1u == (tg + 1u) * nx) xb_add(&bar[XB_TOPGEN], 1u);
            else XB_SPIN(xb_ld(&bar[XB_TOPGEN]) == tg, bar);
            __builtin_amdgcn_fence(__ATOMIC_ACQUIRE, "agent");
            xb_add(&bar[XB_XGEN(x)], 1u);
            asm volatile("s_waitcnt vmcnt(0)" ::: "memory");
        } else {
            XB_SPIN(xb_ld(&bar[XB_XGEN(x)]) == gen, bar);
            __builtin_amdgcn_fence(__ATOMIC_ACQUIRE, "agent");
            asm volatile("s_waitcnt vmcnt(0)" ::: "memory");
        }
    }
    __syncthreads();
}

#define LAUNDER()
__global__ void __launch_bounds__(256, 3) mega(Params p_unused) {
    extern __shared__ __attribute__((aligned(16))) unsigned char smem[];
    if (threadIdx.x == 0) *(u32x4*)(smem + MISC + 16) = (u32x4){0u, 0u, 0u, 0u};
    __syncthreads();
    xcd_barrier_post((unsigned*)(getp().ws + OFF_BAR));
#define GSYNC() xcd_barrier((unsigned*)(getp().ws + OFF_BAR), (volatile LAS unsigned*)(smem + MISC + 16))

    ph_rope(getp());
    ph_mod(getp(), smem);
    ph_tconv_mix(getp(), 0, smem);
    ph_wcomp(getp(), 0, smem);
    GSYNC();
    {
        const Params& p = getp();
        const float* mod = (const float*)(p.ws + OFF_MOD);
        NormArgs a;
        a.xin = p.x; a.Y = nullptr; a.slots = nullptr; a.gpost = nullptr; a.gt = nullptr;
        a.mode = 0; a.gpre = p.g_pre_mix; a.sc = mod + 1024; a.sh = mod + 0;
        ph_norm(p, a);
    }
    GSYNC();
#pragma unroll 1
    for (int l = 0; l < DEPTH_; ++l) {
        ph_gemm_z(getp(), smem);
        GSYNC();
        ph_mix1(getp(), l, smem);
        GSYNC();
        ph_mixc2(getp());
        ph_mix_a2(getp(), smem);
        GSYNC();
        { const Params& p = getp(); for (int it = blockIdx.x; it < 2048; it += gridDim.x) mixc3_item(p, l, it, smem); }
        GSYNC();
        ph_merge(getp(), smem);
        GSYNC();
        ph_outproj(getp(), smem);
        GSYNC();
        {
            const Params& p = getp();
        const float* mod = (const float*)(p.ws + OFF_MOD);
        NormArgs a;
            a.xin = nullptr; a.slots = nullptr;
            a.mode = 1; a.Y = (const bf16_t*)(p.ws + OFF_R1 + R1_QC);
            a.gpost = p.g_post_mix + l * 1024; a.gt = mod + (size_t)l * 8 * 6144 + 2048;
            a.gpre = p.g_pre_ffn + l * 1024; a.sc = mod + (size_t)l * 8 * 6144 + 4096; a.sh = mod + (size_t)l * 8 * 6144 + 3072;
            ph_norm(p, a);
        }
        GSYNC();
        ph_router(getp(), l, smem);
        GSYNC();
        ph_moe1(getp(), l, smem);
        GSYNC();
        ph_moe2(getp(), l, smem);
        GSYNC();
        {
            const Params& p = getp();
        const float* mod = (const float*)(p.ws + OFF_MOD);
        NormArgs a;
            a.xin = nullptr; a.Y = nullptr;
            a.mode = 2; a.slots = (const bf16_t*)(p.ws + OFF_R1);
            a.gpost = p.g_post_ffn + l * 1024; a.gt = mod + (size_t)l * 8 * 6144 + 5120;
            a.gpre = nullptr; a.sc = nullptr; a.sh = nullptr;
            if (l + 1 < DEPTH_) { a.gpre = p.g_pre_mix + (l + 1) * 1024; a.sc = mod + (size_t)(l + 1) * 8 * 6144 + 1024; a.sh = mod + (size_t)(l + 1) * 8 * 6144 + 0; }
            ph_norm(p, a);
        }
        if (l + 1 < DEPTH_) {
            ph_tconv_mix(getp(), l + 1, smem);
            ph_wcomp(getp(), l + 1, smem);
            GSYNC();
        }
    }
}

extern "C" void kernel_launch(void* const* d_in, const int* in_sizes, int n_in, void* d_out, int out_size, void* d_ws, size_t ws_size, hipStream_t stream) {
    if (n_in < 26 || ws_size < WS_TOTAL) { fprintf(stderr, "kernel_launch: bad inputs / workspace too small (%zu < %zu)\n", ws_size, (size_t)WS_TOTAL); return; }
    Params p;
    memset(&p, 0, sizeof(p));
    p.x = (const float*)d_in[0]; p.c = (const float*)d_in[1]; p.positions = (const int*)d_in[2]; p.ada_w = (const float*)d_in[3]; p.ada_b = (const float*)d_in[4];
    p.g_pre_mix = (const float*)d_in[5]; p.g_post_mix = (const float*)d_in[6]; p.g_pre_ffn = (const float*)d_in[7]; p.g_post_ffn = (const float*)d_in[8];
    p.w_in = (const float*)d_in[9]; p.g_kv = (const float*)d_in[10]; p.w_uk = (const float*)d_in[11]; p.w_uv = (const float*)d_in[12]; p.g_ret = (const float*)d_in[13];
    p.w_o_a = (const float*)d_in[14]; p.w_o_b = (const float*)d_in[15]; p.w_o_c = (const float*)d_in[16]; p.w_out = (const float*)d_in[17];
    p.w_router = (const float*)d_in[18]; p.router_bias = (const float*)d_in[19]; p.w1 = (const float*)d_in[20]; p.w3 = (const float*)d_in[21]; p.w2 = (const float*)d_in[22];
    p.ws1 = (const float*)d_in[23]; p.ws3 = (const float*)d_in[24]; p.ws2 = (const float*)d_in[25];
    p.out = (float*)d_out; p.ws = (unsigned char*)d_ws;
    static int grid_blocks = 0;
    if (!grid_blocks) {
        int dev = 0, cus = 0, per_cu = 0;
        (void)hipGetDevice(&dev);
        (void)hipDeviceGetAttribute(&cus, hipDeviceAttributeMultiprocessorCount, dev);
        (void)hipFuncSetAttribute((const void*)mega, hipFuncAttributeMaxDynamicSharedMemorySize, DYN_LDS);
        (void)hipOccupancyMaxActiveBlocksPerMultiprocessor(&per_cu, mega, 256, DYN_LDS);
        if (per_cu < 1) per_cu = 1;
        if (per_cu > 3) per_cu = 3;
        grid_blocks = cus * per_cu;
    }
    (void)hipMemsetAsync((unsigned char*)d_ws + OFF_CTL, 0, 32 * 1024, stream);
    void* args[] = {&p};
    hipError_t e = hipLaunchCooperativeKernel((void*)mega, dim3(grid_blocks), dim3(256), args, DYN_LDS, stream);
    if (e != hipSuccess) fprintf(stderr, "cooperative launch failed: %s (grid %d)\n", hipGetErrorString(e), grid_blocks);
}
```

```cpp
#include <hip/hip_runtime.h>
#include <hip/hip_cooperative_groups.h>
namespace cg = cooperative_groups;
#include <stdint.h>
#include <stdio.h>
#include <string.h>

typedef unsigned short bf16_t;
typedef short bf16x8 __attribute__((ext_vector_type(8)));
typedef short bf16x4 __attribute__((ext_vector_type(4)));
typedef float f32x4 __attribute__((ext_vector_type(4)));
typedef float f32x2 __attribute__((ext_vector_type(2)));
typedef unsigned u32x4 __attribute__((ext_vector_type(4)));
typedef unsigned u32x2 __attribute__((ext_vector_type(2)));

constexpr int T_ = 16384, S_ = 2048, NB_ = 8, D_ = 1024, DEPTH_ = 2;
constexpr int NIN_ = 8772;
constexpr int NZ_ = 8960;
constexpr float EPS_ = 1e-6f;

constexpr int C_QA = 0, C_CKV = 512, C_IQ = 768, C_IK = 1024, C_IW = 1088, C_QB = 1152, C_KB = 1664, C_VB = 2176,
              C_QC = 2688, C_KC = 3200, C_VC = 3712, C_GC = 4736, C_GATES = 5760, C_KA = 8832, C_VA = 8896;

constexpr size_t KiB = 1024, MiB = 1024 * 1024;
constexpr size_t OFF_CTL = 0;
constexpr size_t OFF_MOD = 64 * KiB;
constexpr size_t OFF_IW = 512 * KiB;
constexpr size_t OFF_CKVSS = 768 * KiB;
constexpr size_t OFF_AW = 1 * MiB;
constexpr size_t OFF_ROPE = 2 * MiB;
constexpr size_t OFF_LIST = 6 * MiB;
constexpr size_t OFF_MASKB = 10 * MiB;
constexpr size_t OFF_WB = 14 * MiB;
constexpr size_t WB_WIN = 0;
constexpr size_t WB_WOA = WB_WIN + (size_t)NZ_ * 1024;
constexpr size_t WB_WOB = WB_WOA + 1024 * 512;
constexpr size_t WB_WOC = WB_WOB + 1024 * 512;
constexpr size_t WB_WOUT = WB_WOC + 1024 * 1024;
constexpr size_t WB_WR = WB_WOUT + 1024 * 1024;
constexpr size_t WB_W13 = WB_WR + 128 * 1024;
constexpr size_t WB_W2 = WB_W13 + (size_t)65 * 512 * 1024;
constexpr size_t WB_END = WB_W2 + (size_t)65 * 1024 * 256;
constexpr size_t OFF_H = OFF_WB + ((WB_END * 2 + MiB - 1) / MiB) * MiB;
constexpr size_t OFF_R1 = OFF_H + 32 * MiB;
constexpr size_t R1_QA = 0;
constexpr size_t R1_IQ = R1_QA + 16 * MiB;
constexpr size_t R1_IK = R1_IQ + 8 * MiB;
constexpr size_t R1_KA = R1_IK + 2 * MiB;
constexpr size_t R1_VAT = R1_KA + 2 * MiB;
constexpr size_t R1_QB = R1_VAT + 2 * MiB;
constexpr size_t R1_KB = R1_QB + 16 * MiB;
constexpr size_t R1_VBT = R1_KB + 16 * MiB;
constexpr size_t R1_QC = R1_VBT + 16 * MiB;
constexpr size_t R1_KC = R1_QC + 16 * MiB;
constexpr size_t R1_KCT = R1_KC + 16 * MiB;
constexpr size_t R1_VCT = R1_KCT + 16 * MiB;
constexpr size_t R1_GC = R1_VCT + 32 * MiB;
constexpr size_t R1_GATES = R1_GC + 32 * MiB;
constexpr size_t R1_ZEND = R1_GATES + 96 * MiB;
constexpr size_t R1_SIZE = 288 * MiB;
constexpr size_t OFF_R3 = OFF_R1 + R1_SIZE;
constexpr size_t R3_SIZE = 78 * MiB;
constexpr size_t WS_TOTAL = OFF_R3 + R3_SIZE;
static_assert(R1_ZEND <= R1_SIZE, "r1");
constexpr size_t SC_PER_BATCH = 2162688;

__constant__ float INVF[32] = {
    1.000000000e+00f, 7.498942614e-01f, 5.623413324e-01f, 4.216965139e-01f, 3.162277639e-01f, 2.371373773e-01f, 1.778279394e-01f, 1.333521307e-01f,
    1.000000015e-01f, 7.498941571e-02f, 5.623413250e-02f, 4.216965288e-02f, 3.162277490e-02f, 2.371373773e-02f, 1.778279431e-02f, 1.333521493e-02f,
    9.999999776e-03f, 7.498941850e-03f, 5.623413250e-03f, 4.216964822e-03f, 3.162277630e-03f, 2.371373586e-03f, 1.778279431e-03f, 1.333521446e-03f,
    1.000000047e-03f, 7.498942432e-04f, 5.623413017e-04f, 4.216965172e-04f, 3.162277571e-04f, 2.371373703e-04f, 1.778279402e-04f, 1.333521504e-04f};

__constant__ float LOGG[8] = {-0.0317486983145803f, -0.015748356968139168f, -0.007843177461025893f, -0.003913899321136329f,
                               -0.0019550348358033506f, -0.0009770396478266127f, -0.0004884004981088745f, -0.0002441704321739145f};

__device__ __forceinline__ float bf2f(bf16_t u) { return __uint_as_float(((unsigned)u) << 16); }
__device__ __forceinline__ bf16_t f2bf(float f) {
    unsigned u = __float_as_uint(f);
    u += 0x7fffu + ((u >> 16) & 1u);
    return (bf16_t)(u >> 16);
}
__device__ __forceinline__ unsigned pack2(float a, float b) { return (unsigned)f2bf(a) | ((unsigned)f2bf(b) << 16); }
__device__ __forceinline__ float sigmoidf_(float x) { return __builtin_amdgcn_rcpf(1.0f + __expf(-x)); }
__device__ __forceinline__ float siluf_(float x) { return x * __builtin_amdgcn_rcpf(1.0f + __expf(-x)); }
__device__ __forceinline__ float wave_sum(float v) {
#pragma unroll
    for (int o = 32; o >= 1; o >>= 1) v += __shfl_xor(v, o);
    return v;
}
__device__ __forceinline__ int wave_sum_i(int v) {
#pragma unroll
    for (int o = 32; o >= 1; o >>= 1) v += __shfl_xor(v, o);
    return v;
}

struct Params {
    const float* x; const float* c; const int* positions; const float* ada_w; const float* ada_b;
    const float* g_pre_mix; const float* g_post_mix; const float* g_pre_ffn; const float* g_post_ffn;
    const float* w_in; const float* g_kv; const float* w_uk; const float* w_uv; const float* g_ret;
    const float* w_o_a; const float* w_o_b; const float* w_o_c; const float* w_out;
    const float* w_router; const float* router_bias; const float* w1; const float* w3; const float* w2;
    const float* ws1; const float* ws3; const float* ws2;
    float* out;
    unsigned char* ws;
};

__device__ __forceinline__ int cnt_ge(int cnt, unsigned key, unsigned cand) {
    asm volatile("v_cmp_ge_u32 vcc, %1, %2\n\tv_addc_co_u32 %0, vcc, 0, %0, vcc" : "+v"(cnt) : "v"(key), "v"(cand) : "vcc");
    return cnt;
}
__device__ __forceinline__ int cnt_ge_s(int cnt, unsigned key, unsigned cand) {
    asm volatile("v_cmp_ge_u32 vcc, %1, %2\n\ts_bcnt1_i32_b64 vcc_lo, vcc\n\ts_add_i32 %0, %0, vcc_lo" : "+s"(cnt) : "v"(key), "v"(cand) : "vcc", "scc");
    return cnt;
}
__device__ __forceinline__ int wave_total6(int c) {
    int t = 0;
#pragma unroll
    for (int b = 0; b < 6; ++b) t += __builtin_popcountll(__ballot((c >> b) & 1)) << b;
    return t;
}
__device__ __forceinline__ float xrow16_max(float x) {
    auto s = __builtin_amdgcn_permlane16_swap(__float_as_uint(x), __float_as_uint(x), false, false);
    x = fmaxf(__uint_as_float(s[0]), __uint_as_float(s[1]));
    auto t = __builtin_amdgcn_permlane32_swap(__float_as_uint(x), __float_as_uint(x), false, false);
    return fmaxf(__uint_as_float(t[0]), __uint_as_float(t[1]));
}
__device__ __forceinline__ float xrow16_sum(float x) {
    auto s = __builtin_amdgcn_permlane16_swap(__float_as_uint(x), __float_as_uint(x), false, false);
    x = __uint_as_float(s[0]) + __uint_as_float(s[1]);
    auto t = __builtin_amdgcn_permlane32_swap(__float_as_uint(x), __float_as_uint(x), false, false);
    return __uint_as_float(t[0]) + __uint_as_float(t[1]);
}
__device__ __forceinline__ int ltid() { int t = threadIdx.x; asm volatile("" : "+v"(t)); return t; }
typedef const Params __attribute__((address_space(4))) * KParamsPtr;
__device__ __forceinline__ const Params& getp() {
    KParamsPtr kp = (KParamsPtr)__builtin_amdgcn_kernarg_segment_ptr();
    asm volatile("" : "+s"(kp));
    return *(const Params*)kp;
}
__device__ __forceinline__ void ph_rope(const Params& p) {
    for (int idx = blockIdx.x * 256 + ltid(); idx < T_ * 32; idx += gridDim.x * 256) {
        int t = idx >> 5, i = idx & 31;
        float ang = (float)p.positions[t] * INVF[i];
        double rev = (double)ang * 0.15915494309189535;
        double fr = rev - rint(rev);
        float r = (float)(fr * 6.283185307179586);
        f32x2 cs; cs.x = __cosf(r); cs.y = __sinf(r);
        ((f32x2*)(p.ws + OFF_ROPE))[idx] = cs;
    }
}

__device__ __forceinline__ void ph_mod(const Params& p, unsigned char* smem) {
    float* sc = (float*)smem;
    float* part = sc + 8 * 1024;
    const int tid = ltid();
    if ((int)blockIdx.x >= 192) return;
    __syncthreads();
    for (int i = tid; i < 8192; i += 256) sc[i] = siluf_(p.c[i]);
    __syncthreads();
    for (int it = blockIdx.x; it < 192; it += gridDim.x) {
        const int l = it / 96, jb = (it % 96) * 64;
        const int c4 = (tid & 15) * 4, kg = tid >> 4;
        f32x4 acc[8];
#pragma unroll
        for (int b = 0; b < 8; ++b) acc[b] = (f32x4){0.f, 0.f, 0.f, 0.f};
        const float* w = p.ada_w + (size_t)l * 1024 * 6144 + jb + c4;
#pragma unroll 4
        for (int k = kg * 64; k < kg * 64 + 64; ++k) {
            const f32x4 wv = *(const f32x4*)(w + (size_t)k * 6144);
#pragma unroll
            for (int b = 0; b < 8; ++b) acc[b] += wv * sc[b * 1024 + k];
        }
        if (kg >= 8) {
#pragma unroll
            for (int b = 0; b < 8; ++b) *(f32x4*)(part + ((kg - 8) * 8 + b) * 64 + c4) = acc[b];
        }
        __syncthreads();
        if (kg < 8) {
#pragma unroll
            for (int b = 0; b < 8; ++b) { f32x4* q = (f32x4*)(part + (kg * 8 + b) * 64 + c4); *q = *q + acc[b]; }
        }
        __syncthreads();
        {
            float* mod = (float*)(p.ws + OFF_MOD);
#pragma unroll
            for (int o = 0; o < 2; ++o) {
                const int idx = tid + 256 * o, b = idx >> 6, jj = idx & 63;
                float r = 0.f;
#pragma unroll
                for (int g = 0; g < 8; ++g) r += part[(g * 8 + b) * 64 + jj];
                mod[(size_t)(l * 8 + b) * 6144 + jb + jj] = r + p.ada_b[l * 6144 + jb + jj];
            }
        }
        __syncthreads();
    }
}

struct TJob {
    const float* src; bf16_t* dst;
    int K, NQ, src_ld, dst_ld, mode, p0, nbatch, pad;
    size_t src_bs, dst_bs;
};
__device__ __forceinline__ int tj_src_col(int mode, int p0, int q) {
    if (mode == 0) return q + p0;
    if (mode == 1) return q < 1092 ? q : (q < 1152 ? -1 : q - 60);
    if (mode == 2) return q;
    return q < 64 ? q : -1;
}
__device__ __forceinline__ int tj_dst_row(int mode, int p0, int q) {
    if (mode == 2) return (q >> 5) * 64 + p0 + (q & 31);
    return q;
}
__device__ __forceinline__ void tconv_load(const TJob& j, int it, int tid, f32x4 (&r)[4]) {
    const int nk = j.K / 64;
    const int per = (j.NQ / 64) * nk;
    const int b = it / per, rr = it % per, qt = rr / nk, kt = rr % nk;
    const float* src = j.src + (size_t)b * j.src_bs;
    const int tx4 = (tid & 15) * 4, ty = tid >> 4;
    const int sc = tj_src_col(j.mode, j.p0, qt * 64 + tx4);
#pragma unroll
    for (int i = 0; i < 4; ++i) {
        if (sc >= 0) r[i] = *(const f32x4*)(src + (size_t)(kt * 64 + ty + 16 * i) * j.src_ld + sc);
        else r[i] = (f32x4){0.f, 0.f, 0.f, 0.f};
    }
}
constexpr int TCS = 68;
__device__ __forceinline__ void tconv_put(int tid, const f32x4 (&r)[4], float* tile) {
    const int tx4 = (tid & 15) * 4, ty = tid >> 4;
#pragma unroll
    for (int i = 0; i < 4; ++i) {
        const int k = ty + 16 * i;
        *(f32x4*)(tile + k * TCS + (tx4 ^ (((k >> 4) & 1) * 16))) = r[i];
    }
}
__device__ __forceinline__ void tconv_emit(const TJob& j, int it, int tid, const float* tile) {
    const int nk = j.K / 64;
    const int per = (j.NQ / 64) * nk;
    const int b = it / per, rr = it % per, qt = rr / nk, kt = rr % nk;
    bf16_t* dst = j.dst + (size_t)b * j.dst_bs;
    const int nn = tid >> 2, kc = (tid & 3) * 16;
    const int dr = tj_dst_row(j.mode, j.p0, qt * 64 + nn);
    const int col = nn ^ (((kc >> 4) & 1) * 16);
    unsigned w[8];
#pragma unroll
    for (int i = 0; i < 8; ++i) w[i] = pack2(tile[(kc + 2 * i) * TCS + col], tile[(kc + 2 * i + 1) * TCS + col]);
    u32x4* d = (u32x4*)(dst + (size_t)dr * j.dst_ld + kt * 64 + kc);
    d[0] = (u32x4){w[0], w[1], w[2], w[3]};
    d[1] = (u32x4){w[4], w[5], w[6], w[7]};
}

__device__ __forceinline__ void ph_wcomp(const Params& p, int l, unsigned char* smem) {
    float (*row)[256] = (float (*)[256])smem;
    const int tid = ltid();
    for (int it = blockIdx.x; it < 512; it += gridDim.x) {
    const int k0 = it * 2;
    __syncthreads();
    {
        const int kk = tid >> 7, jj = tid & 127;
        const float* wi = p.w_in + ((size_t)l * 1024 + k0 + kk) * NIN_ + 512;
        row[kk][jj] = wi[jj] * p.g_kv[l * 256 + jj];
        row[kk][jj + 128] = wi[jj + 128] * p.g_kv[l * 256 + jj + 128];
    }
    __syncthreads();
    const int kk = tid >> 7, n = tid & 127;
    const float* wu = (n < 64) ? (p.w_uk + (size_t)l * 256 * 64 + n) : (p.w_uv + (size_t)l * 256 * 64 + (n - 64));
    float acc = 0.f;
    for (int jx = 0; jx < 256; ++jx) acc += row[kk][jx] * wu[jx * 64];
    bf16_t* WinT = (bf16_t*)(p.ws + OFF_WB) + WB_WIN;
    WinT[(size_t)(C_KA + n) * 1024 + k0 + kk] = f2bf(acc);
    }
}

struct NormArgs {
    const float* xin; const bf16_t* Y; const bf16_t* slots;
    const float* gpost; const float* gt;
    const float* gpre; const float* sc; const float* sh;
    int mode;
};
__device__ __forceinline__ void ph_norm(const Params& p, const NormArgs& a) {
    const int lane = ltid() & 63;
    for (int row = blockIdx.x * 4 + (ltid() >> 6); row < T_; row += gridDim.x * 4) {
    const int b = row >> 11;
    float* xo = p.out + (size_t)row * 1024;
    f32x4 xv[4];
    if (a.mode == 0) {
#pragma unroll
        for (int i = 0; i < 4; ++i) xv[i] = *(const f32x4*)(a.xin + (size_t)row * 1024 + i * 256 + lane * 4);
    } else {
        f32x4 yv[4];
        if (a.mode == 1) {
#pragma unroll
            for (int i = 0; i < 4; ++i) {
                u32x2 u = *(const u32x2*)(a.Y + (size_t)row * 1024 + i * 256 + lane * 4);
                yv[i][0] = __uint_as_float(u.x << 16); yv[i][1] = __uint_as_float(u.x & 0xffff0000u);
                yv[i][2] = __uint_as_float(u.y << 16); yv[i][3] = __uint_as_float(u.y & 0xffff0000u);
            }
        } else {
#pragma unroll
            for (int i = 0; i < 4; ++i) yv[i] = (f32x4){0.f, 0.f, 0.f, 0.f};
#pragma unroll
            for (int k = 0; k < 9; ++k) {
                const bf16_t* sp = a.slots + (k < 8 ? ((size_t)row * 8 + k) : ((size_t)8 * T_ + row)) * 1024;
#pragma unroll
                for (int i = 0; i < 4; ++i) {
                    u32x2 u = *(const u32x2*)(sp + i * 256 + lane * 4);
                    yv[i][0] += __uint_as_float(u.x << 16); yv[i][1] += __uint_as_float(u.x & 0xffff0000u);
                    yv[i][2] += __uint_as_float(u.y << 16); yv[i][3] += __uint_as_float(u.y & 0xffff0000u);
                }
            }
        }
        float ss = 0.f;
#pragma unroll
        for (int i = 0; i < 4; ++i) ss += yv[i][0] * yv[i][0] + yv[i][1] * yv[i][1] + yv[i][2] * yv[i][2] + yv[i][3] * yv[i][3];
        ss = wave_sum(ss);
        const float rs = rsqrtf(ss * (1.0f / 1024.0f) + EPS_);
#pragma unroll
        for (int i = 0; i < 4; ++i) {
            const int col = i * 256 + lane * 4;
            f32x4 xo4 = *(const f32x4*)(xo + col);
            f32x4 g4 = *(const f32x4*)(a.gpost + col);
            f32x4 gt4 = *(const f32x4*)(a.gt + (size_t)b * 6144 + col);
            xv[i] = xo4 + gt4 * (yv[i] * rs * g4);
        }
    }
#pragma unroll
    for (int i = 0; i < 4; ++i) *(f32x4*)(xo + i * 256 + lane * 4) = xv[i];
    if (a.gpre) {
        float ss = 0.f;
#pragma unroll
        for (int i = 0; i < 4; ++i) ss += xv[i][0] * xv[i][0] + xv[i][1] * xv[i][1] + xv[i][2] * xv[i][2] + xv[i][3] * xv[i][3];
        ss = wave_sum(ss);
        const float rs = rsqrtf(ss * (1.0f / 1024.0f) + EPS_);
        bf16_t* H = (bf16_t*)(p.ws + OFF_H) + (size_t)row * 1024;
#pragma unroll
        for (int i = 0; i < 4; ++i) {
            const int col = i * 256 + lane * 4;
            f32x4 g4 = *(const f32x4*)(a.gpre + col);
            f32x4 sc4 = *(const f32x4*)(a.sc + (size_t)b * 6144 + col);
            f32x4 sh4 = *(const f32x4*)(a.sh + (size_t)b * 6144 + col);
            f32x4 h = (xv[i] * rs * g4) * (sc4 + 1.0f) + sh4;
            u32x2 u; u.x = pack2(h[0], h[1]); u.y = pack2(h[2], h[3]);
            *(u32x2*)(H + col) = u;
        }
    }
    }
}

#define LAS __attribute__((address_space(3)))
constexpr int STG = 32768;
constexpr int MISC = 49152;
constexpr int DYN_LDS = 49152 + 1280;
__device__ __forceinline__ int stg_row(int tid, int i, int pieces) { return ((tid >> 6) * pieces + i) * 8 + ((tid & 63) >> 3); }
__device__ __forceinline__ int stg_chunk(int tid, int i) { return (tid & 7) ^ ((4 * i + ((tid & 63) >> 4)) & 7); }
template <int NW>
__device__ __forceinline__ void gemm_kloop2(f32x4 (&acc)[4][NW], const bf16_t* abase, const unsigned (&aoff)[4], const bf16_t* bbase, const unsigned (&boff)[NW], int K, unsigned char* smem, int tid) {
    const int lane = tid & 63, wid = __builtin_amdgcn_readfirstlane(tid >> 6), wr = wid >> 1, wc = wid & 1, fr = lane & 15, fq = lane >> 4;
    LAS unsigned char* lds = (LAS unsigned char*)smem;
    const int nt = K >> 6;
    const int offA = (wr * 64 + fr) * 128, offB = 16384 + (wc * (16 * NW) + fr) * 128;
    const int sw = fr >> 1;
    for (int t = 0; t < nt; ++t) {
        __syncthreads();
#pragma unroll
        for (int i = 0; i < 4; ++i) __builtin_amdgcn_global_load_lds((const unsigned*)(abase + aoff[i] + t * 64), (LAS unsigned*)(lds + (wid * 4 + i) * 1024), 16, 0, 0);
#pragma unroll
        for (int i = 0; i < NW; ++i) __builtin_amdgcn_global_load_lds((const unsigned*)(bbase + boff[i] + t * 64), (LAS unsigned*)(lds + 16384 + (wid * NW + i) * 1024), 16, 0, 0);
        asm volatile("s_waitcnt vmcnt(0)" ::: "memory");
        __syncthreads();
#pragma unroll
        for (int ks = 0; ks < 2; ++ks) {
            const int ch = ((ks * 4 + fq) ^ sw) << 4;
            bf16x8 af[4], bfv[NW];
#pragma unroll
            for (int m = 0; m < 4; ++m) af[m] = *(const LAS bf16x8*)(lds + offA + m * 2048 + ch);
#pragma unroll
            for (int n = 0; n < NW; ++n) bfv[n] = *(const LAS bf16x8*)(lds + offB + n * 2048 + ch);
            __builtin_amdgcn_s_setprio(1);
#pragma unroll
            for (int m = 0; m < 4; ++m)
#pragma unroll
                for (int n = 0; n < NW; ++n) acc[m][n] = __builtin_amdgcn_mfma_f32_16x16x32_bf16(af[m], bfv[n], acc[m][n], 0, 0, 0);
            __builtin_amdgcn_s_setprio(0);
        }
    }
}

constexpr int LDT = 72;
struct __attribute__((aligned(16))) GemmLds { bf16_t A[128 * LDT]; bf16_t B[128 * LDT]; };

template <int NW>
__device__ __forceinline__ void gemm_kloop(f32x4 (&acc)[4][NW], const bf16_t* const (&ap)[4], const bf16_t* const (&bp)[NW], int K,
                                           bf16_t* sA, bf16_t* sB, int tid) {
    const int lane = tid & 63, wid = __builtin_amdgcn_readfirstlane(tid >> 6), wr = wid >> 1, wc = wid & 1, fr = lane & 15, fq = lane >> 4;
    u32x4 ra[4], rb[NW];
#pragma unroll
    for (int i = 0; i < 4; ++i) ra[i] = *(const u32x4*)(ap[i]);
#pragma unroll
    for (int i = 0; i < NW; ++i) rb[i] = *(const u32x4*)(bp[i]);
    const int srow = tid >> 3, scol = (tid & 7) * 8;
    for (int k0 = 0; k0 < K; k0 += 64) {
        __syncthreads();
#pragma unroll
        for (int i = 0; i < 4; ++i) *(u32x4*)(sA + (srow + 32 * i) * LDT + scol) = ra[i];
#pragma unroll
        for (int i = 0; i < NW; ++i) *(u32x4*)(sB + (srow + 32 * i) * LDT + scol) = rb[i];
        __syncthreads();
        if (k0 + 64 < K) {
#pragma unroll
            for (int i = 0; i < 4; ++i) ra[i] = *(const u32x4*)(ap[i] + k0 + 64);
#pragma unroll
            for (int i = 0; i < NW; ++i) rb[i] = *(const u32x4*)(bp[i] + k0 + 64);
        }
#pragma unroll
        for (int ks = 0; ks < 2; ++ks) {
            bf16x8 af[4], bfv[NW];
#pragma unroll
            for (int m = 0; m < 4; ++m) af[m] = *(const bf16x8*)(sA + (wr * 64 + m * 16 + fr) * LDT + ks * 32 + fq * 8);
#pragma unroll
            for (int n = 0; n < NW; ++n) bfv[n] = *(const bf16x8*)(sB + (wc * (16 * NW) + n * 16 + fr) * LDT + ks * 32 + fq * 8);
#pragma unroll
            for (int m = 0; m < 4; ++m)
#pragma unroll
                for (int n = 0; n < NW; ++n) acc[m][n] = __builtin_amdgcn_mfma_f32_16x16x32_bf16(af[m], bfv[n], acc[m][n], 0, 0, 0);
        }
    }
}
template <int NW>
__device__ __forceinline__ void zero_acc(f32x4 (&acc)[4][NW]) {
#pragma unroll
    for (int m = 0; m < 4; ++m)
#pragma unroll
        for (int n = 0; n < NW; ++n) acc[m][n] = (f32x4){0.f, 0.f, 0.f, 0.f};
}

__device__ __forceinline__ void store_rope(const f32x4 (&acc)[4][4], bf16_t* dst, int ld, int dcol, float scale, const f32x2* rope, int rowbase, int fr, int fq) {
#pragma unroll
    for (int m = 0; m < 4; ++m)
#pragma unroll
        for (int j = 0; j < 4; ++j) {
            const int t = rowbase + m * 16 + fq * 4 + j;
#pragma unroll
            for (int nn = 0; nn < 2; ++nn) {
                const f32x2 cs = rope[(size_t)t * 32 + nn * 16 + fr];
                const float x1 = acc[m][nn][j], x2 = acc[m][nn + 2][j];
                dst[(size_t)t * ld + dcol + nn * 16 + fr] = f2bf((x1 * cs.x - x2 * cs.y) * scale);
                dst[(size_t)t * ld + dcol + (nn + 2) * 16 + fr] = f2bf((x2 * cs.x + x1 * cs.y) * scale);
            }
        }
}
__device__ __forceinline__ void store_plain(const f32x4 (&acc)[4][4], bf16_t* dst, int ld, int dcol, float scale, int act, int rowbase, int fr, int fq) {
#pragma unroll
    for (int m = 0; m < 4; ++m)
#pragma unroll
        for (int j = 0; j < 4; ++j) {
            const int t = rowbase + m * 16 + fq * 4 + j;
#pragma unroll
            for (int n = 0; n < 4; ++n) {
                float v = acc[m][n][j] * scale;
                if (act == 1) v = sigmoidf_(v);
                else if (act == 2) v = siluf_(v);
                dst[(size_t)t * ld + dcol + n * 16 + fr] = f2bf(v);
            }
        }
}
__device__ __forceinline__ void store_trans(const f32x4 (&acc)[4][4], bf16_t* dstT, int rows_per_b, int rowoff, int rowbase, int fr, int fq) {
#pragma unroll
    for (int m = 0; m < 4; ++m) {
        const int t = rowbase + m * 16 + fq * 4;
        const int b = t >> 11, s = t & 2047;
#pragma unroll
        for (int n = 0; n < 4; ++n) {
            u32x2 u; u.x = pack2(acc[m][n][0], acc[m][n][1]); u.y = pack2(acc[m][n][2], acc[m][n][3]);
            *(u32x2*)(dstT + ((size_t)b * rows_per_b + rowoff + n * 16 + fr) * 2048 + s) = u;
        }
    }
}

constexpr int LDE = 136;
template <int NW>
__device__ __forceinline__ void lds_put_tile(bf16_t* sT, const f32x4 (&acc)[4][NW], int wr, int wc, int fr, int fq) {
#pragma unroll
    for (int m = 0; m < 4; ++m)
#pragma unroll
        for (int j = 0; j < 4; ++j)
#pragma unroll
            for (int n = 0; n < NW; ++n) sT[(wr * 64 + m * 16 + fq * 4 + j) * LDE + wc * (16 * NW) + n * 16 + fr] = f2bf(acc[m][n][j]);
}
__device__ __forceinline__ void lds_put_tile_t(bf16_t* sT, const f32x4 (&acc)[4][4], int wr, int wc, int fr, int fq) {
#pragma unroll
    for (int m = 0; m < 4; ++m)
#pragma unroll
        for (int n = 0; n < 4; ++n) {
            u32x2 u; u.x = pack2(acc[m][n][0], acc[m][n][1]); u.y = pack2(acc[m][n][2], acc[m][n][3]);
            *(u32x2*)(sT + (wc * 64 + n * 16 + fr) * LDE + wr * 64 + m * 16 + fq * 4) = u;
        }
}
__device__ __forceinline__ void rope_acc(f32x4 (&acc)[4][4], float scale, const f32x2* rope, int rowbase, int fr, int fq) {
    const f32x2* rp = rope + (size_t)(rowbase + fq * 4) * 32 + fr;
#pragma unroll
    for (int m = 0; m < 4; ++m) {
#pragma unroll
        for (int j = 0; j < 4; ++j) {
#pragma unroll
            for (int nn = 0; nn < 2; ++nn) {
                const f32x2 cs = rp[(m * 16 + j) * 32 + nn * 16];
                const float cc = cs.x * scale, sn = cs.y * scale;
                const float x1 = acc[m][nn][j], x2 = acc[m][nn + 2][j];
                acc[m][nn][j] = __fmaf_rn(x1, cc, -(x2 * sn));
                acc[m][nn + 2][j] = __fmaf_rn(x2, cc, x1 * sn);
            }
            if (j & 1) __builtin_amdgcn_sched_barrier(0);
        }
    }
}
__device__ __forceinline__ void scale_act_acc(f32x4 (&acc)[4][4], float scale, int act) {
#pragma unroll
    for (int m = 0; m < 4; ++m)
#pragma unroll
        for (int n = 0; n < 4; ++n)
#pragma unroll
            for (int j = 0; j < 4; ++j) {
                float v = acc[m][n][j] * scale;
                if (act == 1) v = sigmoidf_(v);
                else if (act == 2) v = siluf_(v);
                acc[m][n][j] = v;
            }
}
struct SegDst { bf16_t* rm; int ld; int dcol; bf16_t* tr; int tr_rows; int tr_off; int kind; };
__device__ __forceinline__ SegDst seg_dst(unsigned char* r1, int c0) {
    SegDst d; d.rm = nullptr; d.ld = 0; d.dcol = 0; d.tr = nullptr; d.tr_rows = 0; d.tr_off = 0; d.kind = 0;
    if (c0 < C_CKV) { d.rm = (bf16_t*)(r1 + R1_QA); d.ld = 512; d.dcol = c0 - C_QA; d.kind = 1; }
    else if (c0 < C_IQ) { d.kind = 0; }
    else if (c0 < C_IK) { d.rm = (bf16_t*)(r1 + R1_IQ); d.ld = 256; d.dcol = c0 - C_IQ; d.kind = 1; }
    else if (c0 < C_IW) { d.rm = (bf16_t*)(r1 + R1_IK); d.ld = 64; d.dcol = 0; d.kind = 1; }
    else if (c0 < C_QB) { d.kind = 0; }
    else if (c0 < C_KB) { d.rm = (bf16_t*)(r1 + R1_QB); d.ld = 512; d.dcol = c0 - C_QB; d.kind = 1; }
    else if (c0 < C_VB) { d.rm = (bf16_t*)(r1 + R1_KB); d.ld = 512; d.dcol = c0 - C_KB; d.kind = 1; }
    else if (c0 < C_QC) { d.tr = (bf16_t*)(r1 + R1_VBT); d.tr_rows = 512; d.tr_off = c0 - C_VB; d.kind = 2; }
    else if (c0 < C_KC) { d.rm = (bf16_t*)(r1 + R1_QC); d.ld = 512; d.dcol = c0 - C_QC; d.kind = 1; }
    else if (c0 < C_VC) { d.rm = (bf16_t*)(r1 + R1_KC); d.ld = 512; d.dcol = c0 - C_KC; d.tr = (bf16_t*)(r1 + R1_KCT); d.tr_rows = 512; d.tr_off = c0 - C_KC; d.kind = 3; }
    else if (c0 < C_GC) { d.tr = (bf16_t*)(r1 + R1_VCT); d.tr_rows = 1024; d.tr_off = c0 - C_VC; d.kind = 2; }
    else if (c0 < C_GATES) { d.rm = (bf16_t*)(r1 + R1_GC); d.ld = 1024; d.dcol = c0 - C_GC; d.kind = 1; }
    else if (c0 < C_KA) { d.tr = (bf16_t*)(r1 + R1_GATES); d.tr_rows = 3072; d.tr_off = c0 - C_GATES; d.kind = 2; }
    else if (c0 < C_VA) { d.rm = (bf16_t*)(r1 + R1_KA); d.ld = 64; d.dcol = 0; d.kind = 1; }
    else { d.tr = (bf16_t*)(r1 + R1_VAT); d.tr_rows = 64; d.tr_off = 0; d.kind = 2; }
    return d;
}

__device__ __forceinline__ void ph_gemm_z(const Params& p, unsigned char* smem) {
    bf16_t* sT = (bf16_t*)smem;
    const int tid = ltid(), lane = tid & 63, wid = __builtin_amdgcn_readfirstlane(tid >> 6), wr = wid >> 1, wc = wid & 1, fr = lane & 15, fq = lane >> 4;
    const bf16_t* H = (const bf16_t*)(p.ws + OFF_H);
    const bf16_t* WinT = (const bf16_t*)(p.ws + OFF_WB) + WB_WIN;
    const int xcd = blockIdx.x & 7, jb = blockIdx.x >> 3, nper = gridDim.x >> 3;
    for (int q = jb; q < 1120; q += nper) {
        const int half = q / 560, rem = q % 560, nt = rem >> 3, mtl = rem & 7;
        const int mt = 16 * xcd + 8 * half + mtl;
        const int m0 = mt * 128, n0 = nt * 128;
        unsigned ao[4], bo[4];
#pragma unroll
        for (int i = 0; i < 4; ++i) {
            const int R = stg_row(tid, i, 4), g = stg_chunk(tid, i);
            ao[i] = (unsigned)(m0 + R) * 1024u + g * 8;
            bo[i] = (unsigned)(n0 + R) * 1024u + g * 8;
        }
        f32x4 acc[4][4];
        zero_acc<4>(acc);
        gemm_kloop2<4>(acc, H, ao, WinT, bo, 1024, smem, tid);
        int te = tid; asm volatile("" : "+v"(te));
        const int fre = te & 15, fqe = (te & 63) >> 4;
        const Params& pe = getp();
        unsigned char* r1 = pe.ws + OFF_R1;
        const f32x2* rope = (const f32x2*)(pe.ws + OFF_ROPE);
        const int c0 = n0 + wc * 64;
        const int rowbase = m0 + wr * 64;
        if (c0 < C_CKV) rope_acc(acc, 0.125f, rope, rowbase, fre, fqe);
        else if (c0 < C_IQ) {
            float* ss = (float*)(pe.ws + OFF_CKVSS);
            const int blk = (c0 - C_CKV) >> 6;
#pragma unroll
            for (int m = 0; m < 4; ++m)
#pragma unroll
                for (int j = 0; j < 4; ++j) {
                    float sq = 0.f;
#pragma unroll
                    for (int n = 0; n < 4; ++n) sq += acc[m][n][j] * acc[m][n][j];
                    sq += __shfl_xor(sq, 1); sq += __shfl_xor(sq, 2); sq += __shfl_xor(sq, 4); sq += __shfl_xor(sq, 8);
                    if (fre == 0) ss[(size_t)(rowbase + m * 16 + fqe * 4 + j) * 4 + blk] = sq;
                }
        }
        else if (c0 < C_IK) rope_acc(acc, 1.0f, rope, rowbase, fre, fqe);
        else if (c0 < C_IW) rope_acc(acc, 1.0f, rope, rowbase, fre, fqe);
        else if (c0 < C_QB) {
            float* iw = (float*)(pe.ws + OFF_IW);
            if (fre < 4) {
#pragma unroll
                for (int m = 0; m < 4; ++m)
#pragma unroll
                    for (int j = 0; j < 4; ++j) iw[(size_t)(rowbase + m * 16 + fqe * 4 + j) * 4 + fre] = acc[m][0][j] * 0.0625f;
            }
        }
        else if (c0 < C_KB) scale_act_acc(acc, 0.125f, 0);
        else if (c0 < C_QC) { }
        else if (c0 < C_KC) rope_acc(acc, 1.0f, rope, rowbase, fre, fqe);
        else if (c0 < C_VC) rope_acc(acc, 0.125f, rope, rowbase, fre, fqe);
        else if (c0 < C_GC) { }
        else if (c0 < C_GATES) scale_act_acc(acc, 1.0f, 2);
        else if (c0 < C_KA) scale_act_acc(acc, 1.0f, 1);
        else if (c0 < C_VA) rope_acc(acc, 1.0f, rope, rowbase, fre, fqe);
        const SegDst dw = seg_dst(r1, c0);
        const SegDst d0 = seg_dst(r1, n0), d1 = seg_dst(r1, n0 + 64);
        const int anyrm = (d0.kind | d1.kind) & 1, anytr = (d0.kind | d1.kind) & 2;
        __syncthreads();
        if (anyrm) {
            if (dw.kind & 1) lds_put_tile<4>(sT, acc, wr, wc, fre, fqe);
            __syncthreads();
#pragma unroll
            for (int hh = 0; hh < 2; ++hh) {
                const SegDst& d = hh ? d1 : d0;
                if (d.kind & 1) {
#pragma unroll
                    for (int i = 0; i < 4; ++i) {
                        const int c = te + 256 * i, row = c >> 3, ch = c & 7;
                        *(u32x4*)(d.rm + (size_t)(m0 + row) * d.ld + d.dcol + ch * 8) = *(const u32x4*)(sT + row * LDE + hh * 64 + ch * 8);
                    }
                }
            }
        }
        if (anytr) {
            __syncthreads();
            if (dw.kind & 2) lds_put_tile_t(sT, acc, wr, wc, fre, fqe);
            __syncthreads();
            const int b = m0 >> 11, s0 = m0 & 2047;
#pragma unroll
            for (int hh = 0; hh < 2; ++hh) {
                const SegDst& d = hh ? d1 : d0;
                if (d.kind & 2) {
#pragma unroll
                    for (int i = 0; i < 4; ++i) {
                        const int c = te + 256 * i, erow = c >> 4, ch = c & 15;
                        *(u32x4*)(d.tr + ((size_t)b * d.tr_rows + d.tr_off + erow) * 2048 + s0 + ch * 8) = *(const u32x4*)(sT + (hh * 64 + erow) * LDE + ch * 8);
                    }
                }
            }
        }
    }
}

struct __attribute__((aligned(16))) AttnLds { bf16_t K[64 * LDT]; bf16_t Vt[64 * LDT]; float rs[64]; };

__device__ __forceinline__ void tile64_load(u32x4 (&r)[2], const bf16_t* src, size_t src_ld, int tid) {
#pragma unroll
    for (int i = 0; i < 2; ++i) {
        const int c = tid + 256 * i, row = c >> 3, col8 = (c & 7) * 8;
        r[i] = *(const u32x4*)(src + (size_t)row * src_ld + col8);
    }
}
__device__ __forceinline__ void tile64_put(bf16_t* dst, const u32x4 (&r)[2], int tid) {
#pragma unroll
    for (int i = 0; i < 2; ++i) {
        const int c = tid + 256 * i, row = c >> 3, col8 = (c & 7) * 8;
        *(u32x4*)(dst + row * LDT + col8) = r[i];
    }
}
__device__ __forceinline__ void stage_tile64(bf16_t* dst, const bf16_t* src, size_t src_ld, int tid) {
#pragma unroll
    for (int i = 0; i < 2; ++i) {
        const int c = tid + 256 * i, row = c >> 3, col8 = (c & 7) * 8;
        *(u32x4*)(dst + row * LDT + col8) = *(const u32x4*)(src + (size_t)row * src_ld + col8);
    }
}

__device__ __forceinline__ void sb_tile(const AttnLds& sm, const bf16x8 (&qf)[2], f32x4 (&O)[4], float& R, bool diag, int tl, int fr, int fq) {
    f32x4 st[4];
#pragma unroll
    for (int mk = 0; mk < 4; ++mk) {
        st[mk] = (f32x4){0.f, 0.f, 0.f, 0.f};
#pragma unroll
        for (int ks = 0; ks < 2; ++ks) {
            bf16x8 kf = *(const bf16x8*)(sm.K + (mk * 16 + fr) * LDT + ks * 32 + fq * 8);
            st[mk] = __builtin_amdgcn_mfma_f32_16x16x32_bf16(kf, qf[ks], st[mk], 0, 0, 0);
        }
    }
    float Bv[4][4], Om[4][4], P[4];
#pragma unroll
    for (int mk = 0; mk < 4; ++mk) {
        P[mk] = 1.f;
#pragma unroll
        for (int r = 0; r < 4; ++r) {
            const float z = st[mk][r];
            const bool valid = !diag || (16 * mk + 4 * fq + r < tl);
            const float e = __expf(-fabsf(z));
            const float sg = __builtin_amdgcn_rcpf(1.0f + e);
            const float es = e * sg;
            const float beta = (z >= 0.f) ? sg : es, om = (z >= 0.f) ? es : sg;
            Bv[mk][r] = valid ? beta : 0.f;
            Om[mk][r] = valid ? om : 1.f;
            P[mk] *= Om[mk][r];
        }
    }
    float tot[4], above[4];
#pragma unroll
    for (int mk = 0; mk < 4; ++mk) {
        auto sw = __builtin_amdgcn_permlane16_swap(__float_as_uint(P[mk]), __float_as_uint(P[mk]), false, false);
        const float po = __uint_as_float(sw[1]);
        const float pair = __uint_as_float(sw[0]) * po;
        auto tw = __builtin_amdgcn_permlane32_swap(__float_as_uint(pair), __float_as_uint(pair), false, false);
        const float hi = __uint_as_float(tw[1]);
        tot[mk] = __uint_as_float(tw[0]) * hi;
        above[mk] = ((fq & 1) ? 1.f : po) * ((fq < 2) ? hi : 1.f);
    }
    float higher[4];
    higher[3] = 1.f; higher[2] = tot[3]; higher[1] = tot[3] * tot[2]; higher[0] = tot[3] * tot[2] * tot[1];
    float A[4][4];
#pragma unroll
    for (int mk = 0; mk < 4; ++mk) {
        float suf = above[mk] * higher[mk] * R;
#pragma unroll
        for (int r = 3; r >= 0; --r) {
            A[mk][r] = Bv[mk][r] * suf;
            suf *= Om[mk][r];
        }
    }
    R *= (tot[0] * tot[1]) * (tot[2] * tot[3]);
#pragma unroll
    for (int ks = 0; ks < 2; ++ks) {
        u32x4 uu = (u32x4){pack2(A[2 * ks][0], A[2 * ks][1]), pack2(A[2 * ks][2], A[2 * ks][3]),
                           pack2(A[2 * ks + 1][0], A[2 * ks + 1][1]), pack2(A[2 * ks + 1][2], A[2 * ks + 1][3])};
        bf16x8 pf = *(bf16x8*)&uu;
#pragma unroll
        for (int me = 0; me < 4; ++me) {
            const bf16_t* vp = sm.Vt + (me * 16 + fr) * LDT + ks * 32 + 4 * fq;
            u32x2 lo = *(const u32x2*)vp, hi = *(const u32x2*)(vp + 16);
            u32x4 vv = (u32x4){lo.x, lo.y, hi.x, hi.y};
            O[me] = __builtin_amdgcn_mfma_f32_16x16x32_bf16(*(bf16x8*)&vv, pf, O[me], 0, 0, 0);
        }
    }
}
__device__ __forceinline__ void mixb_item(const Params& p, int item, unsigned char* smem) {
    AttnLds& sm = *(AttnLds*)smem;
    const int tid = ltid(), lane = tid & 63, w = __builtin_amdgcn_readfirstlane(tid >> 6), fr = lane & 15, fq = lane >> 4;
    unsigned char* r1 = p.ws + OFF_R1;
    bf16_t* QB = (bf16_t*)(r1 + R1_QB);
    const bf16_t* KB = (const bf16_t*)(r1 + R1_KB);
    const bf16_t* VBT = (const bf16_t*)(r1 + R1_VBT);
    {
        const int qt2 = 15 - (item >> 6), bh = item & 63, b = bh >> 3, h = bh & 7;
        const int tl = 16 * w + fr;
        const int tq0 = b * 2048 + qt2 * 128 + tl, tq1 = tq0 + 64;
        bf16x8 qf0[2], qf1[2];
#pragma unroll
        for (int ks = 0; ks < 2; ++ks) {
            qf0[ks] = *(const bf16x8*)(QB + (size_t)tq0 * 512 + h * 64 + ks * 32 + fq * 8);
            qf1[ks] = *(const bf16x8*)(QB + (size_t)tq1 * 512 + h * 64 + ks * 32 + fq * 8);
        }
        f32x4 O0[4], O1[4];
#pragma unroll
        for (int me = 0; me < 4; ++me) { O0[me] = (f32x4){0.f, 0.f, 0.f, 0.f}; O1[me] = (f32x4){0.f, 0.f, 0.f, 0.f}; }
        float R0 = 1.f, R1 = 1.f;
        const int ktop = 2 * qt2 + 1;
        for (int kt = ktop; kt >= 0; --kt) {
            __syncthreads();
            stage_tile64(sm.K, KB + (size_t)(b * 2048 + kt * 64) * 512 + h * 64, 512, tid);
            stage_tile64(sm.Vt, VBT + ((size_t)(b * 8 + h) * 64) * 2048 + kt * 64, 2048, tid);
            __syncthreads();
            sb_tile(sm, qf1, O1, R1, kt == ktop, tl, fr, fq);
            if (kt < ktop) sb_tile(sm, qf0, O0, R0, kt == ktop - 1, tl, fr, fq);
        }
        const int ts = ltid();
        const int fqs = (ts & 63) >> 4;
        const int tqs0 = b * 2048 + qt2 * 128 + 16 * (ts >> 6) + (ts & 15), tqs1 = tqs0 + 64;
#pragma unroll
        for (int me = 0; me < 4; ++me) {
            u32x2 u; u.x = pack2(O0[me][0], O0[me][1]); u.y = pack2(O0[me][2], O0[me][3]);
            *(u32x2*)(QB + (size_t)tqs0 * 512 + h * 64 + me * 16 + 4 * fqs) = u;
            u32x2 v; v.x = pack2(O1[me][0], O1[me][1]); v.y = pack2(O1[me][2], O1[me][3]);
            *(u32x2*)(QB + (size_t)tqs1 * 512 + h * 64 + me * 16 + 4 * fqs) = v;
        }
    }
}

struct __attribute__((aligned(16))) RetLds { bf16_t K[64 * LDT]; bf16_t KT[64 * LDT]; bf16_t VT[128 * LDT]; bf16_t ST[128 * LDT]; };
struct __attribute__((aligned(16))) RetLds3 { bf16_t K[64 * LDT]; bf16_t VT[128 * LDT]; bf16_t ST[128 * LDT]; };

__device__ __forceinline__ void mixc1_item(const Params& p, int item, unsigned char* smem) {
    RetLds& sm = *(RetLds*)smem;
    const int tid = ltid(), lane = tid & 63, w = __builtin_amdgcn_readfirstlane(tid >> 6), fr = lane & 15, fq = lane >> 4;
    unsigned char* r1 = p.ws + OFF_R1;
    const bf16_t* KCT = (const bf16_t*)(r1 + R1_KCT);
    const bf16_t* VCT = (const bf16_t*)(r1 + R1_VCT);
    bf16_t* KVT = (bf16_t*)(p.ws + OFF_H);
    const int bh = item >> 5, n = item & 31, h = bh & 7;
    const float lg = LOGG[h];
    u32x4 rkt[2], rvt[4];
#pragma unroll
    for (int i = 0; i < 2; ++i) {
        const int c = tid + 256 * i, row = c >> 3, col8 = (c & 7) * 8;
        rkt[i] = *(const u32x4*)(KCT + ((size_t)bh * 64 + row) * 2048 + n * 64 + col8);
    }
#pragma unroll
    for (int i = 0; i < 4; ++i) {
        const int c = tid + 256 * i, row = c >> 3, col8 = (c & 7) * 8;
        rvt[i] = *(const u32x4*)(VCT + ((size_t)bh * 128 + row) * 2048 + n * 64 + col8);
    }
    __syncthreads();
#pragma unroll
    for (int i = 0; i < 2; ++i) {
        const int c = tid + 256 * i, row = c >> 3, col8 = (c & 7) * 8;
        unsigned uu[4] = {rkt[i].x, rkt[i].y, rkt[i].z, rkt[i].w};
#pragma unroll
        for (int q = 0; q < 4; ++q) {
            const float z0 = __expf(lg * (float)(63 - (col8 + 2 * q))), z1 = __expf(lg * (float)(63 - (col8 + 2 * q + 1)));
            uu[q] = pack2(__uint_as_float(uu[q] << 16) * z0, __uint_as_float(uu[q] & 0xffff0000u) * z1);
        }
        *(u32x4*)(sm.KT + row * LDT + col8) = (u32x4){uu[0], uu[1], uu[2], uu[3]};
    }
#pragma unroll
    for (int i = 0; i < 4; ++i) {
        const int c = tid + 256 * i, row = c >> 3, col8 = (c & 7) * 8;
        *(u32x4*)(sm.VT + row * LDT + col8) = rvt[i];
    }
    __syncthreads();
    f32x4 sacc[4][2];
#pragma unroll
    for (int md = 0; md < 4; ++md)
#pragma unroll
        for (int ne = 0; ne < 2; ++ne) sacc[md][ne] = (f32x4){0.f, 0.f, 0.f, 0.f};
#pragma unroll
    for (int ks = 0; ks < 2; ++ks) {
        bf16x8 vf[2];
#pragma unroll
        for (int ne = 0; ne < 2; ++ne) vf[ne] = *(const bf16x8*)(sm.VT + (32 * w + ne * 16 + fr) * LDT + ks * 32 + fq * 8);
#pragma unroll
        for (int md = 0; md < 4; ++md) {
            bf16x8 kf = *(const bf16x8*)(sm.KT + (md * 16 + fr) * LDT + ks * 32 + fq * 8);
#pragma unroll
            for (int ne = 0; ne < 2; ++ne) sacc[md][ne] = __builtin_amdgcn_mfma_f32_16x16x32_bf16(kf, vf[ne], sacc[md][ne], 0, 0, 0);
        }
    }
    bf16_t* dst = KVT + (size_t)item * 128 * 64;
#pragma unroll
    for (int md = 0; md < 4; ++md)
#pragma unroll
        for (int ne = 0; ne < 2; ++ne) {
            u32x2 u; u.x = pack2(sacc[md][ne][0], sacc[md][ne][1]); u.y = pack2(sacc[md][ne][2], sacc[md][ne][3]);
            *(u32x2*)(dst + (32 * w + ne * 16 + fr) * 64 + md * 16 + 4 * fq) = u;
        }
}
__device__ __forceinline__ void ph_mixc2(const Params& p) {
    bf16_t* KVT = (bf16_t*)(p.ws + OFF_H);
    for (int idx = blockIdx.x * 256 + ltid(); idx < 64 * 128 * 16; idx += gridDim.x * 256) {
        const int bh = idx >> 11, ed = idx & 2047;
        const float g64 = __expf(LOGG[bh & 7] * 64.0f);
        bf16_t* pp = KVT + (size_t)bh * 32 * 8192 + (size_t)ed * 4;
        float s0 = 0.f, s1 = 0.f, s2 = 0.f, s3 = 0.f;
#pragma unroll 4
        for (int n = 0; n < 32; ++n) {
            u32x2 kv = *(const u32x2*)(pp + (size_t)n * 8192);
            u32x2 o; o.x = pack2(s0, s1); o.y = pack2(s2, s3);
            *(u32x2*)(pp + (size_t)n * 8192) = o;
            s0 = s0 * g64 + __uint_as_float(kv.x << 16); s1 = s1 * g64 + __uint_as_float(kv.x & 0xffff0000u);
            s2 = s2 * g64 + __uint_as_float(kv.y << 16); s3 = s3 * g64 + __uint_as_float(kv.y & 0xffff0000u);
        }
    }
}
__device__ __forceinline__ void mixc3_item(const Params& p, int l, int item, unsigned char* smem) {
    RetLds3& sm = *(RetLds3*)smem;
    const int tid = ltid(), lane = tid & 63, w = __builtin_amdgcn_readfirstlane(tid >> 6), fr = lane & 15, fq = lane >> 4;
    unsigned char* r1 = p.ws + OFF_R1;
    const bf16_t* QC = (const bf16_t*)(r1 + R1_QC);
    const bf16_t* KC = (const bf16_t*)(r1 + R1_KC);
    const bf16_t* VCT = (const bf16_t*)(r1 + R1_VCT);
    const bf16_t* KVT = (const bf16_t*)(p.ws + OFF_H);
    bf16_t* GC = (bf16_t*)(r1 + R1_GC);
    {
        const int bh = item >> 5, n = item & 31, b = bh >> 3, h = bh & 7;
        const float lg = LOGG[h];
        const int al = 16 * w + fr;
        const float xi = __expf(lg * (float)(al + 1));
        {
            const int tok0 = b * 2048 + n * 64;
            u32x4 rk[2], rvt[4], rst[4];
            bf16x8 qf[2];
#pragma unroll
            for (int ks = 0; ks < 2; ++ks) qf[ks] = *(const bf16x8*)(QC + (size_t)(tok0 + 16 * w + fr) * 512 + h * 64 + ks * 32 + fq * 8);
            tile64_load(rk, KC + (size_t)tok0 * 512 + h * 64, 512, tid);
#pragma unroll
            for (int i = 0; i < 4; ++i) {
                const int c = tid + 256 * i, row = c >> 3, col8 = (c & 7) * 8;
                rvt[i] = *(const u32x4*)(VCT + ((size_t)bh * 128 + row) * 2048 + n * 64 + col8);
                rst[i] = *(const u32x4*)(KVT + (size_t)item * 8192 + row * 64 + col8);
            }
            __syncthreads();
            tile64_put(sm.K, rk, tid);
#pragma unroll
            for (int i = 0; i < 4; ++i) {
                const int c = tid + 256 * i, row = c >> 3, col8 = (c & 7) * 8;
                *(u32x4*)(sm.VT + row * LDT + col8) = rvt[i];
                *(u32x4*)(sm.ST + row * LDT + col8) = rst[i];
            }
            __syncthreads();
            f32x4 st[4];
#pragma unroll
            for (int mc = 0; mc < 4; ++mc) {
                st[mc] = (f32x4){0.f, 0.f, 0.f, 0.f};
#pragma unroll
                for (int ks = 0; ks < 2; ++ks) {
                    bf16x8 kf = *(const bf16x8*)(sm.K + (mc * 16 + fr) * LDT + ks * 32 + fq * 8);
                    st[mc] = __builtin_amdgcn_mfma_f32_16x16x32_bf16(kf, qf[ks], st[mc], 0, 0, 0);
                }
#pragma unroll
                for (int r = 0; r < 4; ++r) {
                    const int cc = 16 * mc + 4 * fq + r;
                    st[mc][r] *= __expf(lg * fabsf((float)(al - cc)));
                }
            }
            f32x4 o[8];
#pragma unroll
            for (int me = 0; me < 8; ++me) {
                o[me] = (f32x4){0.f, 0.f, 0.f, 0.f};
#pragma unroll
                for (int ks = 0; ks < 2; ++ks) {
                    bf16x8 sf = *(const bf16x8*)(sm.ST + (me * 16 + fr) * LDT + ks * 32 + fq * 8);
                    o[me] = __builtin_amdgcn_mfma_f32_16x16x32_bf16(sf, qf[ks], o[me], 0, 0, 0);
                }
                o[me] *= xi;
            }
#pragma unroll
            for (int ks = 0; ks < 2; ++ks) {
                bf16x8 pf;
                {
                    u32x4 uu = (u32x4){pack2(st[2 * ks][0], st[2 * ks][1]), pack2(st[2 * ks][2], st[2 * ks][3]),
                                          pack2(st[2 * ks + 1][0], st[2 * ks + 1][1]), pack2(st[2 * ks + 1][2], st[2 * ks + 1][3])};
                    pf = *(bf16x8*)&uu;
                }
#pragma unroll
                for (int me = 0; me < 8; ++me) {
                    const bf16_t* vp = sm.VT + (me * 16 + fr) * LDT + ks * 32 + 4 * fq;
                    u32x2 lo = *(const u32x2*)vp, hi = *(const u32x2*)(vp + 16);
                    u32x4 vv = (u32x4){lo.x, lo.y, hi.x, hi.y};
                    o[me] = __builtin_amdgcn_mfma_f32_16x16x32_bf16(*(bf16x8*)&vv, pf, o[me], 0, 0, 0);
                }
            }
            {
                float s1 = 0.f;
#pragma unroll
                for (int me = 0; me < 8; ++me) s1 += (o[me][0] + o[me][1]) + (o[me][2] + o[me][3]);
                s1 = xrow16_sum(s1);
                const float mu = s1 * (1.0f / 128.0f);
                float s2 = 0.f;
#pragma unroll
                for (int me = 0; me < 8; ++me)
#pragma unroll
                    for (int r = 0; r < 4; ++r) { const float d = o[me][r] - mu; s2 += d * d; }
                s2 = xrow16_sum(s2);
                const float rstd = rsqrtf(s2 * (1.0f / 128.0f) + EPS_);
                bf16_t* gp = GC + (size_t)(tok0 + al) * 1024 + h * 128;
                const float* gr = p.g_ret + (size_t)l * 1024 + h * 128;
#pragma unroll
                for (int me = 0; me < 8; ++me) {
                    const int e0 = me * 16 + 4 * fq;
                    u32x2 gu = *(const u32x2*)(gp + e0);
                    f32x4 g4 = *(const f32x4*)(gr + e0);
                    const float y0 = (o[me][0] - mu) * rstd * g4[0] * __uint_as_float(gu.x << 16);
                    const float y1 = (o[me][1] - mu) * rstd * g4[1] * __uint_as_float(gu.x & 0xffff0000u);
                    const float y2 = (o[me][2] - mu) * rstd * g4[2] * __uint_as_float(gu.y << 16);
                    const float y3 = (o[me][3] - mu) * rstd * g4[3] * __uint_as_float(gu.y & 0xffff0000u);
                    u32x2 ou; ou.x = pack2(y0, y1); ou.y = pack2(y2, y3);
                    *(u32x2*)(gp + e0) = ou;
                }
            }
        }
    }
}

__device__ __forceinline__ void mixa1_item(const Params& p, int item, unsigned char* smem) {
    float* tau_s = (float*)smem;
    int* stau_s = (int*)(smem + 64);
    const int tid = ltid(), lane = tid & 63, w = __builtin_amdgcn_readfirstlane(tid >> 6), fr = lane & 15, fq = lane >> 4;
    unsigned char* r1 = p.ws + OFF_R1;
    const bf16_t* IQ = (const bf16_t*)(r1 + R1_IQ);
    const bf16_t* IK = (const bf16_t*)(r1 + R1_IK);
    const float* IW = (const float*)(p.ws + OFF_IW);
    float* SC = (float*)(p.ws + OFF_R3);
    unsigned long long* MASKB = (unsigned long long*)(p.ws + OFF_MASKB);
    {
        const int c = 31 - (item >> 5), b = (item >> 2) & 7, qq = item & 3;
        __syncthreads();
        const int nj = c + 1, n = 64 * nj;
        const int tq = b * 2048 + c * 64 + 16 * qq + fr;
        float* scrow = SC + (size_t)b * SC_PER_BATCH + (size_t)2048 * c * (c + 1) + (size_t)(16 * qq + fr) * n;
        bf16x8 iqf[4][2];
        float iw[4];
#pragma unroll
        for (int hh = 0; hh < 4; ++hh) {
            iw[hh] = IW[(size_t)tq * 4 + hh];
#pragma unroll
            for (int ks = 0; ks < 2; ++ks) iqf[hh][ks] = *(const bf16x8*)(IQ + (size_t)tq * 256 + hh * 64 + ks * 32 + fq * 8);
        }
        for (int kt = w; kt < nj; kt += 4) {
            bf16x8 ikf[4][2];
#pragma unroll
            for (int mk = 0; mk < 4; ++mk)
#pragma unroll
                for (int ks = 0; ks < 2; ++ks) ikf[mk][ks] = *(const bf16x8*)(IK + (size_t)(b * 2048 + kt * 64 + mk * 16 + fr) * 64 + ks * 32 + fq * 8);
            f32x4 sc[4];
#pragma unroll
            for (int mk = 0; mk < 4; ++mk) sc[mk] = (f32x4){0.f, 0.f, 0.f, 0.f};
#pragma unroll
            for (int hh = 0; hh < 4; ++hh) {
#pragma unroll
                for (int mk = 0; mk < 4; ++mk) {
                    f32x4 a = (f32x4){0.f, 0.f, 0.f, 0.f};
#pragma unroll
                    for (int ks = 0; ks < 2; ++ks) a = __builtin_amdgcn_mfma_f32_16x16x32_bf16(ikf[mk][ks], iqf[hh][ks], a, 0, 0, 0);
#pragma unroll
                    for (int r = 0; r < 4; ++r) sc[mk][r] = __fmaf_rn(iw[hh], fmaxf(a[r], 0.f), sc[mk][r]);
                }
            }
#pragma unroll
            for (int mk = 0; mk < 4; ++mk) *(f32x4*)(scrow + kt * 64 + 16 * mk + 4 * fq) = sc[mk];
        }
        __syncthreads();
        for (int i = 0; i < 4; ++i) {
            const int r16 = 4 * w + i;
            float tau = -__builtin_inff();
            int stau = 1 << 30;
            if (nj > 4) {
                const float* rowp = SC + (size_t)b * SC_PER_BATCH + (size_t)2048 * c * (c + 1) + (size_t)(16 * qq + r16) * n;
                unsigned key[32];
#pragma unroll
                for (int j = 0; j < 32; ++j) key[j] = __float_as_uint(rowp[j * 64 + lane]);
#pragma unroll
                for (int j = 0; j < 32; ++j) {
                    const unsigned u = key[j];
                    const unsigned k = u ^ ((unsigned)((int)u >> 31) | 0x80000000u);
                    key[j] = (j < nj) ? k : 0u;
                }
                unsigned X = 0u;
                for (int bit = 31; bit >= 0; --bit) {
                    const unsigned cand = X | (1u << bit);
                    int cnt = 0;
                    int c0 = 0, c1 = 0;
#pragma unroll
                    for (int j = 0; j < 32; j += 2) { c0 = cnt_ge(c0, key[j], cand); c1 = cnt_ge(c1, key[j + 1], cand); }
                    cnt = wave_total6(c0 + c1);
                    if (cnt >= 256) X = cand;
                    if (cnt == 256) break;
                }
                int cgt = 0;
                {
                    const unsigned candp = X + 1u;
                    int c0 = 0, c1 = 0;
#pragma unroll
                    for (int j = 0; j < 32; j += 2) { c0 = cnt_ge(c0, key[j], candp); c1 = cnt_ge(c1, key[j + 1], candp); }
                    cgt = wave_total6(c0 + c1);
                }
                const int need = 256 - cgt;
                unsigned eqbits = 0u;
#pragma unroll
                for (int j = 0; j < 32; ++j) {
                    const unsigned ne = min(key[j] ^ X, 1u);
                    eqbits |= (1u - ne) << j;
                }
                const int teq = wave_sum_i(__popc(eqbits));
                if (teq == need) {
                    stau = 1 << 30;
                } else {
                    int lo = 0, hi = n - 1;
                    while (lo < hi) {
                        const int mid = (lo + hi) >> 1;
                        const int jmax = (mid - lane) >> 6;
                        const unsigned msk = jmax < 0 ? 0u : (jmax >= 31 ? 0xffffffffu : ((2u << jmax) - 1u));
                        const int cc = wave_sum_i(__popc(eqbits & msk));
                        if (cc >= need) hi = mid; else lo = mid + 1;
                    }
                    stau = lo;
                }
                const unsigned ux = (X & 0x80000000u) ? (X & 0x7fffffffu) : ~X;
                tau = __uint_as_float(ux);
            }
            if (lane == 0) { tau_s[r16] = tau; stau_s[r16] = stau; }
        }
        __syncthreads();
        {
            const float tau = tau_s[fr];
            const int stau = stau_s[fr];
            for (int kt = w; kt < nj; kt += 4) {
                unsigned lo = 0u, hi = 0u;
#pragma unroll
                for (int mk = 0; mk < 4; ++mk) {
                    const f32x4 v = *(const f32x4*)(scrow + kt * 64 + 16 * mk + 4 * fq);
#pragma unroll
                    for (int r = 0; r < 4; ++r) {
                        const int kl = 16 * mk + 4 * fq + r;
                        const bool sel = (v[r] > tau) || (v[r] == tau && (kt * 64 + kl) <= stau);
                        if (sel) { if (mk < 2) lo |= 1u << kl; else hi |= 1u << (kl - 32); }
                    }
                }
                lo |= __shfl_xor(lo, 16); lo |= __shfl_xor(lo, 32);
                hi |= __shfl_xor(hi, 16); hi |= __shfl_xor(hi, 32);
                if (fq == 0) MASKB[(size_t)tq * 32 + kt] = ((unsigned long long)hi << 32) | lo;
            }
        }
        __syncthreads();
    }
}

__device__ __forceinline__ void a2_tile(const AttnLds& sm, const bf16x8 (&qf)[2], f32x4 (&O)[4], float& mrun, float& lrun, unsigned long long W, int fr, int fq) {
    f32x4 st[4];
    float mx = -1e30f;
    f32x4 rsv[4];
#pragma unroll
    for (int mk = 0; mk < 4; ++mk) {
        st[mk] = (f32x4){0.f, 0.f, 0.f, 0.f};
#pragma unroll
        for (int ks = 0; ks < 2; ++ks) {
            bf16x8 kf = *(const bf16x8*)(sm.K + (mk * 16 + fr) * LDT + ks * 32 + fq * 8);
            st[mk] = __builtin_amdgcn_mfma_f32_16x16x32_bf16(kf, qf[ks], st[mk], 0, 0, 0);
        }
        rsv[mk] = *(const f32x4*)(sm.rs + 16 * mk + 4 * fq);
        const unsigned nib = (unsigned)(W >> (16 * mk + 4 * fq)) & 0xfu;
#pragma unroll
        for (int r = 0; r < 4; ++r) {
            st[mk][r] *= rsv[mk][r];
            if ((nib >> r) & 1u) mx = fmaxf(mx, st[mk][r]);
        }
    }
    mx = xrow16_max(mx);
    const float mnew = fmaxf(mrun, mx);
    const float alpha = __expf(mrun - mnew);
    float ps = 0.f;
    float P[4][4];
#pragma unroll
    for (int mk = 0; mk < 4; ++mk) {
        const unsigned nib = (unsigned)(W >> (16 * mk + 4 * fq)) & 0xfu;
#pragma unroll
        for (int r = 0; r < 4; ++r) {
            const float pv = ((nib >> r) & 1u) ? __expf(st[mk][r] - mnew) : 0.f;
            ps += pv;
            P[mk][r] = pv * rsv[mk][r];
        }
    }
    ps = xrow16_sum(ps);
    lrun = lrun * alpha + ps;
    mrun = mnew;
#pragma unroll
    for (int me = 0; me < 4; ++me) O[me] *= alpha;
#pragma unroll
    for (int ks = 0; ks < 2; ++ks) {
        u32x4 uu = (u32x4){pack2(P[2 * ks][0], P[2 * ks][1]), pack2(P[2 * ks][2], P[2 * ks][3]),
                           pack2(P[2 * ks + 1][0], P[2 * ks + 1][1]), pack2(P[2 * ks + 1][2], P[2 * ks + 1][3])};
        bf16x8 pf = *(bf16x8*)&uu;
#pragma unroll
        for (int me = 0; me < 4; ++me) {
            const bf16_t* vp = sm.Vt + (me * 16 + fr) * LDT + ks * 32 + 4 * fq;
            u32x2 lo = *(const u32x2*)vp, hi = *(const u32x2*)(vp + 16);
            u32x4 vv = (u32x4){lo.x, lo.y, hi.x, hi.y};
            O[me] = __builtin_amdgcn_mfma_f32_16x16x32_bf16(*(bf16x8*)&vv, pf, O[me], 0, 0, 0);
        }
    }
}
__device__ __forceinline__ void ph_mix_a2(const Params& p, unsigned char* smem) {
    AttnLds& sm = *(AttnLds*)smem;
    const int tid = ltid(), lane = tid & 63, w = __builtin_amdgcn_readfirstlane(tid >> 6), fr = lane & 15, fq = lane >> 4;
    unsigned char* r1 = p.ws + OFF_R1;
    bf16_t* QA = (bf16_t*)(r1 + R1_QA);
    const bf16_t* KA = (const bf16_t*)(r1 + R1_KA);
    const bf16_t* VAT = (const bf16_t*)(r1 + R1_VAT);
    const float* CKVSS = (const float*)(p.ws + OFF_CKVSS);
    const unsigned long long* MASKB = (const unsigned long long*)(p.ws + OFF_MASKB);
    for (int item = blockIdx.x; item < 1024; item += gridDim.x) {
        const int c = 31 - (item >> 5), b = (item >> 2) & 7, h0 = (item & 3) * 2;
        const int tq = b * 2048 + c * 64 + 16 * w + fr;
        bf16x8 qf0[2], qf1[2];
#pragma unroll
        for (int ks = 0; ks < 2; ++ks) {
            qf0[ks] = *(const bf16x8*)(QA + (size_t)tq * 512 + h0 * 64 + ks * 32 + fq * 8);
            qf1[ks] = *(const bf16x8*)(QA + (size_t)tq * 512 + (h0 + 1) * 64 + ks * 32 + fq * 8);
        }
        f32x4 O0[4], O1[4];
#pragma unroll
        for (int me = 0; me < 4; ++me) { O0[me] = (f32x4){0.f, 0.f, 0.f, 0.f}; O1[me] = (f32x4){0.f, 0.f, 0.f, 0.f}; }
        float m0r = -1e30f, l0r = 0.f, m1r = -1e30f, l1r = 0.f;
        for (int kt = 0; kt <= c; ++kt) {
            __syncthreads();
            stage_tile64(sm.K, KA + (size_t)(b * 2048 + kt * 64) * 64, 64, tid);
            stage_tile64(sm.Vt, VAT + ((size_t)b * 64) * 2048 + kt * 64, 2048, tid);
            if (tid < 64) {
                const f32x4 s4 = *(const f32x4*)(CKVSS + (size_t)(b * 2048 + kt * 64 + tid) * 4);
                sm.rs[tid] = rsqrtf(((s4[0] + s4[1]) + (s4[2] + s4[3])) * (1.0f / 256.0f) + EPS_);
            }
            const unsigned long long W = MASKB[(size_t)tq * 32 + kt];
            __syncthreads();
            a2_tile(sm, qf0, O0, m0r, l0r, W, fr, fq);
            __builtin_amdgcn_sched_barrier(0);
            a2_tile(sm, qf1, O1, m1r, l1r, W, fr, fq);
        }
        const float inv0 = 1.0f / l0r, inv1 = 1.0f / l1r;
        const int ts = ltid();
        const int fqs = (ts & 63) >> 4;
        const int tqs = b * 2048 + c * 64 + 16 * (ts >> 6) + (ts & 15);
#pragma unroll
        for (int me = 0; me < 4; ++me) {
            u32x2 u; u.x = pack2(O0[me][0] * inv0, O0[me][1] * inv0); u.y = pack2(O0[me][2] * inv0, O0[me][3] * inv0);
            *(u32x2*)(QA + (size_t)tqs * 512 + h0 * 64 + me * 16 + 4 * fqs) = u;
            u32x2 v; v.x = pack2(O1[me][0] * inv1, O1[me][1] * inv1); v.y = pack2(O1[me][2] * inv1, O1[me][3] * inv1);
            *(u32x2*)(QA + (size_t)tqs * 512 + (h0 + 1) * 64 + me * 16 + 4 * fqs) = v;
        }
    }
}

__device__ __forceinline__ void ph_merge(const Params& p, unsigned char* smem) {
    bf16_t* sT = (bf16_t*)smem;
    const int tid = ltid(), lane = tid & 63, wid = __builtin_amdgcn_readfirstlane(tid >> 6), wr = wid >> 1, wc = wid & 1, fr = lane & 15, fq = lane >> 4;
    unsigned char* r1 = p.ws + OFF_R1;
    const bf16_t* WB = (const bf16_t*)(p.ws + OFF_WB);
    const bf16_t* GATES = (const bf16_t*)(r1 + R1_GATES);
    bf16_t* MG = (bf16_t*)(p.ws + OFF_H);
    const int xcd = blockIdx.x & 7, jb = blockIdx.x >> 3, nper = gridDim.x >> 3;
    for (int q = jb; q < 256; q += nper) {
        const int nt = q >> 4, mtl = q & 15;
        const int mt = 16 * xcd + mtl, m0 = mt * 128, n0 = nt * 64;
        f32x4 macc[4][2];
        zero_acc<2>(macc);
#pragma unroll 1
        for (int br = 0; br < 3; ++br) {
            const bf16_t* A = (const bf16_t*)(r1 + (br == 0 ? R1_QA : (br == 1 ? R1_QB : R1_GC)));
            const int K = (br == 2) ? 1024 : 512;
            const bf16_t* Bt = WB + (br == 0 ? WB_WOA : (br == 1 ? WB_WOB : WB_WOC));
            unsigned ao[4], bo[2];
#pragma unroll
            for (int i = 0; i < 4; ++i) ao[i] = (unsigned)(m0 + stg_row(tid, i, 4)) * (unsigned)K + stg_chunk(tid, i) * 8;
#pragma unroll
            for (int i = 0; i < 2; ++i) bo[i] = (unsigned)(n0 + stg_row(tid, i, 2)) * (unsigned)K + stg_chunk(tid, i) * 8;
            f32x4 acc[4][2];
            zero_acc<2>(acc);
            gemm_kloop2<2>(acc, A, ao, Bt, bo, K, smem, tid);
            {
                const int bb = m0 >> 11, s0 = (m0 & 2047) + wr * 64 + fq * 4;
#pragma unroll
                for (int n = 0; n < 2; ++n) {
                    const bf16_t* gp = GATES + ((size_t)bb * 3072 + br * 1024 + n0 + wc * 32 + n * 16 + fr) * 2048 + s0;
#pragma unroll
                    for (int m = 0; m < 4; ++m) {
                        const u32x2 gu = *(const u32x2*)(gp + m * 16);
                        macc[m][n][0] += __uint_as_float(gu.x << 16) * acc[m][n][0];
                        macc[m][n][1] += __uint_as_float(gu.x & 0xffff0000u) * acc[m][n][1];
                        macc[m][n][2] += __uint_as_float(gu.y << 16) * acc[m][n][2];
                        macc[m][n][3] += __uint_as_float(gu.y & 0xffff0000u) * acc[m][n][3];
                    }
                }
            }
        }
        __syncthreads();
        lds_put_tile<2>(sT, macc, wr, wc, fr, fq);
        __syncthreads();
#pragma unroll
        for (int i = 0; i < 4; ++i) {
            const int c = tid + 256 * i, row = c >> 3, ch = c & 7;
            *(u32x4*)(MG + (size_t)(m0 + row) * 1024 + n0 + ch * 8) = *(const u32x4*)(sT + row * LDE + ch * 8);
        }
    }
}

__device__ __forceinline__ void ph_outproj(const Params& p, unsigned char* smem) {
    bf16_t* sT = (bf16_t*)smem;
    const int tid = ltid(), lane = tid & 63, wid = __builtin_amdgcn_readfirstlane(tid >> 6), wr = wid >> 1, wc = wid & 1, fr = lane & 15, fq = lane >> 4;
    const bf16_t* MG = (const bf16_t*)(p.ws + OFF_H);
    const bf16_t* Bt = (const bf16_t*)(p.ws + OFF_WB) + WB_WOUT;
    bf16_t* Y = (bf16_t*)(p.ws + OFF_R1 + R1_QC);
    for (int tile = blockIdx.x; tile < 128 * 8; tile += gridDim.x) {
        const int mt = tile >> 3, nt = tile & 7, m0 = mt * 128, n0 = nt * 128;
        unsigned ao[4], bo[4];
#pragma unroll
        for (int i = 0; i < 4; ++i) {
            const int R = stg_row(tid, i, 4), g = stg_chunk(tid, i);
            ao[i] = (unsigned)(m0 + R) * 1024u + g * 8;
            bo[i] = (unsigned)(n0 + R) * 1024u + g * 8;
        }
        f32x4 acc[4][4];
        zero_acc<4>(acc);
        gemm_kloop2<4>(acc, MG, ao, Bt, bo, 1024, smem, tid);
        __syncthreads();
        lds_put_tile<4>(sT, acc, wr, wc, fr, fq);
        __syncthreads();
#pragma unroll
        for (int i = 0; i < 8; ++i) {
            const int c = tid + 256 * i, row = c >> 4, ch = c & 15;
            *(u32x4*)(Y + (size_t)(m0 + row) * 1024 + n0 + ch * 8) = *(const u32x4*)(sT + row * LDE + ch * 8);
        }
    }
}

__device__ __forceinline__ void ph_router(const Params& p, int l, unsigned char* smem) {
    const int tid = ltid(), lane = tid & 63, wid = __builtin_amdgcn_readfirstlane(tid >> 6), wr = wid >> 1, wc = wid & 1, fr = lane & 15, fq = lane >> 4;
    const bf16_t* H = (const bf16_t*)(p.ws + OFF_H);
    const bf16_t* Bt = (const bf16_t*)(p.ws + OFF_WB) + WB_WR;
    int* cnt = (int*)(p.ws + OFF_CTL) + l * 64;
    int* LIST = (int*)(p.ws + OFF_LIST);
    float* AW = (float*)(p.ws + OFF_AW);
    const float* bias = p.router_bias + l * 64;
    float* lg = (float*)smem;
    for (int mt = blockIdx.x; mt < 128; mt += gridDim.x) {
        const int m0 = mt * 128;
        unsigned ao[4], bo[4];
#pragma unroll
        for (int i = 0; i < 4; ++i) {
            const int R = stg_row(tid, i, 4), g = stg_chunk(tid, i);
            ao[i] = (unsigned)(m0 + R) * 1024u + g * 8;
            bo[i] = (unsigned)R * 1024u + g * 8;
        }
        f32x4 acc[4][4];
        zero_acc<4>(acc);
        gemm_kloop2<4>(acc, H, ao, Bt, bo, 1024, smem, tid);
        __syncthreads();
        if (wc == 0) {
#pragma unroll
            for (int m = 0; m < 4; ++m)
#pragma unroll
                for (int j = 0; j < 4; ++j)
#pragma unroll
                    for (int n = 0; n < 4; ++n) lg[(wr * 64 + m * 16 + fq * 4 + j) * 65 + n * 16 + fr] = acc[m][n][j];
        }
        __syncthreads();
        if (tid < 128) {
            float* row = lg + tid * 65;
            const int t = m0 + tid;
            float gs[8];
#pragma unroll
            for (int g = 0; g < 8; ++g) {
                float m1 = -__builtin_inff(), m2 = -__builtin_inff();
#pragma unroll
                for (int e = 0; e < 8; ++e) {
                    const float v = sigmoidf_(row[g * 8 + e]) + bias[g * 8 + e];
                    row[g * 8 + e] = v;
                    if (v > m1) { m2 = m1; m1 = v; } else if (v > m2) m2 = v;
                }
                gs[g] = m1 + m2;
            }
            unsigned gmask = 0u;
#pragma unroll
            for (int g = 0; g < 8; ++g) {
                int rank = 0;
#pragma unroll
                for (int g2 = 0; g2 < 8; ++g2) rank += (gs[g2] > gs[g] || (gs[g2] == gs[g] && g2 < g)) ? 1 : 0;
                if (rank < 4) gmask |= 1u << g;
            }
            unsigned long long taken = 0ull;
            int eidx[8]; float esc[8];
            float ssum = 0.f;
#pragma unroll
            for (int k = 0; k < 8; ++k) {
                float best = -__builtin_inff(); int bi = 0;
                for (int e = 0; e < 64; ++e) {
                    if (!((gmask >> (e >> 3)) & 1u) || ((taken >> e) & 1ull)) continue;
                    const float v = row[e];
                    if (v > best) { best = v; bi = e; }
                }
                taken |= 1ull << bi;
                eidx[k] = bi;
                esc[k] = best - bias[bi];
                ssum += esc[k];
            }
            const float scale = 2.5f / ssum;
            int slot[8];
#pragma unroll
            for (int k = 0; k < 8; ++k) slot[k] = atomicAdd(&cnt[eidx[k]], 1);
#pragma unroll
            for (int k = 0; k < 8; ++k) {
                LIST[(size_t)eidx[k] * T_ + slot[k]] = t * 8 + k;
                AW[(size_t)t * 8 + k] = esc[k] * scale;
            }
        }
        __syncthreads();
    }
}

struct __attribute__((aligned(16))) MoeLds { int tstart[66]; int xs[10]; int pad0[20]; int hbase[66]; int pad1[14]; int rowid[128]; };
__device__ __forceinline__ void moe_setup(MoeLds& sm, const int* cnt, int tid) {
    __syncthreads();
    if (tid == 0) {
        int ts = 0, hb = 0;
        for (int e = 0; e < 65; ++e) {
            const int ce = (e < 64) ? cnt[e] : T_;
            sm.tstart[e] = ts; sm.hbase[e] = hb;
            ts += (ce + 127) >> 7; hb += ce;
        }
        sm.tstart[65] = ts; sm.hbase[65] = hb;
        const int xcd = blockIdx.x & 7;
        int acc = 0;
        for (int k = 0; k < 8; ++k) { sm.xs[k] = acc; acc += sm.tstart[k * 8 + xcd + 1] - sm.tstart[k * 8 + xcd]; }
        sm.xs[8] = acc; acc += 16; sm.xs[9] = acc;
    }
    __syncthreads();
}

__device__ __forceinline__ void ph_moe1(const Params& p, int l, unsigned char* smem) {
    MoeLds& sm = *(MoeLds*)(smem + MISC + 64);
    const int tid = ltid(), lane = tid & 63, wid = __builtin_amdgcn_readfirstlane(tid >> 6), wr = wid >> 1, wc = wid & 1, fr = lane & 15, fq = lane >> 4;
    const bf16_t* H = (const bf16_t*)(p.ws + OFF_H);
    const bf16_t* W13 = (const bf16_t*)(p.ws + OFF_WB) + WB_W13;
    const int* cnt = (const int*)(p.ws + OFF_CTL) + l * 64;
    const int* LIST = (const int*)(p.ws + OFF_LIST);
    bf16_t* HID = (bf16_t*)(p.ws + OFF_R3);
    moe_setup(sm, cnt, tid);
    const int xcd = blockIdx.x & 7, jb = blockIdx.x >> 3, nper = gridDim.x >> 3;
    const int nitems = sm.xs[9] * 4;
    for (int item = jb; item < nitems; item += nper) {
        const int rtl = item >> 2, nt = item & 3;
        int k = 0;
        while (sm.xs[k + 1] <= rtl) ++k;
        const int e = (k < 8) ? (k * 8 + xcd) : 64;
        const int mtl = rtl - sm.xs[k] + ((k == 8) ? 16 * xcd : 0);
        const int ce = (e < 64) ? cnt[e] : T_;
        __syncthreads();
        if (tid < 128) {
            const int slot = mtl * 128 + tid;
            int tok = 0;
            if (slot < ce) tok = (e < 64) ? (LIST[(size_t)e * T_ + slot] >> 3) : slot;
            sm.rowid[tid] = tok;
        }
        __syncthreads();
        unsigned ao[4], bo[4];
#pragma unroll
        for (int i = 0; i < 4; ++i) {
            const int R = stg_row(tid, i, 4), g = stg_chunk(tid, i);
            ao[i] = (unsigned)sm.rowid[R] * 1024u + g * 8;
            bo[i] = (unsigned)(e * 512 + nt * 128 + R) * 1024u + g * 8;
        }
        f32x4 acc[4][4];
        zero_acc<4>(acc);
        gemm_kloop2<4>(acc, H, ao, W13, bo, 1024, smem, tid);
        const int hb = sm.hbase[e] + mtl * 128;
        f32x4 hacc[4][2];
#pragma unroll
        for (int m = 0; m < 4; ++m)
#pragma unroll
            for (int nn = 0; nn < 2; ++nn)
#pragma unroll
                for (int j = 0; j < 4; ++j) hacc[m][nn][j] = siluf_(acc[m][nn][j]) * acc[m][nn + 2][j];
        bf16_t* sT = (bf16_t*)smem;
        __syncthreads();
        lds_put_tile<2>(sT, hacc, wr, wc, fr, fq);
        __syncthreads();
        const int ts = ltid();
#pragma unroll
        for (int i = 0; i < 4; ++i) {
            const int c = ts + 256 * i, row = c >> 3, ch = c & 7;
            if (mtl * 128 + row < ce)
                *(u32x4*)(HID + (size_t)(hb + row) * 256 + nt * 64 + ch * 8) = *(const u32x4*)(sT + row * LDE + ch * 8);
        }
    }
}

__device__ __forceinline__ void ph_moe2(const Params& p, int l, unsigned char* smem) {
    MoeLds& sm = *(MoeLds*)(smem + MISC + 64);
    const int tid = ltid(), lane = tid & 63, wid = __builtin_amdgcn_readfirstlane(tid >> 6), wr = wid >> 1, wc = wid & 1, fr = lane & 15, fq = lane >> 4;
    const bf16_t* W2 = (const bf16_t*)(p.ws + OFF_WB) + WB_W2;
    const int* cnt = (const int*)(p.ws + OFF_CTL) + l * 64;
    const int* LIST = (const int*)(p.ws + OFF_LIST);
    const float* AW = (const float*)(p.ws + OFF_AW);
    const bf16_t* HID = (const bf16_t*)(p.ws + OFF_R3);
    bf16_t* SLOTS = (bf16_t*)(p.ws + OFF_R1);
    moe_setup(sm, cnt, tid);
    const int xcd = blockIdx.x & 7, jb = blockIdx.x >> 3, nper = gridDim.x >> 3;
    const int nitems = sm.xs[9] * 8;
    for (int item = jb; item < nitems; item += nper) {
        const int rtl = item >> 3, nt = item & 7;
        int k = 0;
        while (sm.xs[k + 1] <= rtl) ++k;
        const int e = (k < 8) ? (k * 8 + xcd) : 64;
        const int mtl = rtl - sm.xs[k] + ((k == 8) ? 16 * xcd : 0);
        const int ce = (e < 64) ? cnt[e] : T_;
        __syncthreads();
        if (tid < 128) {
            const int slot = mtl * 128 + tid;
            int aid = -1;
            if (slot < ce) aid = (e < 64) ? LIST[(size_t)e * T_ + slot] : (8 * T_ + slot);
            sm.rowid[tid] = aid;
        }
        __syncthreads();
        const int hb = sm.hbase[e] + mtl * 128;
        unsigned ao[4], bo[4];
#pragma unroll
        for (int i = 0; i < 4; ++i) {
            const int R = stg_row(tid, i, 4), g = stg_chunk(tid, i);
            ao[i] = (unsigned)(hb + R) * 256u + g * 8;
            bo[i] = (unsigned)(e * 1024 + nt * 128 + R) * 256u + g * 8;
        }
        f32x4 acc[4][4];
        zero_acc<4>(acc);
        gemm_kloop2<4>(acc, HID, ao, W2, bo, 256, smem, tid);
        const int ts = ltid();
        const int fqs = (ts & 63) >> 4;
#pragma unroll
        for (int m = 0; m < 4; ++m)
#pragma unroll
            for (int j = 0; j < 4; ++j) {
                const int r = wr * 64 + m * 16 + fqs * 4 + j;
                const int aid = sm.rowid[r];
                const float wt = (aid >= 0 && e < 64) ? AW[aid] : 1.0f;
#pragma unroll
                for (int n = 0; n < 4; ++n) acc[m][n][j] *= wt;
            }
        bf16_t* sT = (bf16_t*)smem;
        __syncthreads();
        lds_put_tile<4>(sT, acc, wr, wc, fr, fq);
        __syncthreads();
#pragma unroll
        for (int i = 0; i < 8; ++i) {
            const int c = ts + 256 * i, row = c >> 4, ch = c & 15;
            const int aid = sm.rowid[row];
            if (aid >= 0)
                __builtin_nontemporal_store(*(const u32x4*)(sT + row * LDE + ch * 8), (u32x4*)(SLOTS + (size_t)aid * 1024 + nt * 128 + ch * 8));
        }
    }
}

struct JobDesc { int K, NQ, src_ld, dst_ld, mode, p0, nbatch, which; unsigned src_lstride, src_bs, dst_bs, dst_off; };
constexpr int NJOBS = 12;
__constant__ JobDesc JOBS[NJOBS] = {
    {1024, 8832, NIN_, 1024, 1, 0, 1, 9, 1024u * NIN_, 0u, 0u, (unsigned)WB_WIN},
    {512, 1024, 1024, 512, 0, 0, 1, 14, 512u * 1024u, 0u, 0u, (unsigned)WB_WOA},
    {512, 1024, 1024, 512, 0, 0, 1, 15, 512u * 1024u, 0u, 0u, (unsigned)WB_WOB},
    {1024, 1024, 1024, 1024, 0, 0, 1, 16, 1024u * 1024u, 0u, 0u, (unsigned)WB_WOC},
    {1024, 1024, 1024, 1024, 0, 0, 1, 17, 1024u * 1024u, 0u, 0u, (unsigned)WB_WOUT},
    {1024, 128, 64, 1024, 3, 0, 1, 18, 1024u * 64u, 0u, 0u, (unsigned)WB_WR},
    {1024, 256, 256, 1024, 2, 0, 64, 20, 64u * 1024u * 256u, 1024u * 256u, 512u * 1024u, (unsigned)WB_W13},
    {1024, 256, 256, 1024, 2, 32, 64, 21, 64u * 1024u * 256u, 1024u * 256u, 512u * 1024u, (unsigned)WB_W13},
    {1024, 256, 256, 1024, 2, 0, 1, 23, 1024u * 256u, 0u, 0u, (unsigned)(WB_W13 + (size_t)64 * 512 * 1024)},
    {1024, 256, 256, 1024, 2, 32, 1, 24, 1024u * 256u, 0u, 0u, (unsigned)(WB_W13 + (size_t)64 * 512 * 1024)},
    {256, 1024, 1024, 256, 0, 0, 64, 22, 64u * 256u * 1024u, 256u * 1024u, 1024u * 256u, (unsigned)WB_W2},
    {256, 1024, 1024, 256, 0, 0, 1, 25, 256u * 1024u, 0u, 0u, (unsigned)(WB_W2 + (size_t)64 * 1024 * 256)},
};
__constant__ int JOBPRE[NJOBS + 1] = {0, 2208, 2336, 2464, 2720, 2976, 3008, 7104, 11200, 11264, 11328, 15424, 15488};
__device__ __forceinline__ TJob make_job(const Params& p, int l, int it, int& base) {
    int j = 0;
    while (JOBPRE[j + 1] <= it) ++j;
    const JobDesc d = JOBS[j];
    TJob tj;
    tj.src = ((const float* const*)&p)[d.which] + (size_t)l * d.src_lstride;
    tj.dst = (bf16_t*)(p.ws + OFF_WB) + d.dst_off;
    tj.K = d.K; tj.NQ = d.NQ; tj.src_ld = d.src_ld; tj.dst_ld = d.dst_ld; tj.mode = d.mode; tj.p0 = d.p0; tj.nbatch = d.nbatch; tj.pad = 0;
    tj.src_bs = d.src_bs; tj.dst_bs = d.dst_bs;
    base = JOBPRE[j];
    return tj;
}
__device__ __forceinline__ void tconv_range(const Params& p, int l, unsigned char* smem, int first, int stride, int it0, int it1) {
    float* tile = (float*)smem;
    const int tid = ltid();
    const int total = it1;
    __syncthreads();
    int it = it0 + first;
    f32x4 r[4];
    if (it < total) { int base; const TJob tj = make_job(p, l, it, base); tconv_load(tj, it - base, tid, r); }
    while (it < total) {
        const int nxt = it + stride;
        tconv_put(tid, r, tile);
        __syncthreads();
        if (nxt < total) { int base; const TJob tj = make_job(p, l, nxt, base); tconv_load(tj, nxt - base, tid, r); }
        { int base; const TJob tj = make_job(p, l, it, base); tconv_emit(tj, it - base, tid, tile); }
        __syncthreads();
        it = nxt;
    }
}

constexpr int TC_MIX_END = 3008;
__device__ __forceinline__ void ph_tconv_mix(const Params& p, int l, unsigned char* smem) { tconv_range(p, l, smem, blockIdx.x, gridDim.x, 0, TC_MIX_END); }
constexpr int SMEM_BYTES = DYN_LDS;
__device__ __forceinline__ int next_item(int* ctr, unsigned char* smem) {
    int* s_item = (int*)(smem + MISC);
    __syncthreads();
    if (ltid() == 0) *s_item = atomicAdd(ctr, 1);
    __syncthreads();
    return *s_item;
}
__device__ __forceinline__ void ph_mix1(const Params& p, int l, unsigned char* smem) {
    int* ctr = (int*)(p.ws + OFF_CTL) + 256 + l * 4;
    const bool tc_first = (int)blockIdx.x >= (int)(gridDim.x >> 1);
    if (tc_first)
        for (;;) { const int it = next_item(ctr + 3, smem); if (it >= 390) break;
            const int a0 = TC_MIX_END + it * 32; tconv_range(p, l, smem, 0, 1, a0, (a0 + 32 < JOBPRE[NJOBS]) ? a0 + 32 : JOBPRE[NJOBS]); }
    for (;;) { const int it = next_item(ctr + 0, smem); if (it >= 2048) break; mixc1_item(p, it, smem); }
    for (;;) { const int it = next_item(ctr + 1, smem); if (it >= 1024) break; mixb_item(p, it, smem); }
    for (;;) { const int it = next_item(ctr + 2, smem); if (it >= 1024) break; mixa1_item(p, it, smem); }
    if (!tc_first)
        for (;;) { const int it = next_item(ctr + 3, smem); if (it >= 390) break;
            const int a0 = TC_MIX_END + it * 32; tconv_range(p, l, smem, 0, 1, a0, (a0 + 32 < JOBPRE[NJOBS]) ? a0 + 32 : JOBPRE[NJOBS]); }
}


constexpr size_t OFF_BAR = 16 * KiB;
#define XB_TMO      128
#define XB_XCNT(j)  (256  + 64 * (j))
#define XB_XSUB(j)  (1280 + 64 * (j))
#define XB_XGEN(j)  (2304 + 64 * (j))
#define XB_TOP      3328
#define XB_TOPGEN   3392
#define XCD_BAR_WORDS 3456
#define XB_SPIN_CAP (1u << 18)
__device__ __forceinline__ unsigned xb_ld(unsigned* p)              { return __hip_atomic_load(p, __ATOMIC_RELAXED, __HIP_MEMORY_SCOPE_AGENT); }
__device__ __forceinline__ unsigned xb_add(unsigned* p, unsigned v) { return __hip_atomic_fetch_add(p, v, __ATOMIC_RELAXED, __HIP_MEMORY_SCOPE_AGENT); }
__device__ __forceinline__ unsigned xb_xcc_id() { return (unsigned)__builtin_amdgcn_s_getreg((3 << 11) | 20) & 0xFu; }
#define XB_SPIN(cond, bar) do { unsigned _sp = 0; while (cond) { __builtin_amdgcn_s_sleep(1); \
    if ((++_sp & 255u) == 0u) { if (xb_ld(&(bar)[XB_TMO])) break; if (_sp > XB_SPIN_CAP) { atomicAdd(&(bar)[XB_TMO], 1u); break; } } } } while (0)
__device__ __forceinline__ void xcd_barrier_post(unsigned* bar) {
    if (threadIdx.x == 0) (void)xb_add(&bar[XB_XCNT(xb_xcc_id())], 1u);
}
__device__ __forceinline__ void xcd_barrier_complete(unsigned* bar, unsigned x, unsigned& nloc, unsigned& nx) {
    const unsigned G = gridDim.x * gridDim.y * gridDim.z;
    unsigned sum, cnt, mine, sp = 0u;
    for (;;) {
        sum = 0u; cnt = 0u; mine = 0u;
#pragma unroll
        for (unsigned j = 0; j < 16; ++j) { const unsigned c = xb_ld(&bar[XB_XCNT(j)]); sum += c; cnt += (c > 0u) ? 1u : 0u; mine = (j == x) ? c : mine; }
        if (sum == G) break;
        __builtin_amdgcn_s_sleep(1);
        if ((++sp & 255u) == 0u) { if (xb_ld(&bar[XB_TMO])) break; if (sp > XB_SPIN_CAP) { atomicAdd(&bar[XB_TMO], 1u); break; } }
    }
    nloc = mine > 0u ? mine : 1u; nx = cnt > 0u ? cnt : 1u;
}
__device__ __forceinline__ void xcd_barrier(unsigned* bar, volatile LAS unsigned* st) {
    asm volatile("s_waitcnt vmcnt(0)" ::: "memory");
    __syncthreads();
    if (threadIdx.x == 0) {
        const unsigned x = xb_xcc_id();
        __builtin_amdgcn_s_waitcnt(0);
        unsigned nloc = st[0], nx = st[1];
        if (nloc == 0u) { xcd_barrier_complete(bar, x, nloc, nx); st[0] = nloc; st[1] = nx; }
        const unsigned old = xb_add(&bar[XB_XSUB(x)], 1u);
        const unsigned gen = old / nloc;
        if (old + 1u == (gen + 1u) * nloc) {
            __builtin_amdgcn_fence(__ATOMIC_RELEASE, "agent");
            asm volatile("s_waitcnt vmcnt(0)" ::: "memory");
            const unsigned og = xb_add(&bar[XB_TOP], 1u);
            const unsigned tg = og / nx;
            if (og + 1u == (tg + 1u) * nx) xb_add(&bar[XB_TOPGEN], 1u);
            else XB_SPIN(xb_ld(&bar[XB_TOPGEN]) == tg, bar);
            __builtin_amdgcn_fence(__ATOMIC_ACQUIRE, "agent");
            xb_add(&bar[XB_XGEN(x)], 1u);
            asm volatile("s_waitcnt vmcnt(0)" ::: "memory");
        } else {
            XB_SPIN(xb_ld(&bar[XB_XGEN(x)]) == gen, bar);
            __builtin_amdgcn_fence(__ATOMIC_ACQUIRE, "agent");
            asm volatile("s_waitcnt vmcnt(0)" ::: "memory");
        }
    }
    __syncthreads();
}

#define LAUNDER()
__global__ void __launch_bounds__(256, 3) mega(Params p_unused) {
    extern __shared__ __attribute__((aligned(16))) unsigned char smem[];
    if (threadIdx.x == 0) *(u32x4*)(smem + MISC + 16) = (u32x4){0u, 0u, 0u, 0u};
    __syncthreads();
    xcd_barrier_post((unsigned*)(getp().ws + OFF_BAR));
#define GSYNC() xcd_barrier((unsigned*)(getp().ws + OFF_BAR), (volatile LAS unsigned*)(smem + MISC + 16))

    ph_rope(getp());
    ph_mod(getp(), smem);
    ph_tconv_mix(getp(), 0, smem);
    ph_wcomp(getp(), 0, smem);
    GSYNC();
    {
        const Params& p = getp();
        const float* mod = (const float*)(p.ws + OFF_MOD);
        NormArgs a;
        a.xin = p.x; a.Y = nullptr; a.slots = nullptr; a.gpost = nullptr; a.gt = nullptr;
        a.mode = 0; a.gpre = p.g_pre_mix; a.sc = mod + 1024; a.sh = mod + 0;
        ph_norm(p, a);
    }
    GSYNC();
#pragma unroll 1
    for (int l = 0; l < DEPTH_; ++l) {
        ph_gemm_z(getp(), smem);
        GSYNC();
        ph_mix1(getp(), l, smem);
        GSYNC();
        ph_mixc2(getp());
        ph_mix_a2(getp(), smem);
        GSYNC();
        { const Params& p = getp(); for (int it = blockIdx.x; it < 2048; it += gridDim.x) mixc3_item(p, l, it, smem); }
        GSYNC();
        ph_merge(getp(), smem);
        GSYNC();
        ph_outproj(getp(), smem);
        GSYNC();
        {
            const Params& p = getp();
        const float* mod = (const float*)(p.ws + OFF_MOD);
        NormArgs a;
            a.xin = nullptr; a.slots = nullptr;
            a.mode = 1; a.Y = (const bf16_t*)(p.ws + OFF_R1 + R1_QC);
            a.gpost = p.g_post_mix + l * 1024; a.gt = mod + (size_t)l * 8 * 6144 + 2048;
            a.gpre = p.g_pre_ffn + l * 1024; a.sc = mod + (size_t)l * 8 * 6144 + 4096; a.sh = mod + (size_t)l * 8 * 6144 + 3072;
            ph_norm(p, a);
        }
        GSYNC();
        ph_router(getp(), l, smem);
        GSYNC();
        ph_moe1(getp(), l, smem);
        GSYNC();
        ph_moe2(getp(), l, smem);
        GSYNC();
        {
            const Params& p = getp();
        const float* mod = (const float*)(p.ws + OFF_MOD);
        NormArgs a;
            a.xin = nullptr; a.Y = nullptr;
            a.mode = 2; a.slots = (const bf16_t*)(p.ws + OFF_R1);
            a.gpost = p.g_post_ffn + l * 1024; a.gt = mod + (size_t)l * 8 * 6144 + 5120;
            a.gpre = nullptr; a.sc = nullptr; a.sh = nullptr;
            if (l + 1 < DEPTH_) { a.gpre = p.g_pre_mix + (l + 1) * 1024; a.sc = mod + (size_t)(l + 1) * 8 * 6144 + 1024; a.sh = mod + (size_t)(l + 1) * 8 * 6144 + 0; }
            ph_norm(p, a);
        }
        if (l + 1 < DEPTH_) {
            ph_tconv_mix(getp(), l + 1, smem);
            ph_wcomp(getp(), l + 1, smem);
            GSYNC();
        }
    }
}

extern "C" void kernel_launch(void* const* d_in, const int* in_sizes, int n_in, void* d_out, int out_size, void* d_ws, size_t ws_size, hipStream_t stream) {
    if (n_in < 26 || ws_size < WS_TOTAL) { fprintf(stderr, "kernel_launch: bad inputs / workspace too small (%zu < %zu)\n", ws_size, (size_t)WS_TOTAL); return; }
    Params p;
    memset(&p, 0, sizeof(p));
    p.x = (const float*)d_in[0]; p.c = (const float*)d_in[1]; p.positions = (const int*)d_in[2]; p.ada_w = (const float*)d_in[3]; p.ada_b = (const float*)d_in[4];
    p.g_pre_mix = (const float*)d_in[5]; p.g_post_mix = (const float*)d_in[6]; p.g_pre_ffn = (const float*)d_in[7]; p.g_post_ffn = (const float*)d_in[8];
    p.w_in = (const float*)d_in[9]; p.g_kv = (const float*)d_in[10]; p.w_uk = (const float*)d_in[11]; p.w_uv = (const float*)d_in[12]; p.g_ret = (const float*)d_in[13];
    p.w_o_a = (const float*)d_in[14]; p.w_o_b = (const float*)d_in[15]; p.w_o_c = (const float*)d_in[16]; p.w_out = (const float*)d_in[17];
    p.w_router = (const float*)d_in[18]; p.router_bias = (const float*)d_in[19]; p.w1 = (const float*)d_in[20]; p.w3 = (const float*)d_in[21]; p.w2 = (const float*)d_in[22];
    p.ws1 = (const float*)d_in[23]; p.ws3 = (const float*)d_in[24]; p.ws2 = (const float*)d_in[25];
    p.out = (float*)d_out; p.ws = (unsigned char*)d_ws;
    static int grid_blocks = 0;
    if (!grid_blocks) {
        int dev = 0, cus = 0, per_cu = 0;
        (void)hipGetDevice(&dev);
        (void)hipDeviceGetAttribute(&cus, hipDeviceAttributeMultiprocessorCount, dev);
        (void)hipFuncSetAttribute((const void*)mega, hipFuncAttributeMaxDynamicSharedMemorySize, DYN_LDS);
        (void)hipOccupancyMaxActiveBlocksPerMultiprocessor(&per_cu, mega, 256, DYN_LDS);
        if (per_cu < 1) per_cu = 1;
        if (per_cu > 3) per_cu = 3;
        grid_blocks = cus * per_cu;
    }
    (void)hipMemsetAsync((unsigned char*)d_ws + OFF_CTL, 0, 32 * 1024, stream);
    void* args[] = {&p};
    hipError_t e = hipLaunchCooperativeKernel((void*)mega, dim3(grid_blocks), dim3(256), args, DYN_LDS, stream);
    if (e != hipSuccess) fprintf(stderr, "cooperative launch failed: %s (grid %d)\n", hipGetErrorString(e), grid_blocks);
}
```

```cpp
#include <hip/hip_runtime.h>
#include <hip/hip_cooperative_groups.h>
namespace cg = cooperative_groups;
#include <stdint.h>
#include <stdio.h>
#include <string.h>

typedef unsigned short bf16_t;
typedef short bf16x8 __attribute__((ext_vector_type(8)));
typedef short bf16x4 __attribute__((ext_vector_type(4)));
typedef float f32x4 __attribute__((ext_vector_type(4)));
typedef float f32x2 __attribute__((ext_vector_type(2)));
typedef unsigned u32x4 __attribute__((ext_vector_type(4)));
typedef unsigned u32x2 __attribute__((ext_vector_type(2)));

constexpr int T_ = 16384, S_ = 2048, NB_ = 8, D_ = 1024, DEPTH_ = 2;
constexpr int NIN_ = 8772;
constexpr int NZ_ = 8960;
constexpr float EPS_ = 1e-6f;

constexpr int C_QA = 0, C_CKV = 512, C_IQ = 768, C_IK = 1024, C_IW = 1088, C_QB = 1152, C_KB = 1664, C_VB = 2176,
              C_QC = 2688, C_KC = 3200, C_VC = 3712, C_GC = 4736, C_GATES = 5760, C_KA = 8832, C_VA = 8896;

constexpr size_t KiB = 1024, MiB = 1024 * 1024;
constexpr size_t OFF_CTL = 0;
constexpr size_t OFF_MOD = 64 * KiB;
constexpr size_t OFF_IW = 512 * KiB;
constexpr size_t OFF_CKVSS = 768 * KiB;
constexpr size_t OFF_AW = 1 * MiB;
constexpr size_t OFF_ROPE = 2 * MiB;
constexpr size_t OFF_LIST = 6 * MiB;
constexpr size_t OFF_MASKB = 10 * MiB;
constexpr size_t OFF_WB = 14 * MiB;
constexpr size_t WB_WIN = 0;
constexpr size_t WB_WOA = WB_WIN + (size_t)NZ_ * 1024;
constexpr size_t WB_WOB = WB_WOA + 1024 * 512;
constexpr size_t WB_WOC = WB_WOB + 1024 * 512;
constexpr size_t WB_WOUT = WB_WOC + 1024 * 1024;
constexpr size_t WB_WR = WB_WOUT + 1024 * 1024;
constexpr size_t WB_W13 = WB_WR + 128 * 1024;
constexpr size_t WB_W2 = WB_W13 + (size_t)65 * 512 * 1024;
constexpr size_t WB_END = WB_W2 + (size_t)65 * 1024 * 256;
constexpr size_t OFF_H = OFF_WB + ((WB_END * 2 + MiB - 1) / MiB) * MiB;
constexpr size_t OFF_R1 = OFF_H + 32 * MiB;
constexpr size_t R1_QA = 0;
constexpr size_t R1_IQ = R1_QA + 16 * MiB;
constexpr size_t R1_IK = R1_IQ + 8 * MiB;
constexpr size_t R1_KA = R1_IK + 2 * MiB;
constexpr size_t R1_VAT = R1_KA + 2 * MiB;
constexpr size_t R1_QB = R1_VAT + 2 * MiB;
constexpr size_t R1_KB = R1_QB + 16 * MiB;
constexpr size_t R1_VBT = R1_KB + 16 * MiB;
constexpr size_t R1_QC = R1_VBT + 16 * MiB;
constexpr size_t R1_KC = R1_QC + 16 * MiB;
constexpr size_t R1_KCT = R1_KC + 16 * MiB;
constexpr size_t R1_VCT = R1_KCT + 16 * MiB;
constexpr size_t R1_GC = R1_VCT + 32 * MiB;
constexpr size_t R1_GATES = R1_GC + 32 * MiB;
constexpr size_t R1_ZEND = R1_GATES + 96 * MiB;
constexpr size_t R1_SIZE = 288 * MiB;
constexpr size_t OFF_R3 = OFF_R1 + R1_SIZE;
constexpr size_t R3_SIZE = 78 * MiB;
constexpr size_t WS_TOTAL = OFF_R3 + R3_SIZE;
static_assert(R1_ZEND <= R1_SIZE, "r1");
constexpr size_t SC_PER_BATCH = 2162688;

__constant__ float INVF[32] = {
    1.000000000e+00f, 7.498942614e-01f, 5.623413324e-01f, 4.216965139e-01f, 3.162277639e-01f, 2.371373773e-01f, 1.778279394e-01f, 1.333521307e-01f,
    1.000000015e-01f, 7.498941571e-02f, 5.623413250e-02f, 4.216965288e-02f, 3.162277490e-02f, 2.371373773e-02f, 1.778279431e-02f, 1.333521493e-02f,
    9.999999776e-03f, 7.498941850e-03f, 5.623413250e-03f, 4.216964822e-03f, 3.162277630e-03f, 2.371373586e-03f, 1.778279431e-03f, 1.333521446e-03f,
    1.000000047e-03f, 7.498942432e-04f, 5.623413017e-04f, 4.216965172e-04f, 3.162277571e-04f, 2.371373703e-04f, 1.778279402e-04f, 1.333521504e-04f};

__constant__ float LOGG[8] = {-0.0317486983145803f, -0.015748356968139168f, -0.007843177461025893f, -0.003913899321136329f,
                               -0.0019550348358033506f, -0.0009770396478266127f, -0.0004884004981088745f, -0.0002441704321739145f};

__device__ __forceinline__ float bf2f(bf16_t u) { return __uint_as_float(((unsigned)u) << 16); }
__device__ __forceinline__ bf16_t f2bf(float f) {
    unsigned u = __float_as_uint(f);
    u += 0x7fffu + ((u >> 16) & 1u);
    return (bf16_t)(u >> 16);
}
__device__ __forceinline__ unsigned pack2(float a, float b) { return (unsigned)f2bf(a) | ((unsigned)f2bf(b) << 16); }
__device__ __forceinline__ float sigmoidf_(float x) { return __builtin_amdgcn_rcpf(1.0f + __expf(-x)); }
__device__ __forceinline__ float siluf_(float x) { return x * __builtin_amdgcn_rcpf(1.0f + __expf(-x)); }
__device__ __forceinline__ float wave_sum(float v) {
#pragma unroll
    for (int o = 32; o >= 1; o >>= 1) v += __shfl_xor(v, o);
    return v;
}
__device__ __forceinline__ int wave_sum_i(int v) {
#pragma unroll
    for (int o = 32; o >= 1; o >>= 1) v += __shfl_xor(v, o);
    return v;
}

struct Params {
    const float* x; const float* c; const int* positions; const float* ada_w; const float* ada_b;
    const float* g_pre_mix; const float* g_post_mix; const float* g_pre_ffn; const float* g_post_ffn;
    const float* w_in; const float* g_kv; const float* w_uk; const float* w_uv; const float* g_ret;
    const float* w_o_a; const float* w_o_b; const float* w_o_c; const float* w_out;
    const float* w_router; const float* router_bias; const float* w1; const float* w3; const float* w2;
    const float* ws1; const float* ws3; const float* ws2;
    float* out;
    unsigned char* ws;
};

__device__ __forceinline__ int cnt_ge(int cnt, unsigned key, unsigned cand) {
    asm volatile("v_cmp_ge_u32 vcc, %1, %2\n\tv_addc_co_u32 %0, vcc, 0, %0, vcc" : "+v"(cnt) : "v"(key), "v"(cand) : "vcc");
    return cnt;
}
__device__ __forceinline__ int cnt_ge_s(int cnt, unsigned key, unsigned cand) {
    asm volatile("v_cmp_ge_u32 vcc, %1, %2\n\ts_bcnt1_i32_b64 vcc_lo, vcc\n\ts_add_i32 %0, %0, vcc_lo" : "+s"(cnt) : "v"(key), "v"(cand) : "vcc", "scc");
    return cnt;
}
__device__ __forceinline__ int wave_total6(int c) {
    int t = 0;
#pragma unroll
    for (int b = 0; b < 6; ++b) t += __builtin_popcountll(__ballot((c >> b) & 1)) << b;
    return t;
}
__device__ __forceinline__ float xrow16_max(float x) {
    auto s = __builtin_amdgcn_permlane16_swap(__float_as_uint(x), __float_as_uint(x), false, false);
    x = fmaxf(__uint_as_float(s[0]), __uint_as_float(s[1]));
    auto t = __builtin_amdgcn_permlane32_swap(__float_as_uint(x), __float_as_uint(x), false, false);
    return fmaxf(__uint_as_float(t[0]), __uint_as_float(t[1]));
}
__device__ __forceinline__ float xrow16_sum(float x) {
    auto s = __builtin_amdgcn_permlane16_swap(__float_as_uint(x), __float_as_uint(x), false, false);
    x = __uint_as_float(s[0]) + __uint_as_float(s[1]);
    auto t = __builtin_amdgcn_permlane32_swap(__float_as_uint(x), __float_as_uint(x), false, false);
    return __uint_as_float(t[0]) + __uint_as_float(t[1]);
}
__device__ __forceinline__ int ltid() { int t = threadIdx.x; asm volatile("" : "+v"(t)); return t; }
typedef const Params __attribute__((address_space(4))) * KParamsPtr;
__device__ __forceinline__ const Params& getp() {
    KParamsPtr kp = (KParamsPtr)__builtin_amdgcn_kernarg_segment_ptr();
    asm volatile("" : "+s"(kp));
    return *(const Params*)kp;
}
__device__ __forceinline__ void ph_rope(const Params& p) {
    for (int idx = blockIdx.x * 256 + ltid(); idx < T_ * 32; idx += gridDim.x * 256) {
        int t = idx >> 5, i = idx & 31;
        float ang = (float)p.positions[t] * INVF[i];
        double rev = (double)ang * 0.15915494309189535;
        double fr = rev - rint(rev);
        float r = (float)(fr * 6.283185307179586);
        f32x2 cs; cs.x = __cosf(r); cs.y = __sinf(r);
        ((f32x2*)(p.ws + OFF_ROPE))[idx] = cs;
    }
}

__device__ __forceinline__ void ph_mod(const Params& p, unsigned char* smem) {
    float* sc = (float*)smem;
    float* part = sc + 8 * 1024;
    const int tid = ltid();
    if ((int)blockIdx.x >= 192) return;
    __syncthreads();
    for (int i = tid; i < 8192; i += 256) sc[i] = siluf_(p.c[i]);
    __syncthreads();
    for (int it = blockIdx.x; it < 192; it += gridDim.x) {
        const int l = it / 96, jb = (it % 96) * 64;
        const int c4 = (tid & 15) * 4, kg = tid >> 4;
        f32x4 acc[8];
#pragma unroll
        for (int b = 0; b < 8; ++b) acc[b] = (f32x4){0.f, 0.f, 0.f, 0.f};
        const float* w = p.ada_w + (size_t)l * 1024 * 6144 + jb + c4;
#pragma unroll 4
        for (int k = kg * 64; k < kg * 64 + 64; ++k) {
            const f32x4 wv = *(const f32x4*)(w + (size_t)k * 6144);
#pragma unroll
            for (int b = 0; b < 8; ++b) acc[b] += wv * sc[b * 1024 + k];
        }
        if (kg >= 8) {
#pragma unroll
            for (int b = 0; b < 8; ++b) *(f32x4*)(part + ((kg - 8) * 8 + b) * 64 + c4) = acc[b];
        }
        __syncthreads();
        if (kg < 8) {
#pragma unroll
            for (int b = 0; b < 8; ++b) { f32x4* q = (f32x4*)(part + (kg * 8 + b) * 64 + c4); *q = *q + acc[b]; }
        }
        __syncthreads();
        {
            float* mod = (float*)(p.ws + OFF_MOD);
#pragma unroll
            for (int o = 0; o < 2; ++o) {
                const int idx = tid + 256 * o, b = idx >> 6, jj = idx & 63;
                float r = 0.f;
#pragma unroll
                for (int g = 0; g < 8; ++g) r += part[(g * 8 + b) * 64 + jj];
                mod[(size_t)(l * 8 + b) * 6144 + jb + jj] = r + p.ada_b[l * 6144 + jb + jj];
            }
        }
        __syncthreads();
    }
}

struct TJob {
    const float* src; bf16_t* dst;
    int K, NQ, src_ld, dst_ld, mode, p0, nbatch, pad;
    size_t src_bs, dst_bs;
};
__device__ __forceinline__ int tj_src_col(int mode, int p0, int q) {
    if (mode == 0) return q + p0;
    if (mode == 1) return q < 1092 ? q : (q < 1152 ? -1 : q - 60);
    if (mode == 2) return q;
    return q < 64 ? q : -1;
}
__device__ __forceinline__ int tj_dst_row(int mode, int p0, int q) {
    if (mode == 2) return (q >> 5) * 64 + p0 + (q & 31);
    return q;
}
__device__ __forceinline__ void tconv_load(const TJob& j, int it, int tid, f32x4 (&r)[4]) {
    const int nk = j.K / 64;
    const int per = (j.NQ / 64) * nk;
    const int b = it / per, rr = it % per, qt = rr / nk, kt = rr % nk;
    const float* src = j.src + (size_t)b * j.src_bs;
    const int tx4 = (tid & 15) * 4, ty = tid >> 4;
    const int sc = tj_src_col(j.mode, j.p0, qt * 64 + tx4);
#pragma unroll
    for (int i = 0; i < 4; ++i) {
        if (sc >= 0) r[i] = *(const f32x4*)(src + (size_t)(kt * 64 + ty + 16 * i) * j.src_ld + sc);
        else r[i] = (f32x4){0.f, 0.f, 0.f, 0.f};
    }
}
constexpr int TCS = 68;
__device__ __forceinline__ void tconv_put(int tid, const f32x4 (&r)[4], float* tile) {
    const int tx4 = (tid & 15) * 4, ty = tid >> 4;
#pragma unroll
    for (int i = 0; i < 4; ++i) {
        const int k = ty + 16 * i;
        *(f32x4*)(tile + k * TCS + (tx4 ^ (((k >> 4) & 1) * 16))) = r[i];
    }
}
__device__ __forceinline__ void tconv_emit(const TJob& j, int it, int tid, const float* tile) {
    const int nk = j.K / 64;
    const int per = (j.NQ / 64) * nk;
    const int b = it / per, rr = it % per, qt = rr / nk, kt = rr % nk;
    bf16_t* dst = j.dst + (size_t)b * j.dst_bs;
    const int nn = tid >> 2, kc = (tid & 3) * 16;
    const int dr = tj_dst_row(j.mode, j.p0, qt * 64 + nn);
    const int col = nn ^ (((kc >> 4) & 1) * 16);
    unsigned w[8];
#pragma unroll
    for (int i = 0; i < 8; ++i) w[i] = pack2(tile[(kc + 2 * i) * TCS + col], tile[(kc + 2 * i + 1) * TCS + col]);
    u32x4* d = (u32x4*)(dst + (size_t)dr * j.dst_ld + kt * 64 + kc);
    d[0] = (u32x4){w[0], w[1], w[2], w[3]};
    d[1] = (u32x4){w[4], w[5], w[6], w[7]};
}

__device__ __forceinline__ void ph_wcomp(const Params& p, int l, unsigned char* smem) {
    float (*row)[256] = (float (*)[256])smem;
    const int tid = ltid();
    for (int it = blockIdx.x; it < 512; it += gridDim.x) {
    const int k0 = it * 2;
    __syncthreads();
    {
        const int kk = tid >> 7, jj = tid & 127;
        const float* wi = p.w_in + ((size_t)l * 1024 + k0 + kk) * NIN_ + 512;
        row[kk][jj] = wi[jj] * p.g_kv[l * 256 + jj];
        row[kk][jj + 128] = wi[jj + 128] * p.g_kv[l * 256 + jj + 128];
    }
    __syncthreads();
    const int kk = tid >> 7, n = tid & 127;
    const float* wu = (n < 64) ? (p.w_uk + (size_t)l * 256 * 64 + n) : (p.w_uv + (size_t)l * 256 * 64 + (n - 64));
    float acc = 0.f;
    for (int jx = 0; jx < 256; ++jx) acc += row[kk][jx] * wu[jx * 64];
    bf16_t* WinT = (bf16_t*)(p.ws + OFF_WB) + WB_WIN;
    WinT[(size_t)(C_KA + n) * 1024 + k0 + kk] = f2bf(acc);
    }
}

struct NormArgs {
    const float* xin; const bf16_t* Y; const bf16_t* slots;
    const float* gpost; const float* gt;
    const float* gpre; const float* sc; const float* sh;
    int mode;
};
__device__ __forceinline__ void ph_norm(const Params& p, const NormArgs& a) {
    const int lane = ltid() & 63;
    for (int row = blockIdx.x * 4 + (ltid() >> 6); row < T_; row += gridDim.x * 4) {
    const int b = row >> 11;
    float* xo = p.out + (size_t)row * 1024;
    f32x4 xv[4];
    if (a.mode == 0) {
#pragma unroll
        for (int i = 0; i < 4; ++i) xv[i] = *(const f32x4*)(a.xin + (size_t)row * 1024 + i * 256 + lane * 4);
    } else {
        f32x4 yv[4];
        if (a.mode == 1) {
#pragma unroll
            for (int i = 0; i < 4; ++i) {
                u32x2 u = *(const u32x2*)(a.Y + (size_t)row * 1024 + i * 256 + lane * 4);
                yv[i][0] = __uint_as_float(u.x << 16); yv[i][1] = __uint_as_float(u.x & 0xffff0000u);
                yv[i][2] = __uint_as_float(u.y << 16); yv[i][3] = __uint_as_float(u.y & 0xffff0000u);
            }
        } else {
#pragma unroll
            for (int i = 0; i < 4; ++i) yv[i] = (f32x4){0.f, 0.f, 0.f, 0.f};
#pragma unroll
            for (int k = 0; k < 9; ++k) {
                const bf16_t* sp = a.slots + (k < 8 ? ((size_t)row * 8 + k) : ((size_t)8 * T_ + row)) * 1024;
#pragma unroll
                for (int i = 0; i < 4; ++i) {
                    u32x2 u = *(const u32x2*)(sp + i * 256 + lane * 4);
                    yv[i][0] += __uint_as_float(u.x << 16); yv[i][1] += __uint_as_float(u.x & 0xffff0000u);
                    yv[i][2] += __uint_as_float(u.y << 16); yv[i][3] += __uint_as_float(u.y & 0xffff0000u);
                }
            }
        }
        float ss = 0.f;
#pragma unroll
        for (int i = 0; i < 4; ++i) ss += yv[i][0] * yv[i][0] + yv[i][1] * yv[i][1] + yv[i][2] * yv[i][2] + yv[i][3] * yv[i][3];
        ss = wave_sum(ss);
        const float rs = rsqrtf(ss * (1.0f / 1024.0f) + EPS_);
#pragma unroll
        for (int i = 0; i < 4; ++i) {
            const int col = i * 256 + lane * 4;
            f32x4 xo4 = *(const f32x4*)(xo + col);
            f32x4 g4 = *(const f32x4*)(a.gpost + col);
            f32x4 gt4 = *(const f32x4*)(a.gt + (size_t)b * 6144 + col);
            xv[i] = xo4 + gt4 * (yv[i] * rs * g4);
        }
    }
#pragma unroll
    for (int i = 0; i < 4; ++i) *(f32x4*)(xo + i * 256 + lane * 4) = xv[i];
    if (a.gpre) {
        float ss = 0.f;
#pragma unroll
        for (int i = 0; i < 4; ++i) ss += xv[i][0] * xv[i][0] + xv[i][1] * xv[i][1] + xv[i][2] * xv[i][2] + xv[i][3] * xv[i][3];
        ss = wave_sum(ss);
        const float rs = rsqrtf(ss * (1.0f / 1024.0f) + EPS_);
        bf16_t* H = (bf16_t*)(p.ws + OFF_H) + (size_t)row * 1024;
#pragma unroll
        for (int i = 0; i < 4; ++i) {
            const int col = i * 256 + lane * 4;
            f32x4 g4 = *(const f32x4*)(a.gpre + col);
            f32x4 sc4 = *(const f32x4*)(a.sc + (size_t)b * 6144 + col);
            f32x4 sh4 = *(const f32x4*)(a.sh + (size_t)b * 6144 + col);
            f32x4 h = (xv[i] * rs * g4) * (sc4 + 1.0f) + sh4;
            u32x2 u; u.x = pack2(h[0], h[1]); u.y = pack2(h[2], h[3]);
            *(u32x2*)(H + col) = u;
        }
    }
    }
}

#define LAS __attribute__((address_space(3)))
constexpr int STG = 32768;
constexpr int MISC = 49152;
constexpr int DYN_LDS = 49152 + 1280;
__device__ __forceinline__ int stg_row(int tid, int i, int pieces) { return ((tid >> 6) * pieces + i) * 8 + ((tid & 63) >> 3); }
__device__ __forceinline__ int stg_chunk(int tid, int i) { return (tid & 7) ^ ((4 * i + ((tid & 63) >> 4)) & 7); }
template <int NW>
__device__ __forceinline__ void gemm_kloop2(f32x4 (&acc)[4][NW], const bf16_t* abase, const unsigned (&aoff)[4], const bf16_t* bbase, const unsigned (&boff)[NW], int K, unsigned char* smem, int tid) {
    const int lane = tid & 63, wid = __builtin_amdgcn_readfirstlane(tid >> 6), wr = wid >> 1, wc = wid & 1, fr = lane & 15, fq = lane >> 4;
    LAS unsigned char* lds = (LAS unsigned char*)smem;
    const int nt = K >> 6;
    const int offA = (wr * 64 + fr) * 128, offB = 16384 + (wc * (16 * NW) + fr) * 128;
    const int sw = fr >> 1;
    for (int t = 0; t < nt; ++t) {
        __syncthreads();
#pragma unroll
        for (int i = 0; i < 4; ++i) __builtin_amdgcn_global_load_lds((const unsigned*)(abase + aoff[i] + t * 64), (LAS unsigned*)(lds + (wid * 4 + i) * 1024), 16, 0, 0);
#pragma unroll
        for (int i = 0; i < NW; ++i) __builtin_amdgcn_global_load_lds((const unsigned*)(bbase + boff[i] + t * 64), (LAS unsigned*)(lds + 16384 + (wid * NW + i) * 1024), 16, 0, 0);
        asm volatile("s_waitcnt vmcnt(0)" ::: "memory");
        __syncthreads();
#pragma unroll
        for (int ks = 0; ks < 2; ++ks) {
            const int ch = ((ks * 4 + fq) ^ sw) << 4;
            bf16x8 af[4], bfv[NW];
#pragma unroll
            for (int m = 0; m < 4; ++m) af[m] = *(const LAS bf16x8*)(lds + offA + m * 2048 + ch);
#pragma unroll
            for (int n = 0; n < NW; ++n) bfv[n] = *(const LAS bf16x8*)(lds + offB + n * 2048 + ch);
            __builtin_amdgcn_s_setprio(1);
#pragma unroll
            for (int m = 0; m < 4; ++m)
#pragma unroll
                for (int n = 0; n < NW; ++n) acc[m][n] = __builtin_amdgcn_mfma_f32_16x16x32_bf16(af[m], bfv[n], acc[m][n], 0, 0, 0);
            __builtin_amdgcn_s_setprio(0);
        }
    }
}

constexpr int LDT = 72;
struct __attribute__((aligned(16))) GemmLds { bf16_t A[128 * LDT]; bf16_t B[128 * LDT]; };

template <int NW>
__device__ __forceinline__ void gemm_kloop(f32x4 (&acc)[4][NW], const bf16_t* const (&ap)[4], const bf16_t* const (&bp)[NW], int K,
                                           bf16_t* sA, bf16_t* sB, int tid) {
    const int lane = tid & 63, wid = __builtin_amdgcn_readfirstlane(tid >> 6), wr = wid >> 1, wc = wid & 1, fr = lane & 15, fq = lane >> 4;
    u32x4 ra[4], rb[NW];
#pragma unroll
    for (int i = 0; i < 4; ++i) ra[i] = *(const u32x4*)(ap[i]);
#pragma unroll
    for (int i = 0; i < NW; ++i) rb[i] = *(const u32x4*)(bp[i]);
    const int srow = tid >> 3, scol = (tid & 7) * 8;
    for (int k0 = 0; k0 < K; k0 += 64) {
        __syncthreads();
#pragma unroll
        for (int i = 0; i < 4; ++i) *(u32x4*)(sA + (srow + 32 * i) * LDT + scol) = ra[i];
#pragma unroll
        for (int i = 0; i < NW; ++i) *(u32x4*)(sB + (srow + 32 * i) * LDT + scol) = rb[i];
        __syncthreads();
        if (k0 + 64 < K) {
#pragma unroll
            for (int i = 0; i < 4; ++i) ra[i] = *(const u32x4*)(ap[i] + k0 + 64);
#pragma unroll
            for (int i = 0; i < NW; ++i) rb[i] = *(const u32x4*)(bp[i] + k0 + 64);
        }
#pragma unroll
        for (int ks = 0; ks < 2; ++ks) {
            bf16x8 af[4], bfv[NW];
#pragma unroll
            for (int m = 0; m < 4; ++m) af[m] = *(const bf16x8*)(sA + (wr * 64 + m * 16 + fr) * LDT + ks * 32 + fq * 8);
#pragma unroll
            for (int n = 0; n < NW; ++n) bfv[n] = *(const bf16x8*)(sB + (wc * (16 * NW) + n * 16 + fr) * LDT + ks * 32 + fq * 8);
#pragma unroll
            for (int m = 0; m < 4; ++m)
#pragma unroll
                for (int n = 0; n < NW; ++n) acc[m][n] = __builtin_amdgcn_mfma_f32_16x16x32_bf16(af[m], bfv[n], acc[m][n], 0, 0, 0);
        }
    }
}
template <int NW>
__device__ __forceinline__ void zero_acc(f32x4 (&acc)[4][NW]) {
#pragma unroll
    for (int m = 0; m < 4; ++m)
#pragma unroll
        for (int n = 0; n < NW; ++n) acc[m][n] = (f32x4){0.f, 0.f, 0.f, 0.f};
}

__device__ __forceinline__ void store_rope(const f32x4 (&acc)[4][4], bf16_t* dst, int ld, int dcol, float scale, const f32x2* rope, int rowbase, int fr, int fq) {
#pragma unroll
    for (int m = 0; m < 4; ++m)
#pragma unroll
        for (int j = 0; j < 4; ++j) {
            const int t = rowbase + m * 16 + fq * 4 + j;
#pragma unroll
            for (int nn = 0; nn < 2; ++nn) {
                const f32x2 cs = rope[(size_t)t * 32 + nn * 16 + fr];
                const float x1 = acc[m][nn][j], x2 = acc[m][nn + 2][j];
                dst[(size_t)t * ld + dcol + nn * 16 + fr] = f2bf((x1 * cs.x - x2 * cs.y) * scale);
                dst[(size_t)t * ld + dcol + (nn + 2) * 16 + fr] = f2bf((x2 * cs.x + x1 * cs.y) * scale);
            }
        }
}
__device__ __forceinline__ void store_plain(const f32x4 (&acc)[4][4], bf16_t* dst, int ld, int dcol, float scale, int act, int rowbase, int fr, int fq) {
#pragma unroll
    for (int m = 0; m < 4; ++m)
#pragma unroll
        for (int j = 0; j < 4; ++j) {
            const int t = rowbase + m * 16 + fq * 4 + j;
#pragma unroll
            for (int n = 0; n < 4; ++n) {
                float v = acc[m][n][j] * scale;
                if (act == 1) v = sigmoidf_(v);
                else if (act == 2) v = siluf_(v);
                dst[(size_t)t * ld + dcol + n * 16 + fr] = f2bf(v);
            }
        }
}
__device__ __forceinline__ void store_trans(const f32x4 (&acc)[4][4], bf16_t* dstT, int rows_per_b, int rowoff, int rowbase, int fr, int fq) {
#pragma unroll
    for (int m = 0; m < 4; ++m) {
        const int t = rowbase + m * 16 + fq * 4;
        const int b = t >> 11, s = t & 2047;
#pragma unroll
        for (int n = 0; n < 4; ++n) {
            u32x2 u; u.x = pack2(acc[m][n][0], acc[m][n][1]); u.y = pack2(acc[m][n][2], acc[m][n][3]);
            *(u32x2*)(dstT + ((size_t)b * rows_per_b + rowoff + n * 16 + fr) * 2048 + s) = u;
        }
    }
}

constexpr int LDE = 136;
template <int NW>
__device__ __forceinline__ void lds_put_tile(bf16_t* sT, const f32x4 (&acc)[4][NW], int wr, int wc, int fr, int fq) {
#pragma unroll
    for (int m = 0; m < 4; ++m)
#pragma unroll
        for (int j = 0; j < 4; ++j)
#pragma unroll
            for (int n = 0; n < NW; ++n) sT[(wr * 64 + m * 16 + fq * 4 + j) * LDE + wc * (16 * NW) + n * 16 + fr] = f2bf(acc[m][n][j]);
}
__device__ __forceinline__ void lds_put_tile_t(bf16_t* sT, const f32x4 (&acc)[4][4], int wr, int wc, int fr, int fq) {
#pragma unroll
    for (int m = 0; m < 4; ++m)
#pragma unroll
        for (int n = 0; n < 4; ++n) {
            u32x2 u; u.x = pack2(acc[m][n][0], acc[m][n][1]); u.y = pack2(acc[m][n][2], acc[m][n][3]);
            *(u32x2*)(sT + (wc * 64 + n * 16 + fr) * LDE + wr * 64 + m * 16 + fq * 4) = u;
        }
}
__device__ __forceinline__ void rope_acc(f32x4 (&acc)[4][4], float scale, const f32x2* rope, int rowbase, int fr, int fq) {
    const f32x2* rp = rope + (size_t)(rowbase + fq * 4) * 32 + fr;
#pragma unroll
    for (int m = 0; m < 4; ++m) {
#pragma unroll
        for (int j = 0; j < 4; ++j) {
#pragma unroll
            for (int nn = 0; nn < 2; ++nn) {
                const f32x2 cs = rp[(m * 16 + j) * 32 + nn * 16];
                const float cc = cs.x * scale, sn = cs.y * scale;
                const float x1 = acc[m][nn][j], x2 = acc[m][nn + 2][j];
                acc[m][nn][j] = __fmaf_rn(x1, cc, -(x2 * sn));
                acc[m][nn + 2][j] = __fmaf_rn(x2, cc, x1 * sn);
            }
            if (j & 1) __builtin_amdgcn_sched_barrier(0);
        }
    }
}
__device__ __forceinline__ void scale_act_acc(f32x4 (&acc)[4][4], float scale, int act) {
#pragma unroll
    for (int m = 0; m < 4; ++m)
#pragma unroll
        for (int n = 0; n < 4; ++n)
#pragma unroll
            for (int j = 0; j < 4; ++j) {
                float v = acc[m][n][j] * scale;
                if (act == 1) v = sigmoidf_(v);
                else if (act == 2) v = siluf_(v);
                acc[m][n][j] = v;
            }
}
struct SegDst { bf16_t* rm; int ld; int dcol; bf16_t* tr; int tr_rows; int tr_off; int kind; };
__device__ __forceinline__ SegDst seg_dst(unsigned char* r1, int c0) {
    SegDst d; d.rm = nullptr; d.ld = 0; d.dcol = 0; d.tr = nullptr; d.tr_rows = 0; d.tr_off = 0; d.kind = 0;
    if (c0 < C_CKV) { d.rm = (bf16_t*)(r1 + R1_QA); d.ld = 512; d.dcol = c0 - C_QA; d.kind = 1; }
    else if (c0 < C_IQ) { d.kind = 0; }
    else if (c0 < C_IK) { d.rm = (bf16_t*)(r1 + R1_IQ); d.ld = 256; d.dcol = c0 - C_IQ; d.kind = 1; }
    else if (c0 < C_IW) { d.rm = (bf16_t*)(r1 + R1_IK); d.ld = 64; d.dcol = 0; d.kind = 1; }
    else if (c0 < C_QB) { d.kind = 0; }
    else if (c0 < C_KB) { d.rm = (bf16_t*)(r1 + R1_QB); d.ld = 512; d.dcol = c0 - C_QB; d.kind = 1; }
    else if (c0 < C_VB) { d.rm = (bf16_t*)(r1 + R1_KB); d.ld = 512; d.dcol = c0 - C_KB; d.kind = 1; }
    else if (c0 < C_QC) { d.tr = (bf16_t*)(r1 + R1_VBT); d.tr_rows = 512; d.tr_off = c0 - C_VB; d.kind = 2; }
    else if (c0 < C_KC) { d.rm = (bf16_t*)(r1 + R1_QC); d.ld = 512; d.dcol = c0 - C_QC; d.kind = 1; }
    else if (c0 < C_VC) { d.rm = (bf16_t*)(r1 + R1_KC); d.ld = 512; d.dcol = c0 - C_KC; d.tr = (bf16_t*)(r1 + R1_KCT); d.tr_rows = 512; d.tr_off = c0 - C_KC; d.kind = 3; }
    else if (c0 < C_GC) { d.tr = (bf16_t*)(r1 + R1_VCT); d.tr_rows = 1024; d.tr_off = c0 - C_VC; d.kind = 2; }
    else if (c0 < C_GATES) { d.rm = (bf16_t*)(r1 + R1_GC); d.ld = 1024; d.dcol = c0 - C_GC; d.kind = 1; }
    else if (c0 < C_KA) { d.tr = (bf16_t*)(r1 + R1_GATES); d.tr_rows = 3072; d.tr_off = c0 - C_GATES; d.kind = 2; }
    else if (c0 < C_VA) { d.rm = (bf16_t*)(r1 + R1_KA); d.ld = 64; d.dcol = 0; d.kind = 1; }
    else { d.tr = (bf16_t*)(r1 + R1_VAT); d.tr_rows = 64; d.tr_off = 0; d.kind = 2; }
    return d;
}

__device__ __forceinline__ void ph_gemm_z(const Params& p, unsigned char* smem) {
    bf16_t* sT = (bf16_t*)smem;
    const int tid = ltid(), lane = tid & 63, wid = __builtin_amdgcn_readfirstlane(tid >> 6), wr = wid >> 1, wc = wid & 1, fr = lane & 15, fq = lane >> 4;
    const bf16_t* H = (const bf16_t*)(p.ws + OFF_H);
    const bf16_t* WinT = (const bf16_t*)(p.ws + OFF_WB) + WB_WIN;
    const int xcd = blockIdx.x & 7, jb = blockIdx.x >> 3, nper = gridDim.x >> 3;
    for (int q = jb; q < 1120; q += nper) {
        const int half = q / 560, rem = q % 560, nt = rem >> 3, mtl = rem & 7;
        const int mt = 16 * xcd + 8 * half + mtl;
        const int m0 = mt * 128, n0 = nt * 128;
        unsigned ao[4], bo[4];
#pragma unroll
        for (int i = 0; i < 4; ++i) {
            const int R = stg_row(tid, i, 4), g = stg_chunk(tid, i);
            ao[i] = (unsigned)(m0 + R) * 1024u + g * 8;
            bo[i] = (unsigned)(n0 + R) * 1024u + g * 8;
        }
        f32x4 acc[4][4];
        zero_acc<4>(acc);
        gemm_kloop2<4>(acc, H, ao, WinT, bo, 1024, smem, tid);
        int te = tid; asm volatile("" : "+v"(te));
        const int fre = te & 15, fqe = (te & 63) >> 4;
        const Params& pe = getp();
        unsigned char* r1 = pe.ws + OFF_R1;
        const f32x2* rope = (const f32x2*)(pe.ws + OFF_ROPE);
        const int c0 = n0 + wc * 64;
        const int rowbase = m0 + wr * 64;
        if (c0 < C_CKV) rope_acc(acc, 0.125f, rope, rowbase, fre, fqe);
        else if (c0 < C_IQ) {
            float* ss = (float*)(pe.ws + OFF_CKVSS);
            const int blk = (c0 - C_CKV) >> 6;
#pragma unroll
            for (int m = 0; m < 4; ++m)
#pragma unroll
                for (int j = 0; j < 4; ++j) {
                    float sq = 0.f;
#pragma unroll
                    for (int n = 0; n < 4; ++n) sq += acc[m][n][j] * acc[m][n][j];
                    sq += __shfl_xor(sq, 1); sq += __shfl_xor(sq, 2); sq += __shfl_xor(sq, 4); sq += __shfl_xor(sq, 8);
                    if (fre == 0) ss[(size_t)(rowbase + m * 16 + fqe * 4 + j) * 4 + blk] = sq;
                }
        }
        else if (c0 < C_IK) rope_acc(acc, 1.0f, rope, rowbase, fre, fqe);
        else if (c0 < C_IW) rope_acc(acc, 1.0f, rope, rowbase, fre, fqe);
        else if (c0 < C_QB) {
            float* iw = (float*)(pe.ws + OFF_IW);
            if (fre < 4) {
#pragma unroll
                for (int m = 0; m < 4; ++m)
#pragma unroll
                    for (int j = 0; j < 4; ++j) iw[(size_t)(rowbase + m * 16 + fqe * 4 + j) * 4 + fre] = acc[m][0][j] * 0.0625f;
            }
        }
        else if (c0 < C_KB) scale_act_acc(acc, 0.125f, 0);
        else if (c0 < C_QC) { }
        else if (c0 < C_KC) rope_acc(acc, 1.0f, rope, rowbase, fre, fqe);
        else if (c0 < C_VC) rope_acc(acc, 0.125f, rope, rowbase, fre, fqe);
        else if (c0 < C_GC) { }
        else if (c0 < C_GATES) scale_act_acc(acc, 1.0f, 2);
        else if (c0 < C_KA) scale_act_acc(acc, 1.0f, 1);
        else if (c0 < C_VA) rope_acc(acc, 1.0f, rope, rowbase, fre, fqe);
        const SegDst dw = seg_dst(r1, c0);
        const SegDst d0 = seg_dst(r1, n0), d1 = seg_dst(r1, n0 + 64);
        const int anyrm = (d0.kind | d1.kind) & 1, anytr = (d0.kind | d1.kind) & 2;
        __syncthreads();
        if (anyrm) {
            if (dw.kind & 1) lds_put_tile<4>(sT, acc, wr, wc, fre, fqe);
            __syncthreads();
#pragma unroll
            for (int hh = 0; hh < 2; ++hh) {
                const SegDst& d = hh ? d1 : d0;
                if (d.kind & 1) {
#pragma unroll
                    for (int i = 0; i < 4; ++i) {
                        const int c = te + 256 * i, row = c >> 3, ch = c & 7;
                        *(u32x4*)(d.rm + (size_t)(m0 + row) * d.ld + d.dcol + ch * 8) = *(const u32x4*)(sT + row * LDE + hh * 64 + ch * 8);
                    }
                }
            }
        }
        if (anytr) {
            __syncthreads();
            if (dw.kind & 2) lds_put_tile_t(sT, acc, wr, wc, fre, fqe);
            __syncthreads();
            const int b = m0 >> 11, s0 = m0 & 2047;
#pragma unroll
            for (int hh = 0; hh < 2; ++hh) {
                const SegDst& d = hh ? d1 : d0;
                if (d.kind & 2) {
#pragma unroll
                    for (int i = 0; i < 4; ++i) {
                        const int c = te + 256 * i, erow = c >> 4, ch = c & 15;
                        *(u32x4*)(d.tr + ((size_t)b * d.tr_rows + d.tr_off + erow) * 2048 + s0 + ch * 8) = *(const u32x4*)(sT + (hh * 64 + erow) * LDE + ch * 8);
                    }
                }
            }
        }
    }
}

struct __attribute__((aligned(16))) AttnLds { bf16_t K[64 * LDT]; bf16_t Vt[64 * LDT]; float rs[64]; };

__device__ __forceinline__ void tile64_load(u32x4 (&r)[2], const bf16_t* src, size_t src_ld, int tid) {
#pragma unroll
    for (int i = 0; i < 2; ++i) {
        const int c = tid + 256 * i, row = c >> 3, col8 = (c & 7) * 8;
        r[i] = *(const u32x4*)(src + (size_t)row * src_ld + col8);
    }
}
__device__ __forceinline__ void tile64_put(bf16_t* dst, const u32x4 (&r)[2], int tid) {
#pragma unroll
    for (int i = 0; i < 2; ++i) {
        const int c = tid + 256 * i, row = c >> 3, col8 = (c & 7) * 8;
        *(u32x4*)(dst + row * LDT + col8) = r[i];
    }
}
__device__ __forceinline__ void stage_tile64(bf16_t* dst, const bf16_t* src, size_t src_ld, int tid) {
#pragma unroll
    for (int i = 0; i < 2; ++i) {
        const int c = tid + 256 * i, row = c >> 3, col8 = (c & 7) * 8;
        *(u32x4*)(dst + row * LDT + col8) = *(const u32x4*)(src + (size_t)row * src_ld + col8);
    }
}

__device__ __forceinline__ void sb_tile(const AttnLds& sm, const bf16x8 (&qf)[2], f32x4 (&O)[4], float& R, bool diag, int tl, int fr, int fq) {
    f32x4 st[4];
#pragma unroll
    for (int mk = 0; mk < 4; ++mk) {
        st[mk] = (f32x4){0.f, 0.f, 0.f, 0.f};
#pragma unroll
        for (int ks = 0; ks < 2; ++ks) {
            bf16x8 kf = *(const bf16x8*)(sm.K + (mk * 16 + fr) * LDT + ks * 32 + fq * 8);
            st[mk] = __builtin_amdgcn_mfma_f32_16x16x32_bf16(kf, qf[ks], st[mk], 0, 0, 0);
        }
    }
    float Bv[4][4], Om[4][4], P[4];
#pragma unroll
    for (int mk = 0; mk < 4; ++mk) {
        P[mk] = 1.f;
#pragma unroll
        for (int r = 0; r < 4; ++r) {
            const float z = st[mk][r];
            const bool valid = !diag || (16 * mk + 4 * fq + r < tl);
            const float e = __expf(-fabsf(z));
            const float sg = __builtin_amdgcn_rcpf(1.0f + e);
            const float es = e * sg;
            const float beta = (z >= 0.f) ? sg : es, om = (z >= 0.f) ? es : sg;
            Bv[mk][r] = valid ? beta : 0.f;
            Om[mk][r] = valid ? om : 1.f;
            P[mk] *= Om[mk][r];
        }
    }
    float tot[4], above[4];
#pragma unroll
    for (int mk = 0; mk < 4; ++mk) {
        auto sw = __builtin_amdgcn_permlane16_swap(__float_as_uint(P[mk]), __float_as_uint(P[mk]), false, false);
        const float po = __uint_as_float(sw[1]);
        const float pair = __uint_as_float(sw[0]) * po;
        auto tw = __builtin_amdgcn_permlane32_swap(__float_as_uint(pair), __float_as_uint(pair), false, false);
        const float hi = __uint_as_float(tw[1]);
        tot[mk] = __uint_as_float(tw[0]) * hi;
        above[mk] = ((fq & 1) ? 1.f : po) * ((fq < 2) ? hi : 1.f);
    }
    float higher[4];
    higher[3] = 1.f; higher[2] = tot[3]; higher[1] = tot[3] * tot[2]; higher[0] = tot[3] * tot[2] * tot[1];
    float A[4][4];
#pragma unroll
    for (int mk = 0; mk < 4; ++mk) {
        float suf = above[mk] * higher[mk] * R;
#pragma unroll
        for (int r = 3; r >= 0; --r) {
            A[mk][r] = Bv[mk][r] * suf;
            suf *= Om[mk][r];
        }
    }
    R *= (tot[0] * tot[1]) * (tot[2] * tot[3]);
#pragma unroll
    for (int ks = 0; ks < 2; ++ks) {
        u32x4 uu = (u32x4){pack2(A[2 * ks][0], A[2 * ks][1]), pack2(A[2 * ks][2], A[2 * ks][3]),
                           pack2(A[2 * ks + 1][0], A[2 * ks + 1][1]), pack2(A[2 * ks + 1][2], A[2 * ks + 1][3])};
        bf16x8 pf = *(bf16x8*)&uu;
#pragma unroll
        for (int me = 0; me < 4; ++me) {
            const bf16_t* vp = sm.Vt + (me * 16 + fr) * LDT + ks * 32 + 4 * fq;
            u32x2 lo = *(const u32x2*)vp, hi = *(const u32x2*)(vp + 16);
            u32x4 vv = (u32x4){lo.x, lo.y, hi.x, hi.y};
            O[me] = __builtin_amdgcn_mfma_f32_16x16x32_bf16(*(bf16x8*)&vv, pf, O[me], 0, 0, 0);
        }
    }
}
__device__ __forceinline__ void mixb_item(const Params& p, int item, unsigned char* smem) {
    AttnLds& sm = *(AttnLds*)smem;
    const int tid = ltid(), lane = tid & 63, w = __builtin_amdgcn_readfirstlane(tid >> 6), fr = lane & 15, fq = lane >> 4;
    unsigned char* r1 = p.ws + OFF_R1;
    bf16_t* QB = (bf16_t*)(r1 + R1_QB);
    const bf16_t* KB = (const bf16_t*)(r1 + R1_KB);
    const bf16_t* VBT = (const bf16_t*)(r1 + R1_VBT);
    {
        const int qt2 = 15 - (item >> 6), bh = item & 63, b = bh >> 3, h = bh & 7;
        const int tl = 16 * w + fr;
        const int tq0 = b * 2048 + qt2 * 128 + tl, tq1 = tq0 + 64;
        bf16x8 qf0[2], qf1[2];
#pragma unroll
        for (int ks = 0; ks < 2; ++ks) {
            qf0[ks] = *(const bf16x8*)(QB + (size_t)tq0 * 512 + h * 64 + ks * 32 + fq * 8);
            qf1[ks] = *(const bf16x8*)(QB + (size_t)tq1 * 512 + h * 64 + ks * 32 + fq * 8);
        }
        f32x4 O0[4], O1[4];
#pragma unroll
        for (int me = 0; me < 4; ++me) { O0[me] = (f32x4){0.f, 0.f, 0.f, 0.f}; O1[me] = (f32x4){0.f, 0.f, 0.f, 0.f}; }
        float R0 = 1.f, R1 = 1.f;
        const int ktop = 2 * qt2 + 1;
        for (int kt = ktop; kt >= 0; --kt) {
            __syncthreads();
            stage_tile64(sm.K, KB + (size_t)(b * 2048 + kt * 64) * 512 + h * 64, 512, tid);
            stage_tile64(sm.Vt, VBT + ((size_t)(b * 8 + h) * 64) * 2048 + kt * 64, 2048, tid);
            __syncthreads();
            sb_tile(sm, qf1, O1, R1, kt == ktop, tl, fr, fq);
            if (kt < ktop) sb_tile(sm, qf0, O0, R0, kt == ktop - 1, tl, fr, fq);
        }
        const int ts = ltid();
        const int fqs = (ts & 63) >> 4;
        const int tqs0 = b * 2048 + qt2 * 128 + 16 * (ts >> 6) + (ts & 15), tqs1 = tqs0 + 64;
#pragma unroll
        for (int me = 0; me < 4; ++me) {
            u32x2 u; u.x = pack2(O0[me][0], O0[me][1]); u.y = pack2(O0[me][2], O0[me][3]);
            *(u32x2*)(QB + (size_t)tqs0 * 512 + h * 64 + me * 16 + 4 * fqs) = u;
            u32x2 v; v.x = pack2(O1[me][0], O1[me][1]); v.y = pack2(O1[me][2], O1[me][3]);
            *(u32x2*)(QB + (size_t)tqs1 * 512 + h * 64 + me * 16 + 4 * fqs) = v;
        }
    }
}

struct __attribute__((aligned(16))) RetLds { bf16_t K[64 * LDT]; bf16_t KT[64 * LDT]; bf16_t VT[128 * LDT]; bf16_t ST[128 * LDT]; };
struct __attribute__((aligned(16))) RetLds3 { bf16_t K[64 * LDT]; bf16_t VT[128 * LDT]; bf16_t ST[128 * LDT]; };

__device__ __forceinline__ void mixc1_item(const Params& p, int item, unsigned char* smem) {
    RetLds& sm = *(RetLds*)smem;
    const int tid = ltid(), lane = tid & 63, w = __builtin_amdgcn_readfirstlane(tid >> 6), fr = lane & 15, fq = lane >> 4;
    unsigned char* r1 = p.ws + OFF_R1;
    const bf16_t* KCT = (const bf16_t*)(r1 + R1_KCT);
    const bf16_t* VCT = (const bf16_t*)(r1 + R1_VCT);
    bf16_t* KVT = (bf16_t*)(p.ws + OFF_H);
    const int bh = item >> 5, n = item & 31, h = bh & 7;
    const float lg = LOGG[h];
    u32x4 rkt[2], rvt[4];
#pragma unroll
    for (int i = 0; i < 2; ++i) {
        const int c = tid + 256 * i, row = c >> 3, col8 = (c & 7) * 8;
        rkt[i] = *(const u32x4*)(KCT + ((size_t)bh * 64 + row) * 2048 + n * 64 + col8);
    }
#pragma unroll
    for (int i = 0; i < 4; ++i) {
        const int c = tid + 256 * i, row = c >> 3, col8 = (c & 7) * 8;
        rvt[i] = *(const u32x4*)(VCT + ((size_t)bh * 128 + row) * 2048 + n * 64 + col8);
    }
    __syncthreads();
#pragma unroll
    for (int i = 0; i < 2; ++i) {
        const int c = tid + 256 * i, row = c >> 3, col8 = (c & 7) * 8;
        unsigned uu[4] = {rkt[i].x, rkt[i].y, rkt[i].z, rkt[i].w};
#pragma unroll
        for (int q = 0; q < 4; ++q) {
            const float z0 = __expf(lg * (float)(63 - (col8 + 2 * q))), z1 = __expf(lg * (float)(63 - (col8 + 2 * q + 1)));
            uu[q] = pack2(__uint_as_float(uu[q] << 16) * z0, __uint_as_float(uu[q] & 0xffff0000u) * z1);
        }
        *(u32x4*)(sm.KT + row * LDT + col8) = (u32x4){uu[0], uu[1], uu[2], uu[3]};
    }
#pragma unroll
    for (int i = 0; i < 4; ++i) {
        const int c = tid + 256 * i, row = c >> 3, col8 = (c & 7) * 8;
        *(u32x4*)(sm.VT + row * LDT + col8) = rvt[i];
    }
    __syncthreads();
    f32x4 sacc[4][2];
#pragma unroll
    for (int md = 0; md < 4; ++md)
#pragma unroll
        for (int ne = 0; ne < 2; ++ne) sacc[md][ne] = (f32x4){0.f, 0.f, 0.f, 0.f};
#pragma unroll
    for (int ks = 0; ks < 2; ++ks) {
        bf16x8 vf[2];
#pragma unroll
        for (int ne = 0; ne < 2; ++ne) vf[ne] = *(const bf16x8*)(sm.VT + (32 * w + ne * 16 + fr) * LDT + ks * 32 + fq * 8);
#pragma unroll
        for (int md = 0; md < 4; ++md) {
            bf16x8 kf = *(const bf16x8*)(sm.KT + (md * 16 + fr) * LDT + ks * 32 + fq * 8);
#pragma unroll
            for (int ne = 0; ne < 2; ++ne) sacc[md][ne] = __builtin_amdgcn_mfma_f32_16x16x32_bf16(kf, vf[ne], sacc[md][ne], 0, 0, 0);
        }
    }
    bf16_t* dst = KVT + (size_t)item * 128 * 64;
#pragma unroll
    for (int md = 0; md < 4; ++md)
#pragma unroll
        for (int ne = 0; ne < 2; ++ne) {
            u32x2 u; u.x = pack2(sacc[md][ne][0], sacc[md][ne][1]); u.y = pack2(sacc[md][ne][2], sacc[md][ne][3]);
            *(u32x2*)(dst + (32 * w + ne * 16 + fr) * 64 + md * 16 + 4 * fq) = u;
        }
}
__device__ __forceinline__ void ph_mixc2(const Params& p) {
    bf16_t* KVT = (bf16_t*)(p.ws + OFF_H);
    for (int idx = blockIdx.x * 256 + ltid(); idx < 64 * 128 * 16; idx += gridDim.x * 256) {
        const int bh = idx >> 11, ed = idx & 2047;
        const float g64 = __expf(LOGG[bh & 7] * 64.0f);
        bf16_t* pp = KVT + (size_t)bh * 32 * 8192 + (size_t)ed * 4;
        float s0 = 0.f, s1 = 0.f, s2 = 0.f, s3 = 0.f;
#pragma unroll 4
        for (int n = 0; n < 32; ++n) {
            u32x2 kv = *(const u32x2*)(pp + (size_t)n * 8192);
            u32x2 o; o.x = pack2(s0, s1); o.y = pack2(s2, s3);
            *(u32x2*)(pp + (size_t)n * 8192) = o;
            s0 = s0 * g64 + __uint_as_float(kv.x << 16); s1 = s1 * g64 + __uint_as_float(kv.x & 0xffff0000u);
            s2 = s2 * g64 + __uint_as_float(kv.y << 16); s3 = s3 * g64 + __uint_as_float(kv.y & 0xffff0000u);
        }
    }
}
__device__ __forceinline__ void mixc3_item(const Params& p, int l, int item, unsigned char* smem) {
    RetLds3& sm = *(RetLds3*)smem;
    const int tid = ltid(), lane = tid & 63, w = __builtin_amdgcn_readfirstlane(tid >> 6), fr = lane & 15, fq = lane >> 4;
    unsigned char* r1 = p.ws + OFF_R1;
    const bf16_t* QC = (const bf16_t*)(r1 + R1_QC);
    const bf16_t* KC = (const bf16_t*)(r1 + R1_KC);
    const bf16_t* VCT = (const bf16_t*)(r1 + R1_VCT);
    const bf16_t* KVT = (const bf16_t*)(p.ws + OFF_H);
    bf16_t* GC = (bf16_t*)(r1 + R1_GC);
    {
        const int bh = item >> 5, n = item & 31, b = bh >> 3, h = bh & 7;
        const float lg = LOGG[h];
        const int al = 16 * w + fr;
        const float xi = __expf(lg * (float)(al + 1));
        {
            const int tok0 = b * 2048 + n * 64;
            u32x4 rk[2], rvt[4], rst[4];
            bf16x8 qf[2];
#pragma unroll
            for (int ks = 0; ks < 2; ++ks) qf[ks] = *(const bf16x8*)(QC + (size_t)(tok0 + 16 * w + fr) * 512 + h * 64 + ks * 32 + fq * 8);
            tile64_load(rk, KC + (size_t)tok0 * 512 + h * 64, 512, tid);
#pragma unroll
            for (int i = 0; i < 4; ++i) {
                const int c = tid + 256 * i, row = c >> 3, col8 = (c & 7) * 8;
                rvt[i] = *(const u32x4*)(VCT + ((size_t)bh * 128 + row) * 2048 + n * 64 + col8);
                rst[i] = *(const u32x4*)(KVT + (size_t)item * 8192 + row * 64 + col8);
            }
            __syncthreads();
            tile64_put(sm.K, rk, tid);
#pragma unroll
            for (int i = 0; i < 4; ++i) {
                const int c = tid + 256 * i, row = c >> 3, col8 = (c & 7) * 8;
                *(u32x4*)(sm.VT + row * LDT + col8) = rvt[i];
                *(u32x4*)(sm.ST + row * LDT + col8) = rst[i];
            }
            __syncthreads();
            f32x4 st[4];
#pragma unroll
            for (int mc = 0; mc < 4; ++mc) {
                st[mc] = (f32x4){0.f, 0.f, 0.f, 0.f};
#pragma unroll
                for (int ks = 0; ks < 2; ++ks) {
                    bf16x8 kf = *(const bf16x8*)(sm.K + (mc * 16 + fr) * LDT + ks * 32 + fq * 8);
                    st[mc] = __builtin_amdgcn_mfma_f32_16x16x32_bf16(kf, qf[ks], st[mc], 0, 0, 0);
                }
#pragma unroll
                for (int r = 0; r < 4; ++r) {
                    const int cc = 16 * mc + 4 * fq + r;
                    st[mc][r] *= __expf(lg * fabsf((float)(al - cc)));
                }
            }
            f32x4 o[8];
#pragma unroll
            for (int me = 0; me < 8; ++me) {
                o[me] = (f32x4){0.f, 0.f, 0.f, 0.f};
#pragma unroll
                for (int ks = 0; ks < 2; ++ks) {
                    bf16x8 sf = *(const bf16x8*)(sm.ST + (me * 16 + fr) * LDT + ks * 32 + fq * 8);
                    o[me] = __builtin_amdgcn_mfma_f32_16x16x32_bf16(sf, qf[ks], o[me], 0, 0, 0);
                }
                o[me] *= xi;
            }
#pragma unroll
            for (int ks = 0; ks < 2; ++ks) {
                bf16x8 pf;
                {
                    u32x4 uu = (u32x4){pack2(st[2 * ks][0], st[2 * ks][1]), pack2(st[2 * ks][2], st[2 * ks][3]),
                                          pack2(st[2 * ks + 1][0], st[2 * ks + 1][1]), pack2(st[2 * ks + 1][2], st[2 * ks + 1][3])};
                    pf = *(bf16x8*)&uu;
                }
#pragma unroll
                for (int me = 0; me < 8; ++me) {
                    const bf16_t* vp = sm.VT + (me * 16 + fr) * LDT + ks * 32 + 4 * fq;
                    u32x2 lo = *(const u32x2*)vp, hi = *(const u32x2*)(vp + 16);
                    u32x4 vv = (u32x4){lo.x, lo.y, hi.x, hi.y};
                    o[me] = __builtin_amdgcn_mfma_f32_16x16x32_bf16(*(bf16x8*)&vv, pf, o[me], 0, 0, 0);
                }
            }
            {
                float s1 = 0.f;
#pragma unroll
                for (int me = 0; me < 8; ++me) s1 += (o[me][0] + o[me][1]) + (o[me][2] + o[me][3]);
                s1 = xrow16_sum(s1);
                const float mu = s1 * (1.0f / 128.0f);
                float s2 = 0.f;
#pragma unroll
                for (int me = 0; me < 8; ++me)
#pragma unroll
                    for (int r = 0; r < 4; ++r) { const float d = o[me][r] - mu; s2 += d * d; }
                s2 = xrow16_sum(s2);
                const float rstd = rsqrtf(s2 * (1.0f / 128.0f) + EPS_);
                bf16_t* gp = GC + (size_t)(tok0 + al) * 1024 + h * 128;
                const float* gr = p.g_ret + (size_t)l * 1024 + h * 128;
#pragma unroll
                for (int me = 0; me < 8; ++me) {
                    const int e0 = me * 16 + 4 * fq;
                    u32x2 gu = *(const u32x2*)(gp + e0);
                    f32x4 g4 = *(const f32x4*)(gr + e0);
                    const float y0 = (o[me][0] - mu) * rstd * g4[0] * __uint_as_float(gu.x << 16);
                    const float y1 = (o[me][1] - mu) * rstd * g4[1] * __uint_as_float(gu.x & 0xffff0000u);
                    const float y2 = (o[me][2] - mu) * rstd * g4[2] * __uint_as_float(gu.y << 16);
                    const float y3 = (o[me][3] - mu) * rstd * g4[3] * __uint_as_float(gu.y & 0xffff0000u);
                    u32x2 ou; ou.x = pack2(y0, y1); ou.y = pack2(y2, y3);
                    *(u32x2*)(gp + e0) = ou;
                }
            }
        }
    }
}

__device__ __forceinline__ void mixa1_item(const Params& p, int item, unsigned char* smem) {
    float* tau_s = (float*)smem;
    int* stau_s = (int*)(smem + 64);
    const int tid = ltid(), lane = tid & 63, w = __builtin_amdgcn_readfirstlane(tid >> 6), fr = lane & 15, fq = lane >> 4;
    unsigned char* r1 = p.ws + OFF_R1;
    const bf16_t* IQ = (const bf16_t*)(r1 + R1_IQ);
    const bf16_t* IK = (const bf16_t*)(r1 + R1_IK);
    const float* IW = (const float*)(p.ws + OFF_IW);
    float* SC = (float*)(p.ws + OFF_R3);
    unsigned long long* MASKB = (unsigned long long*)(p.ws + OFF_MASKB);
    {
        const int c = 31 - (item >> 5), b = (item >> 2) & 7, qq = item & 3;
        __syncthreads();
        const int nj = c + 1, n = 64 * nj;
        const int tq = b * 2048 + c * 64 + 16 * qq + fr;
        float* scrow = SC + (size_t)b * SC_PER_BATCH + (size_t)2048 * c * (c + 1) + (size_t)(16 * qq + fr) * n;
        bf16x8 iqf[4][2];
        float iw[4];
#pragma unroll
        for (int hh = 0; hh < 4; ++hh) {
            iw[hh] = IW[(size_t)tq * 4 + hh];
#pragma unroll
            for (int ks = 0; ks < 2; ++ks) iqf[hh][ks] = *(const bf16x8*)(IQ + (size_t)tq * 256 + hh * 64 + ks * 32 + fq * 8);
        }
        for (int kt = w; kt < nj; kt += 4) {
            bf16x8 ikf[4][2];
#pragma unroll
            for (int mk = 0; mk < 4; ++mk)
#pragma unroll
                for (int ks = 0; ks < 2; ++ks) ikf[mk][ks] = *(const bf16x8*)(IK + (size_t)(b * 2048 + kt * 64 + mk * 16 + fr) * 64 + ks * 32 + fq * 8);
            f32x4 sc[4];
#pragma unroll
            for (int mk = 0; mk < 4; ++mk) sc[mk] = (f32x4){0.f, 0.f, 0.f, 0.f};
#pragma unroll
            for (int hh = 0; hh < 4; ++hh) {
#pragma unroll
                for (int mk = 0; mk < 4; ++mk) {
                    f32x4 a = (f32x4){0.f, 0.f, 0.f, 0.f};
#pragma unroll
                    for (int ks = 0; ks < 2; ++ks) a = __builtin_amdgcn_mfma_f32_16x16x32_bf16(ikf[mk][ks], iqf[hh][ks], a, 0, 0, 0);
#pragma unroll
                    for (int r = 0; r < 4; ++r) sc[mk][r] = __fmaf_rn(iw[hh], fmaxf(a[r], 0.f), sc[mk][r]);
                }
            }
#pragma unroll
            for (int mk = 0; mk < 4; ++mk) *(f32x4*)(scrow + kt * 64 + 16 * mk + 4 * fq) = sc[mk];
        }
        __syncthreads();
        for (int i = 0; i < 4; ++i) {
            const int r16 = 4 * w + i;
            float tau = -__builtin_inff();
            int stau = 1 << 30;
            if (nj > 4) {
                const float* rowp = SC + (size_t)b * SC_PER_BATCH + (size_t)2048 * c * (c + 1) + (size_t)(16 * qq + r16) * n;
                unsigned key[32];
#pragma unroll
                for (int j = 0; j < 32; ++j) key[j] = __float_as_uint(rowp[j * 64 + lane]);
#pragma unroll
                for (int j = 0; j < 32; ++j) {
                    const unsigned u = key[j];
                    const unsigned k = u ^ ((unsigned)((int)u >> 31) | 0x80000000u);
                    key[j] = (j < nj) ? k : 0u;
                }
                unsigned X = 0u;
                for (int bit = 31; bit >= 0; --bit) {
                    const unsigned cand = X | (1u << bit);
                    int cnt = 0;
                    int c0 = 0, c1 = 0;
#pragma unroll
                    for (int j = 0; j < 32; j += 4) {
                        if (j < nj) {
                            c0 = cnt_ge(c0, key[j], cand); c1 = cnt_ge(c1, key[j + 1], cand);
                            c0 = cnt_ge(c0, key[j + 2], cand); c1 = cnt_ge(c1, key[j + 3], cand);
                        }
                    }
                    cnt = wave_total6(c0 + c1);
                    if (cnt >= 256) X = cand;
                    if (cnt == 256) break;
                }
                int cgt = 0;
                {
                    const unsigned candp = X + 1u;
                    int c0 = 0, c1 = 0;
#pragma unroll
                    for (int j = 0; j < 32; j += 2) { c0 = cnt_ge(c0, key[j], candp); c1 = cnt_ge(c1, key[j + 1], candp); }
                    cgt = wave_total6(c0 + c1);
                }
                const int need = 256 - cgt;
                unsigned eqbits = 0u;
#pragma unroll
                for (int j = 0; j < 32; ++j) {
                    const unsigned ne = min(key[j] ^ X, 1u);
                    eqbits |= (1u - ne) << j;
                }
                const int teq = wave_sum_i(__popc(eqbits));
                if (teq == need) {
                    stau = 1 << 30;
                } else {
                    int lo = 0, hi = n - 1;
                    while (lo < hi) {
                        const int mid = (lo + hi) >> 1;
                        const int jmax = (mid - lane) >> 6;
                        const unsigned msk = jmax < 0 ? 0u : (jmax >= 31 ? 0xffffffffu : ((2u << jmax) - 1u));
                        const int cc = wave_sum_i(__popc(eqbits & msk));
                        if (cc >= need) hi = mid; else lo = mid + 1;
                    }
                    stau = lo;
                }
                const unsigned ux = (X & 0x80000000u) ? (X & 0x7fffffffu) : ~X;
                tau = __uint_as_float(ux);
            }
            if (lane == 0) { tau_s[r16] = tau; stau_s[r16] = stau; }
        }
        __syncthreads();
        {
            const float tau = tau_s[fr];
            const int stau = stau_s[fr];
            for (int kt = w; kt < nj; kt += 4) {
                unsigned lo = 0u, hi = 0u;
#pragma unroll
                for (int mk = 0; mk < 4; ++mk) {
                    const f32x4 v = *(const f32x4*)(scrow + kt * 64 + 16 * mk + 4 * fq);
#pragma unroll
                    for (int r = 0; r < 4; ++r) {
                        const int kl = 16 * mk + 4 * fq + r;
                        const bool sel = (v[r] > tau) || (v[r] == tau && (kt * 64 + kl) <= stau);
                        if (sel) { if (mk < 2) lo |= 1u << kl; else hi |= 1u << (kl - 32); }
                    }
                }
                lo |= __shfl_xor(lo, 16); lo |= __shfl_xor(lo, 32);
                hi |= __shfl_xor(hi, 16); hi |= __shfl_xor(hi, 32);
                if (fq == 0) MASKB[(size_t)tq * 32 + kt] = ((unsigned long long)hi << 32) | lo;
            }
        }
        __syncthreads();
    }
}

__device__ __forceinline__ void a2_tile(const AttnLds& sm, const bf16x8 (&qf)[2], f32x4 (&O)[4], float& mrun, float& lrun, unsigned long long W, int fr, int fq) {
    f32x4 st[4];
    float mx = -1e30f;
    f32x4 rsv[4];
#pragma unroll
    for (int mk = 0; mk < 4; ++mk) {
        st[mk] = (f32x4){0.f, 0.f, 0.f, 0.f};
#pragma unroll
        for (int ks = 0; ks < 2; ++ks) {
            bf16x8 kf = *(const bf16x8*)(sm.K + (mk * 16 + fr) * LDT + ks * 32 + fq * 8);
            st[mk] = __builtin_amdgcn_mfma_f32_16x16x32_bf16(kf, qf[ks], st[mk], 0, 0, 0);
        }
        rsv[mk] = *(const f32x4*)(sm.rs + 16 * mk + 4 * fq);
        const unsigned nib = (unsigned)(W >> (16 * mk + 4 * fq)) & 0xfu;
#pragma unroll
        for (int r = 0; r < 4; ++r) {
            st[mk][r] *= rsv[mk][r];
            if ((nib >> r) & 1u) mx = fmaxf(mx, st[mk][r]);
        }
    }
    mx = xrow16_max(mx);
    const float mnew = fmaxf(mrun, mx);
    const float alpha = __expf(mrun - mnew);
    float ps = 0.f;
    float P[4][4];
#pragma unroll
    for (int mk = 0; mk < 4; ++mk) {
        const unsigned nib = (unsigned)(W >> (16 * mk + 4 * fq)) & 0xfu;
#pragma unroll
        for (int r = 0; r < 4; ++r) {
            const float pv = ((nib >> r) & 1u) ? __expf(st[mk][r] - mnew) : 0.f;
            ps += pv;
            P[mk][r] = pv * rsv[mk][r];
        }
    }
    ps = xrow16_sum(ps);
    lrun = lrun * alpha + ps;
    mrun = mnew;
#pragma unroll
    for (int me = 0; me < 4; ++me) O[me] *= alpha;
#pragma unroll
    for (int ks = 0; ks < 2; ++ks) {
        u32x4 uu = (u32x4){pack2(P[2 * ks][0], P[2 * ks][1]), pack2(P[2 * ks][2], P[2 * ks][3]),
                           pack2(P[2 * ks + 1][0], P[2 * ks + 1][1]), pack2(P[2 * ks + 1][2], P[2 * ks + 1][3])};
        bf16x8 pf = *(bf16x8*)&uu;
#pragma unroll
        for (int me = 0; me < 4; ++me) {
            const bf16_t* vp = sm.Vt + (me * 16 + fr) * LDT + ks * 32 + 4 * fq;
            u32x2 lo = *(const u32x2*)vp, hi = *(const u32x2*)(vp + 16);
            u32x4 vv = (u32x4){lo.x, lo.y, hi.x, hi.y};
            O[me] = __builtin_amdgcn_mfma_f32_16x16x32_bf16(*(bf16x8*)&vv, pf, O[me], 0, 0, 0);
        }
    }
}
__device__ __forceinline__ void ph_mix_a2(const Params& p, unsigned char* smem) {
    AttnLds& sm = *(AttnLds*)smem;
    const int tid = ltid(), lane = tid & 63, w = __builtin_amdgcn_readfirstlane(tid >> 6), fr = lane & 15, fq = lane >> 4;
    unsigned char* r1 = p.ws + OFF_R1;
    bf16_t* QA = (bf16_t*)(r1 + R1_QA);
    const bf16_t* KA = (const bf16_t*)(r1 + R1_KA);
    const bf16_t* VAT = (const bf16_t*)(r1 + R1_VAT);
    const float* CKVSS = (const float*)(p.ws + OFF_CKVSS);
    const unsigned long long* MASKB = (const unsigned long long*)(p.ws + OFF_MASKB);
    for (int item = blockIdx.x; item < 1024; item += gridDim.x) {
        const int c = 31 - (item >> 5), b = (item >> 2) & 7, h0 = (item & 3) * 2;
        const int tq = b * 2048 + c * 64 + 16 * w + fr;
        bf16x8 qf0[2], qf1[2];
#pragma unroll
        for (int ks = 0; ks < 2; ++ks) {
            qf0[ks] = *(const bf16x8*)(QA + (size_t)tq * 512 + h0 * 64 + ks * 32 + fq * 8);
            qf1[ks] = *(const bf16x8*)(QA + (size_t)tq * 512 + (h0 + 1) * 64 + ks * 32 + fq * 8);
        }
        f32x4 O0[4], O1[4];
#pragma unroll
        for (int me = 0; me < 4; ++me) { O0[me] = (f32x4){0.f, 0.f, 0.f, 0.f}; O1[me] = (f32x4){0.f, 0.f, 0.f, 0.f}; }
        float m0r = -1e30f, l0r = 0.f, m1r = -1e30f, l1r = 0.f;
        for (int kt = 0; kt <= c; ++kt) {
            __syncthreads();
            stage_tile64(sm.K, KA + (size_t)(b * 2048 + kt * 64) * 64, 64, tid);
            stage_tile64(sm.Vt, VAT + ((size_t)b * 64) * 2048 + kt * 64, 2048, tid);
            if (tid < 64) {
                const f32x4 s4 = *(const f32x4*)(CKVSS + (size_t)(b * 2048 + kt * 64 + tid) * 4);
                sm.rs[tid] = rsqrtf(((s4[0] + s4[1]) + (s4[2] + s4[3])) * (1.0f / 256.0f) + EPS_);
            }
            const unsigned long long W = MASKB[(size_t)tq * 32 + kt];
            __syncthreads();
            a2_tile(sm, qf0, O0, m0r, l0r, W, fr, fq);
            __builtin_amdgcn_sched_barrier(0);
            a2_tile(sm, qf1, O1, m1r, l1r, W, fr, fq);
        }
        const float inv0 = 1.0f / l0r, inv1 = 1.0f / l1r;
        const int ts = ltid();
        const int fqs = (ts & 63) >> 4;
        const int tqs = b * 2048 + c * 64 + 16 * (ts >> 6) + (ts & 15);
#pragma unroll
        for (int me = 0; me < 4; ++me) {
            u32x2 u; u.x = pack2(O0[me][0] * inv0, O0[me][1] * inv0); u.y = pack2(O0[me][2] * inv0, O0[me][3] * inv0);
            *(u32x2*)(QA + (size_t)tqs * 512 + h0 * 64 + me * 16 + 4 * fqs) = u;
            u32x2 v; v.x = pack2(O1[me][0] * inv1, O1[me][1] * inv1); v.y = pack2(O1[me][2] * inv1, O1[me][3] * inv1);
            *(u32x2*)(QA + (size_t)tqs * 512 + (h0 + 1) * 64 + me * 16 + 4 * fqs) = v;
        }
    }
}

__device__ __forceinline__ void ph_merge(const Params& p, unsigned char* smem) {
    bf16_t* sT = (bf16_t*)smem;
    const int tid = ltid(), lane = tid & 63, wid = __builtin_amdgcn_readfirstlane(tid >> 6), wr = wid >> 1, wc = wid & 1, fr = lane & 15, fq = lane >> 4;
    unsigned char* r1 = p.ws + OFF_R1;
    const bf16_t* WB = (const bf16_t*)(p.ws + OFF_WB);
    const bf16_t* GATES = (const bf16_t*)(r1 + R1_GATES);
    bf16_t* MG = (bf16_t*)(p.ws + OFF_H);
    const int xcd = blockIdx.x & 7, jb = blockIdx.x >> 3, nper = gridDim.x >> 3;
    for (int q = jb; q < 256; q += nper) {
        const int nt = q >> 4, mtl = q & 15;
        const int mt = 16 * xcd + mtl, m0 = mt * 128, n0 = nt * 64;
        f32x4 macc[4][2];
        zero_acc<2>(macc);
#pragma unroll 1
        for (int br = 0; br < 3; ++br) {
            const bf16_t* A = (const bf16_t*)(r1 + (br == 0 ? R1_QA : (br == 1 ? R1_QB : R1_GC)));
            const int K = (br == 2) ? 1024 : 512;
            const bf16_t* Bt = WB + (br == 0 ? WB_WOA : (br == 1 ? WB_WOB : WB_WOC));
            unsigned ao[4], bo[2];
#pragma unroll
            for (int i = 0; i < 4; ++i) ao[i] = (unsigned)(m0 + stg_row(tid, i, 4)) * (unsigned)K + stg_chunk(tid, i) * 8;
#pragma unroll
            for (int i = 0; i < 2; ++i) bo[i] = (unsigned)(n0 + stg_row(tid, i, 2)) * (unsigned)K + stg_chunk(tid, i) * 8;
            f32x4 acc[4][2];
            zero_acc<2>(acc);
            gemm_kloop2<2>(acc, A, ao, Bt, bo, K, smem, tid);
            {
                const int bb = m0 >> 11, s0 = (m0 & 2047) + wr * 64 + fq * 4;
#pragma unroll
                for (int n = 0; n < 2; ++n) {
                    const bf16_t* gp = GATES + ((size_t)bb * 3072 + br * 1024 + n0 + wc * 32 + n * 16 + fr) * 2048 + s0;
#pragma unroll
                    for (int m = 0; m < 4; ++m) {
                        const u32x2 gu = *(const u32x2*)(gp + m * 16);
                        macc[m][n][0] += __uint_as_float(gu.x << 16) * acc[m][n][0];
                        macc[m][n][1] += __uint_as_float(gu.x & 0xffff0000u) * acc[m][n][1];
                        macc[m][n][2] += __uint_as_float(gu.y << 16) * acc[m][n][2];
                        macc[m][n][3] += __uint_as_float(gu.y & 0xffff0000u) * acc[m][n][3];
                    }
                }
            }
        }
        __syncthreads();
        lds_put_tile<2>(sT, macc, wr, wc, fr, fq);
        __syncthreads();
#pragma unroll
        for (int i = 0; i < 4; ++i) {
            const int c = tid + 256 * i, row = c >> 3, ch = c & 7;
            *(u32x4*)(MG + (size_t)(m0 + row) * 1024 + n0 + ch * 8) = *(const u32x4*)(sT + row * LDE + ch * 8);
        }
    }
}

__device__ __forceinline__ void ph_outproj(const Params& p, unsigned char* smem) {
    bf16_t* sT = (bf16_t*)smem;
    const int tid = ltid(), lane = tid & 63, wid = __builtin_amdgcn_readfirstlane(tid >> 6), wr = wid >> 1, wc = wid & 1, fr = lane & 15, fq = lane >> 4;
    const bf16_t* MG = (const bf16_t*)(p.ws + OFF_H);
    const bf16_t* Bt = (const bf16_t*)(p.ws + OFF_WB) + WB_WOUT;
    bf16_t* Y = (bf16_t*)(p.ws + OFF_R1 + R1_QC);
    for (int tile = blockIdx.x; tile < 128 * 8; tile += gridDim.x) {
        const int mt = tile >> 3, nt = tile & 7, m0 = mt * 128, n0 = nt * 128;
        unsigned ao[4], bo[4];
#pragma unroll
        for (int i = 0; i < 4; ++i) {
            const int R = stg_row(tid, i, 4), g = stg_chunk(tid, i);
            ao[i] = (unsigned)(m0 + R) * 1024u + g * 8;
            bo[i] = (unsigned)(n0 + R) * 1024u + g * 8;
        }
        f32x4 acc[4][4];
        zero_acc<4>(acc);
        gemm_kloop2<4>(acc, MG, ao, Bt, bo, 1024, smem, tid);
        __syncthreads();
        lds_put_tile<4>(sT, acc, wr, wc, fr, fq);
        __syncthreads();
#pragma unroll
        for (int i = 0; i < 8; ++i) {
            const int c = tid + 256 * i, row = c >> 4, ch = c & 15;
            *(u32x4*)(Y + (size_t)(m0 + row) * 1024 + n0 + ch * 8) = *(const u32x4*)(sT + row * LDE + ch * 8);
        }
    }
}

__device__ __forceinline__ void ph_router(const Params& p, int l, unsigned char* smem) {
    const int tid = ltid(), lane = tid & 63, wid = __builtin_amdgcn_readfirstlane(tid >> 6), wr = wid >> 1, wc = wid & 1, fr = lane & 15, fq = lane >> 4;
    const bf16_t* H = (const bf16_t*)(p.ws + OFF_H);
    const bf16_t* Bt = (const bf16_t*)(p.ws + OFF_WB) + WB_WR;
    int* cnt = (int*)(p.ws + OFF_CTL) + l * 64;
    int* LIST = (int*)(p.ws + OFF_LIST);
    float* AW = (float*)(p.ws + OFF_AW);
    const float* bias = p.router_bias + l * 64;
    float* lg = (float*)smem;
    for (int mt = blockIdx.x; mt < 128; mt += gridDim.x) {
        const int m0 = mt * 128;
        unsigned ao[4], bo[4];
#pragma unroll
        for (int i = 0; i < 4; ++i) {
            const int R = stg_row(tid, i, 4), g = stg_chunk(tid, i);
            ao[i] = (unsigned)(m0 + R) * 1024u + g * 8;
            bo[i] = (unsigned)R * 1024u + g * 8;
        }
        f32x4 acc[4][4];
        zero_acc<4>(acc);
        gemm_kloop2<4>(acc, H, ao, Bt, bo, 1024, smem, tid);
        __syncthreads();
        if (wc == 0) {
#pragma unroll
            for (int m = 0; m < 4; ++m)
#pragma unroll
                for (int j = 0; j < 4; ++j)
#pragma unroll
                    for (int n = 0; n < 4; ++n) lg[(wr * 64 + m * 16 + fq * 4 + j) * 65 + n * 16 + fr] = acc[m][n][j];
        }
        __syncthreads();
        if (tid < 128) {
            float* row = lg + tid * 65;
            const int t = m0 + tid;
            float gs[8];
#pragma unroll
            for (int g = 0; g < 8; ++g) {
                float m1 = -__builtin_inff(), m2 = -__builtin_inff();
#pragma unroll
                for (int e = 0; e < 8; ++e) {
                    const float v = sigmoidf_(row[g * 8 + e]) + bias[g * 8 + e];
                    row[g * 8 + e] = v;
                    if (v > m1) { m2 = m1; m1 = v; } else if (v > m2) m2 = v;
                }
                gs[g] = m1 + m2;
            }
            unsigned gmask = 0u;
#pragma unroll
            for (int g = 0; g < 8; ++g) {
                int rank = 0;
#pragma unroll
                for (int g2 = 0; g2 < 8; ++g2) rank += (gs[g2] > gs[g] || (gs[g2] == gs[g] && g2 < g)) ? 1 : 0;
                if (rank < 4) gmask |= 1u << g;
            }
            unsigned long long taken = 0ull;
            int eidx[8]; float esc[8];
            float ssum = 0.f;
#pragma unroll
            for (int k = 0; k < 8; ++k) {
                float best = -__builtin_inff(); int bi = 0;
                for (int e = 0; e < 64; ++e) {
                    if (!((gmask >> (e >> 3)) & 1u) || ((taken >> e) & 1ull)) continue;
                    const float v = row[e];
                    if (v > best) { best = v; bi = e; }
                }
                taken |= 1ull << bi;
                eidx[k] = bi;
                esc[k] = best - bias[bi];
                ssum += esc[k];
            }
            const float scale = 2.5f / ssum;
            int slot[8];
#pragma unroll
            for (int k = 0; k < 8; ++k) slot[k] = atomicAdd(&cnt[eidx[k]], 1);
#pragma unroll
            for (int k = 0; k < 8; ++k) {
                LIST[(size_t)eidx[k] * T_ + slot[k]] = t * 8 + k;
                AW[(size_t)t * 8 + k] = esc[k] * scale;
            }
        }
        __syncthreads();
    }
}

struct __attribute__((aligned(16))) MoeLds { int tstart[66]; int xs[10]; int pad0[20]; int hbase[66]; int pad1[14]; int rowid[128]; };
__device__ __forceinline__ void moe_setup(MoeLds& sm, const int* cnt, int tid) {
    __syncthreads();
    if (tid == 0) {
        int ts = 0, hb = 0;
        for (int e = 0; e < 65; ++e) {
            const int ce = (e < 64) ? cnt[e] : T_;
            sm.tstart[e] = ts; sm.hbase[e] = hb;
            ts += (ce + 127) >> 7; hb += ce;
        }
        sm.tstart[65] = ts; sm.hbase[65] = hb;
        const int xcd = blockIdx.x & 7;
        int acc = 0;
        for (int k = 0; k < 8; ++k) { sm.xs[k] = acc; acc += sm.tstart[k * 8 + xcd + 1] - sm.tstart[k * 8 + xcd]; }
        sm.xs[8] = acc; acc += 16; sm.xs[9] = acc;
    }
    __syncthreads();
}

__device__ __forceinline__ void ph_moe1(const Params& p, int l, unsigned char* smem) {
    MoeLds& sm = *(MoeLds*)(smem + MISC + 64);
    const int tid = ltid(), lane = tid & 63, wid = __builtin_amdgcn_readfirstlane(tid >> 6), wr = wid >> 1, wc = wid & 1, fr = lane & 15, fq = lane >> 4;
    const bf16_t* H = (const bf16_t*)(p.ws + OFF_H);
    const bf16_t* W13 = (const bf16_t*)(p.ws + OFF_WB) + WB_W13;
    const int* cnt = (const int*)(p.ws + OFF_CTL) + l * 64;
    const int* LIST = (const int*)(p.ws + OFF_LIST);
    bf16_t* HID = (bf16_t*)(p.ws + OFF_R3);
    moe_setup(sm, cnt, tid);
    const int xcd = blockIdx.x & 7, jb = blockIdx.x >> 3, nper = gridDim.x >> 3;
    const int nitems = sm.xs[9] * 4;
    for (int item = jb; item < nitems; item += nper) {
        const int rtl = item >> 2, nt = item & 3;
        int k = 0;
        while (sm.xs[k + 1] <= rtl) ++k;
        const int e = (k < 8) ? (k * 8 + xcd) : 64;
        const int mtl = rtl - sm.xs[k] + ((k == 8) ? 16 * xcd : 0);
        const int ce = (e < 64) ? cnt[e] : T_;
        __syncthreads();
        if (tid < 128) {
            const int slot = mtl * 128 + tid;
            int tok = 0;
            if (slot < ce) tok = (e < 64) ? (LIST[(size_t)e * T_ + slot] >> 3) : slot;
            sm.rowid[tid] = tok;
        }
        __syncthreads();
        unsigned ao[4], bo[4];
#pragma unroll
        for (int i = 0; i < 4; ++i) {
            const int R = stg_row(tid, i, 4), g = stg_chunk(tid, i);
            ao[i] = (unsigned)sm.rowid[R] * 1024u + g * 8;
            bo[i] = (unsigned)(e * 512 + nt * 128 + R) * 1024u + g * 8;
        }
        f32x4 acc[4][4];
        zero_acc<4>(acc);
        gemm_kloop2<4>(acc, H, ao, W13, bo, 1024, smem, tid);
        const int hb = sm.hbase[e] + mtl * 128;
        f32x4 hacc[4][2];
#pragma unroll
        for (int m = 0; m < 4; ++m)
#pragma unroll
            for (int nn = 0; nn < 2; ++nn)
#pragma unroll
                for (int j = 0; j < 4; ++j) hacc[m][nn][j] = siluf_(acc[m][nn][j]) * acc[m][nn + 2][j];
        bf16_t* sT = (bf16_t*)smem;
        __syncthreads();
        lds_put_tile<2>(sT, hacc, wr, wc, fr, fq);
        __syncthreads();
        const int ts = ltid();
#pragma unroll
        for (int i = 0; i < 4; ++i) {
            const int c = ts + 256 * i, row = c >> 3, ch = c & 7;
            if (mtl * 128 + row < ce)
                *(u32x4*)(HID + (size_t)(hb + row) * 256 + nt * 64 + ch * 8) = *(const u32x4*)(sT + row * LDE + ch * 8);
        }
    }
}

__device__ __forceinline__ void ph_moe2(const Params& p, int l, unsigned char* smem) {
    MoeLds& sm = *(MoeLds*)(smem + MISC + 64);
    const int tid = ltid(), lane = tid & 63, wid = __builtin_amdgcn_readfirstlane(tid >> 6), wr = wid >> 1, wc = wid & 1, fr = lane & 15, fq = lane >> 4;
    const bf16_t* W2 = (const bf16_t*)(p.ws + OFF_WB) + WB_W2;
    const int* cnt = (const int*)(p.ws + OFF_CTL) + l * 64;
    const int* LIST = (const int*)(p.ws + OFF_LIST);
    const float* AW = (const float*)(p.ws + OFF_AW);
    const bf16_t* HID = (const bf16_t*)(p.ws + OFF_R3);
    bf16_t* SLOTS = (bf16_t*)(p.ws + OFF_R1);
    moe_setup(sm, cnt, tid);
    const int xcd = blockIdx.x & 7, jb = blockIdx.x >> 3, nper = gridDim.x >> 3;
    const int nitems = sm.xs[9] * 8;
    for (int item = jb; item < nitems; item += nper) {
        const int rtl = item >> 3, nt = item & 7;
        int k = 0;
        while (sm.xs[k + 1] <= rtl) ++k;
        const int e = (k < 8) ? (k * 8 + xcd) : 64;
        const int mtl = rtl - sm.xs[k] + ((k == 8) ? 16 * xcd : 0);
        const int ce = (e < 64) ? cnt[e] : T_;
        __syncthreads();
        if (tid < 128) {
            const int slot = mtl * 128 + tid;
            int aid = -1;
            if (slot < ce) aid = (e < 64) ? LIST[(size_t)e * T_ + slot] : (8 * T_ + slot);
            sm.rowid[tid] = aid;
        }
        __syncthreads();
        const int hb = sm.hbase[e] + mtl * 128;
        unsigned ao[4], bo[4];
#pragma unroll
        for (int i = 0; i < 4; ++i) {
            const int R = stg_row(tid, i, 4), g = stg_chunk(tid, i);
            ao[i] = (unsigned)(hb + R) * 256u + g * 8;
            bo[i] = (unsigned)(e * 1024 + nt * 128 + R) * 256u + g * 8;
        }
        f32x4 acc[4][4];
        zero_acc<4>(acc);
        gemm_kloop2<4>(acc, HID, ao, W2, bo, 256, smem, tid);
        const int ts = ltid();
        const int fqs = (ts & 63) >> 4;
#pragma unroll
        for (int m = 0; m < 4; ++m)
#pragma unroll
            for (int j = 0; j < 4; ++j) {
                const int r = wr * 64 + m * 16 + fqs * 4 + j;
                const int aid = sm.rowid[r];
                const float wt = (aid >= 0 && e < 64) ? AW[aid] : 1.0f;
#pragma unroll
                for (int n = 0; n < 4; ++n) acc[m][n][j] *= wt;
            }
        bf16_t* sT = (bf16_t*)smem;
        __syncthreads();
        lds_put_tile<4>(sT, acc, wr, wc, fr, fq);
        __syncthreads();
#pragma unroll
        for (int i = 0; i < 8; ++i) {
            const int c = ts + 256 * i, row = c >> 4, ch = c & 15;
            const int aid = sm.rowid[row];
            if (aid >= 0)
                __builtin_nontemporal_store(*(const u32x4*)(sT + row * LDE + ch * 8), (u32x4*)(SLOTS + (size_t)aid * 1024 + nt * 128 + ch * 8));
        }
    }
}

struct JobDesc { int K, NQ, src_ld, dst_ld, mode, p0, nbatch, which; unsigned src_lstride, src_bs, dst_bs, dst_off; };
constexpr int NJOBS = 12;
__constant__ JobDesc JOBS[NJOBS] = {
    {1024, 8832, NIN_, 1024, 1, 0, 1, 9, 1024u * NIN_, 0u, 0u, (unsigned)WB_WIN},
    {512, 1024, 1024, 512, 0, 0, 1, 14, 512u * 1024u, 0u, 0u, (unsigned)WB_WOA},
    {512, 1024, 1024, 512, 0, 0, 1, 15, 512u * 1024u, 0u, 0u, (unsigned)WB_WOB},
    {1024, 1024, 1024, 1024, 0, 0, 1, 16, 1024u * 1024u, 0u, 0u, (unsigned)WB_WOC},
    {1024, 1024, 1024, 1024, 0, 0, 1, 17, 1024u * 1024u, 0u, 0u, (unsigned)WB_WOUT},
    {1024, 128, 64, 1024, 3, 0, 1, 18, 1024u * 64u, 0u, 0u, (unsigned)WB_WR},
    {1024, 256, 256, 1024, 2, 0, 64, 20, 64u * 1024u * 256u, 1024u * 256u, 512u * 1024u, (unsigned)WB_W13},
    {1024, 256, 256, 1024, 2, 32, 64, 21, 64u * 1024u * 256u, 1024u * 256u, 512u * 1024u, (unsigned)WB_W13},
    {1024, 256, 256, 1024, 2, 0, 1, 23, 1024u * 256u, 0u, 0u, (unsigned)(WB_W13 + (size_t)64 * 512 * 1024)},
    {1024, 256, 256, 1024, 2, 32, 1, 24, 1024u * 256u, 0u, 0u, (unsigned)(WB_W13 + (size_t)64 * 512 * 1024)},
    {256, 1024, 1024, 256, 0, 0, 64, 22, 64u * 256u * 1024u, 256u * 1024u, 1024u * 256u, (unsigned)WB_W2},
    {256, 1024, 1024, 256, 0, 0, 1, 25, 256u * 1024u, 0u, 0u, (unsigned)(WB_W2 + (size_t)64 * 1024 * 256)},
};
__constant__ int JOBPRE[NJOBS + 1] = {0, 2208, 2336, 2464, 2720, 2976, 3008, 7104, 11200, 11264, 11328, 15424, 15488};
__device__ __forceinline__ TJob make_job(const Params& p, int l, int it, int& base) {
    int j = 0;
    while (JOBPRE[j + 1] <= it) ++j;
    const JobDesc d = JOBS[j];
    TJob tj;
    tj.src = ((const float* const*)&p)[d.which] + (size_t)l * d.src_lstride;
    tj.dst = (bf16_t*)(p.ws + OFF_WB) + d.dst_off;
    tj.K = d.K; tj.NQ = d.NQ; tj.src_ld = d.src_ld; tj.dst_ld = d.dst_ld; tj.mode = d.mode; tj.p0 = d.p0; tj.nbatch = d.nbatch; tj.pad = 0;
    tj.src_bs = d.src_bs; tj.dst_bs = d.dst_bs;
    base = JOBPRE[j];
    return tj;
}
__device__ __forceinline__ void tconv_range(const Params& p, int l, unsigned char* smem, int first, int stride, int it0, int it1) {
    float* tile = (float*)smem;
    const int tid = ltid();
    const int total = it1;
    __syncthreads();
    int it = it0 + first;
    f32x4 r[4];
    if (it < total) { int base; const TJob tj = make_job(p, l, it, base); tconv_load(tj, it - base, tid, r); }
    while (it < total) {
        const int nxt = it + stride;
        tconv_put(tid, r, tile);
        __syncthreads();
        if (nxt < total) { int base; const TJob tj = make_job(p, l, nxt, base); tconv_load(tj, nxt - base, tid, r); }
        { int base; const TJob tj = make_job(p, l, it, base); tconv_emit(tj, it - base, tid, tile); }
        __syncthreads();
        it = nxt;
    }
}

constexpr int TC_MIX_END = 3008;
__device__ __forceinline__ void ph_tconv_mix(const Params& p, int l, unsigned char* smem) { tconv_range(p, l, smem, blockIdx.x, gridDim.x, 0, TC_MIX_END); }
constexpr int SMEM_BYTES = DYN_LDS;
__device__ __forceinline__ int next_item(int* ctr, unsigned char* smem) {
    int* s_item = (int*)(smem + MISC);
    __syncthreads();
    if (ltid() == 0) *s_item = atomicAdd(ctr, 1);
    __syncthreads();
    return *s_item;
}
constexpr int TC_CH = 8;
constexpr int TC_NCH = (15488 - TC_MIX_END + TC_CH - 1) / TC_CH;
__device__ __forceinline__ void ph_tconv_moe(const Params& p, int l, unsigned char* smem) {
    int* ctr = (int*)(p.ws + OFF_CTL) + 256 + l * 4;
    for (;;) { const int it = next_item(ctr + 3, smem); if (it >= TC_NCH) break;
        const int a0 = TC_MIX_END + it * TC_CH; tconv_range(p, l, smem, 0, 1, a0, (a0 + TC_CH < JOBPRE[NJOBS]) ? a0 + TC_CH : JOBPRE[NJOBS]); }
}
__device__ __forceinline__ void ph_mix1(const Params& p, int l, unsigned char* smem) {
    int* ctr = (int*)(p.ws + OFF_CTL) + 256 + l * 4;
    for (;;) { const int it = next_item(ctr + 0, smem); if (it >= 2048) break; mixc1_item(p, it, smem); }
    for (;;) { const int it = next_item(ctr + 1, smem); if (it >= 1024) break; mixb_item(p, it, smem); }
    for (;;) { const int it = next_item(ctr + 2, smem); if (it >= 1024) break; mixa1_item(p, it, smem); }
}


constexpr size_t OFF_BAR = 16 * KiB;
#define XB_TMO      128
#define XB_XCNT(j)  (256  + 64 * (j))
#define XB_XSUB(j)  (1280 + 64 * (j))
#define XB_XGEN(j)  (2304 + 64 * (j))
#define XB_TOP      3328
#define XB_TOPGEN   3392
#define XCD_BAR_WORDS 3456
#define XB_SPIN_CAP (1u << 18)
__device__ __forceinline__ unsigned xb_ld(unsigned* p)              { return __hip_atomic_load(p, __ATOMIC_RELAXED, __HIP_MEMORY_SCOPE_AGENT); }
__device__ __forceinline__ unsigned xb_add(unsigned* p, unsigned v) { return __hip_atomic_fetch_add(p, v, __ATOMIC_RELAXED, __HIP_MEMORY_SCOPE_AGENT); }
__device__ __forceinline__ unsigned xb_xcc_id() { return (unsigned)__builtin_amdgcn_s_getreg((3 << 11) | 20) & 0xFu; }
#define XB_SPIN(cond, bar) do { unsigned _sp = 0; while (cond) { __builtin_amdgcn_s_sleep(1); \
    if ((++_sp & 255u) == 0u) { if (xb_ld(&(bar)[XB_TMO])) break; if (_sp > XB_SPIN_CAP) { atomicAdd(&(bar)[XB_TMO], 1u); break; } } } } while (0)
__device__ __forceinline__ void xcd_barrier_post(unsigned* bar) {
    if (threadIdx.x == 0) (void)xb_add(&bar[XB_XCNT(xb_xcc_id())], 1u);
}
__device__ __forceinline__ void xcd_barrier_complete(unsigned* bar, unsigned x, unsigned& nloc, unsigned& nx) {
    const unsigned G = gridDim.x * gridDim.y * gridDim.z;
    unsigned sum, cnt, mine, sp = 0u;
    for (;;) {
        sum = 0u; cnt = 0u; mine = 0u;
#pragma unroll
        for (unsigned j = 0; j < 16; ++j) { const unsigned c = xb_ld(&bar[XB_XCNT(j)]); sum += c; cnt += (c > 0u) ? 1u : 0u; mine = (j == x) ? c : mine; }
        if (sum == G) break;
        __builtin_amdgcn_s_sleep(1);
        if ((++sp & 255u) == 0u) { if (xb_ld(&bar[XB_TMO])) break; if (sp > XB_SPIN_CAP) { atomicAdd(&bar[XB_TMO], 1u); break; } }
    }
    nloc = mine > 0u ? mine : 1u; nx = cnt > 0u ? cnt : 1u;
}
__device__ __forceinline__ void xcd_barrier(unsigned* bar, volatile LAS unsigned* st) {
    asm volatile("s_waitcnt vmcnt(0)" ::: "memory");
    __syncthreads();
    if (threadIdx.x == 0) {
        const unsigned x = xb_xcc_id();
        __builtin_amdgcn_s_waitcnt(0);
        unsigned nloc = st[0], nx = st[1];
        if (nloc == 0u) { xcd_barrier_complete(bar, x, nloc, nx); st[0] = nloc; st[1] = nx; }
        const unsigned old = xb_add(&bar[XB_XSUB(x)], 1u);
        const unsigned gen = old / nloc;
        if (old + 1u == (gen + 1u) * nloc) {
            __builtin_amdgcn_fence(__ATOMIC_RELEASE, "agent");
            asm volatile("s_waitcnt vmcnt(0)" ::: "memory");
            const unsigned og = xb_add(&bar[XB_TOP], 1u);
            const unsigned tg = og / nx;
            if (og + 1u == (tg + 1u) * nx) xb_add(&bar[XB_TOPGEN], 1u);
            else XB_SPIN(xb_ld(&bar[XB_TOPGEN]) == tg, bar);
            __builtin_amdgcn_fence(__ATOMIC_ACQUIRE, "agent");
            xb_add(&bar[XB_XGEN(x)], 1u);
            asm volatile("s_waitcnt vmcnt(0)" ::: "memory");
        } else {
            XB_SPIN(xb_ld(&bar[XB_XGEN(x)]) == gen, bar);
            __builtin_amdgcn_fence(__ATOMIC_ACQUIRE, "agent");
            asm volatile("s_waitcnt vmcnt(0)" ::: "memory");
        }
    }
    __syncthreads();
}

#define LAUNDER()
__global__ void __launch_bounds__(256, 3) mega(Params p_unused) {
    extern __shared__ __attribute__((aligned(16))) unsigned char smem[];
    if (threadIdx.x == 0) *(u32x4*)(smem + MISC + 16) = (u32x4){0u, 0u, 0u, 0u};
    __syncthreads();
    xcd_barrier_post((unsigned*)(getp().ws + OFF_BAR));
#define GSYNC() xcd_barrier((unsigned*)(getp().ws + OFF_BAR), (volatile LAS unsigned*)(smem + MISC + 16))

    ph_rope(getp());
    ph_mod(getp(), smem);
    ph_tconv_mix(getp(), 0, smem);
    ph_wcomp(getp(), 0, smem);
    GSYNC();
    {
        const Params& p = getp();
        const float* mod = (const float*)(p.ws + OFF_MOD);
        NormArgs a;
        a.xin = p.x; a.Y = nullptr; a.slots = nullptr; a.gpost = nullptr; a.gt = nullptr;
        a.mode = 0; a.gpre = p.g_pre_mix; a.sc = mod + 1024; a.sh = mod + 0;
        ph_norm(p, a);
    }
    GSYNC();
#pragma unroll 1
    for (int l = 0; l < DEPTH_; ++l) {
        ph_gemm_z(getp(), smem);
        GSYNC();
        ph_mix1(getp(), l, smem);
        GSYNC();
        ph_mixc2(getp());
        ph_mix_a2(getp(), smem);
        GSYNC();
        { const Params& p = getp(); for (int it = blockIdx.x; it < 2048; it += gridDim.x) mixc3_item(p, l, it, smem); }
        GSYNC();
        ph_merge(getp(), smem);
        GSYNC();
        ph_outproj(getp(), smem);
        GSYNC();
        {
            const Params& p = getp();
        const float* mod = (const float*)(p.ws + OFF_MOD);
        NormArgs a;
            a.xin = nullptr; a.slots = nullptr;
            a.mode = 1; a.Y = (const bf16_t*)(p.ws + OFF_R1 + R1_QC);
            a.gpost = p.g_post_mix + l * 1024; a.gt = mod + (size_t)l * 8 * 6144 + 2048;
            a.gpre = p.g_pre_ffn + l * 1024; a.sc = mod + (size_t)l * 8 * 6144 + 4096; a.sh = mod + (size_t)l * 8 * 6144 + 3072;
            ph_norm(p, a);
        }
        GSYNC();
        ph_router(getp(), l, smem);
        ph_tconv_moe(getp(), l, smem);
        GSYNC();
        ph_moe1(getp(), l, smem);
        GSYNC();
        ph_moe2(getp(), l, smem);
        GSYNC();
        {
            const Params& p = getp();
        const float* mod = (const float*)(p.ws + OFF_MOD);
        NormArgs a;
            a.xin = nullptr; a.Y = nullptr;
            a.mode = 2; a.slots = (const bf16_t*)(p.ws + OFF_R1);
            a.gpost = p.g_post_ffn + l * 1024; a.gt = mod + (size_t)l * 8 * 6144 + 5120;
            a.gpre = nullptr; a.sc = nullptr; a.sh = nullptr;
            if (l + 1 < DEPTH_) { a.gpre = p.g_pre_mix + (l + 1) * 1024; a.sc = mod + (size_t)(l + 1) * 8 * 6144 + 1024; a.sh = mod + (size_t)(l + 1) * 8 * 6144 + 0; }
            ph_norm(p, a);
        }
        if (l + 1 < DEPTH_) {
            ph_tconv_mix(getp(), l + 1, smem);
            ph_wcomp(getp(), l + 1, smem);
            GSYNC();
        }
    }
}

extern "C" void kernel_launch(void* const* d_in, const int* in_sizes, int n_in, void* d_out, int out_size, void* d_ws, size_t ws_size, hipStream_t stream) {
    if (n_in < 26 || ws_size < WS_TOTAL) { fprintf(stderr, "kernel_launch: bad inputs / workspace too small (%zu < %zu)\n", ws_size, (size_t)WS_TOTAL); return; }
    Params p;
    memset(&p, 0, sizeof(p));
    p.x = (const float*)d_in[0]; p.c = (const float*)d_in[1]; p.positions = (const int*)d_in[2]; p.ada_w = (const float*)d_in[3]; p.ada_b = (const float*)d_in[4];
    p.g_pre_mix = (const float*)d_in[5]; p.g_post_mix = (const float*)d_in[6]; p.g_pre_ffn = (const float*)d_in[7]; p.g_post_ffn = (const float*)d_in[8];
    p.w_in = (const float*)d_in[9]; p.g_kv = (const float*)d_in[10]; p.w_uk = (const float*)d_in[11]; p.w_uv = (const float*)d_in[12]; p.g_ret = (const float*)d_in[13];
    p.w_o_a = (const float*)d_in[14]; p.w_o_b = (const float*)d_in[15]; p.w_o_c = (const float*)d_in[16]; p.w_out = (const float*)d_in[17];
    p.w_router = (const float*)d_in[18]; p.router_bias = (const float*)d_in[19]; p.w1 = (const float*)d_in[20]; p.w3 = (const float*)d_in[21]; p.w2 = (const float*)d_in[22];
    p.ws1 = (const float*)d_in[23]; p.ws3 = (const float*)d_in[24]; p.ws2 = (const float*)d_in[25];
    p.out = (float*)d_out; p.ws = (unsigned char*)d_ws;
    static int grid_blocks = 0;
    if (!grid_blocks) {
        int dev = 0, cus = 0, per_cu = 0;
        (void)hipGetDevice(&dev);
        (void)hipDeviceGetAttribute(&cus, hipDeviceAttributeMultiprocessorCount, dev);
        (void)hipFuncSetAttribute((const void*)mega, hipFuncAttributeMaxDynamicSharedMemorySize, DYN_LDS);
        (void)hipOccupancyMaxActiveBlocksPerMultiprocessor(&per_cu, mega, 256, DYN_LDS);
        if (per_cu < 1) per_cu = 1;
        if (per_cu > 3) per_cu = 3;
        grid_blocks = cus * per_cu;
    }
    (void)hipMemsetAsync((unsigned char*)d_ws + OFF_CTL, 0, 32 * 1024, stream);
    void* args[] = {&p};
    hipError_t e = hipLaunchCooperativeKernel((void*)mega, dim3(grid_blocks), dim3(256), args, DYN_LDS, stream);
    if (e != hipSuccess) fprintf(stderr, "cooperative launch failed: %s (grid %d)\n", hipGetErrorString(e), grid_blocks);
}
```

```cpp
#include <hip/hip_runtime.h>
#include <hip/hip_cooperative_groups.h>
namespace cg = cooperative_groups;
#include <stdint.h>
#include <stdio.h>
#include <string.h>

typedef unsigned short bf16_t;
typedef short bf16x8 __attribute__((ext_vector_type(8)));
typedef short bf16x4 __attribute__((ext_vector_type(4)));
typedef float f32x4 __attribute__((ext_vector_type(4)));
typedef float f32x2 __attribute__((ext_vector_type(2)));
typedef unsigned u32x4 __attribute__((ext_vector_type(4)));
typedef unsigned u32x2 __attribute__((ext_vector_type(2)));

constexpr int T_ = 16384, S_ = 2048, NB_ = 8, D_ = 1024, DEPTH_ = 2;
constexpr int NIN_ = 8772;
constexpr int NZ_ = 8960;
constexpr float EPS_ = 1e-6f;

constexpr int C_QA = 0, C_CKV = 512, C_IQ = 768, C_IK = 1024, C_IW = 1088, C_QB = 1152, C_KB = 1664, C_VB = 2176,
              C_QC = 2688, C_KC = 3200, C_VC = 3712, C_GC = 4736, C_GATES = 5760, C_KA = 8832, C_VA = 8896;

constexpr size_t KiB = 1024, MiB = 1024 * 1024;
constexpr size_t OFF_CTL = 0;
constexpr size_t OFF_MOD = 64 * KiB;
constexpr size_t OFF_IW = 512 * KiB;
constexpr size_t OFF_CKVSS = 768 * KiB;
constexpr size_t OFF_AW = 1 * MiB;
constexpr size_t OFF_ROPE = 2 * MiB;
constexpr size_t OFF_LIST = 6 * MiB;
constexpr size_t OFF_MASKB = 10 * MiB;
constexpr size_t OFF_WB = 14 * MiB;
constexpr size_t WB_WIN = 0;
constexpr size_t WB_WOA = WB_WIN + (size_t)NZ_ * 1024;
constexpr size_t WB_WOB = WB_WOA + 1024 * 512;
constexpr size_t WB_WOC = WB_WOB + 1024 * 512;
constexpr size_t WB_WOUT = WB_WOC + 1024 * 1024;
constexpr size_t WB_WR = WB_WOUT + 1024 * 1024;
constexpr size_t WB_W13 = WB_WR + 128 * 1024;
constexpr size_t WB_W2 = WB_W13 + (size_t)65 * 512 * 1024;
constexpr size_t WB_END = WB_W2 + (size_t)65 * 1024 * 256;
constexpr size_t OFF_H = OFF_WB + ((WB_END * 2 + MiB - 1) / MiB) * MiB;
constexpr size_t OFF_R1 = OFF_H + 32 * MiB;
constexpr size_t R1_QA = 0;
constexpr size_t R1_IQ = R1_QA + 16 * MiB;
constexpr size_t R1_IK = R1_IQ + 8 * MiB;
constexpr size_t R1_KA = R1_IK + 2 * MiB;
constexpr size_t R1_VAT = R1_KA + 2 * MiB;
constexpr size_t R1_QB = R1_VAT + 2 * MiB;
constexpr size_t R1_KB = R1_QB + 16 * MiB;
constexpr size_t R1_VBT = R1_KB + 16 * MiB;
constexpr size_t R1_QC = R1_VBT + 16 * MiB;
constexpr size_t R1_KC = R1_QC + 16 * MiB;
constexpr size_t R1_KCT = R1_KC + 16 * MiB;
constexpr size_t R1_VCT = R1_KCT + 16 * MiB;
constexpr size_t R1_GC = R1_VCT + 32 * MiB;
constexpr size_t R1_GATES = R1_GC + 32 * MiB;
constexpr size_t R1_ZEND = R1_GATES + 96 * MiB;
constexpr size_t R1_SIZE = 288 * MiB;
constexpr size_t OFF_R3 = OFF_R1 + R1_SIZE;
constexpr size_t R3_SIZE = 78 * MiB;
constexpr size_t WS_TOTAL = OFF_R3 + R3_SIZE;
static_assert(R1_ZEND <= R1_SIZE, "r1");
constexpr size_t SC_PER_BATCH = 2162688;

__constant__ float INVF[32] = {
    1.000000000e+00f, 7.498942614e-01f, 5.623413324e-01f, 4.216965139e-01f, 3.162277639e-01f, 2.371373773e-01f, 1.778279394e-01f, 1.333521307e-01f,
    1.000000015e-01f, 7.498941571e-02f, 5.623413250e-02f, 4.216965288e-02f, 3.162277490e-02f, 2.371373773e-02f, 1.778279431e-02f, 1.333521493e-02f,
    9.999999776e-03f, 7.498941850e-03f, 5.623413250e-03f, 4.216964822e-03f, 3.162277630e-03f, 2.371373586e-03f, 1.778279431e-03f, 1.333521446e-03f,
    1.000000047e-03f, 7.498942432e-04f, 5.623413017e-04f, 4.216965172e-04f, 3.162277571e-04f, 2.371373703e-04f, 1.778279402e-04f, 1.333521504e-04f};

__constant__ float LOGG[8] = {-0.0317486983145803f, -0.015748356968139168f, -0.007843177461025893f, -0.003913899321136329f,
                               -0.0019550348358033506f, -0.0009770396478266127f, -0.0004884004981088745f, -0.0002441704321739145f};

__device__ __forceinline__ float bf2f(bf16_t u) { return __uint_as_float(((unsigned)u) << 16); }
__device__ __forceinline__ bf16_t f2bf(float f) {
    unsigned u = __float_as_uint(f);
    u += 0x7fffu + ((u >> 16) & 1u);
    return (bf16_t)(u >> 16);
}
__device__ __forceinline__ unsigned pack2(float a, float b) { return (unsigned)f2bf(a) | ((unsigned)f2bf(b) << 16); }
__device__ __forceinline__ float sigmoidf_(float x) { return __builtin_amdgcn_rcpf(1.0f + __expf(-x)); }
__device__ __forceinline__ float siluf_(float x) { return x * __builtin_amdgcn_rcpf(1.0f + __expf(-x)); }
__device__ __forceinline__ float wave_sum(float v) {
#pragma unroll
    for (int o = 32; o >= 1; o >>= 1) v += __shfl_xor(v, o);
    return v;
}
__device__ __forceinline__ int wave_sum_i(int v) {
#pragma unroll
    for (int o = 32; o >= 1; o >>= 1) v += __shfl_xor(v, o);
    return v;
}

struct Params {
    const float* x; const float* c; const int* positions; const float* ada_w; const float* ada_b;
    const float* g_pre_mix; const float* g_post_mix; const float* g_pre_ffn; const float* g_post_ffn;
    const float* w_in; const float* g_kv; const float* w_uk; const float* w_uv; const float* g_ret;
    const float* w_o_a; const float* w_o_b; const float* w_o_c; const float* w_out;
    const float* w_router; const float* router_bias; const float* w1; const float* w3; const float* w2;
    const float* ws1; const float* ws3; const float* ws2;
    float* out;
    unsigned char* ws;
};

__device__ __forceinline__ int cnt_ge(int cnt, unsigned key, unsigned cand) {
    asm volatile("v_cmp_ge_u32 vcc, %1, %2\n\tv_addc_co_u32 %0, vcc, 0, %0, vcc" : "+v"(cnt) : "v"(key), "v"(cand) : "vcc");
    return cnt;
}
__device__ __forceinline__ int cnt_ge_s(int cnt, unsigned key, unsigned cand) {
    asm volatile("v_cmp_ge_u32 vcc, %1, %2\n\ts_bcnt1_i32_b64 vcc_lo, vcc\n\ts_add_i32 %0, %0, vcc_lo" : "+s"(cnt) : "v"(key), "v"(cand) : "vcc", "scc");
    return cnt;
}
__device__ __forceinline__ int wave_total6(int c) {
    int t = 0;
#pragma unroll
    for (int b = 0; b < 6; ++b) t += __builtin_popcountll(__ballot((c >> b) & 1)) << b;
    return t;
}
__device__ __forceinline__ float xrow16_max(float x) {
    auto s = __builtin_amdgcn_permlane16_swap(__float_as_uint(x), __float_as_uint(x), false, false);
    x = fmaxf(__uint_as_float(s[0]), __uint_as_float(s[1]));
    auto t = __builtin_amdgcn_permlane32_swap(__float_as_uint(x), __float_as_uint(x), false, false);
    return fmaxf(__uint_as_float(t[0]), __uint_as_float(t[1]));
}
__device__ __forceinline__ float xrow16_sum(float x) {
    auto s = __builtin_amdgcn_permlane16_swap(__float_as_uint(x), __float_as_uint(x), false, false);
    x = __uint_as_float(s[0]) + __uint_as_float(s[1]);
    auto t = __builtin_amdgcn_permlane32_swap(__float_as_uint(x), __float_as_uint(x), false, false);
    return __uint_as_float(t[0]) + __uint_as_float(t[1]);
}
__device__ __forceinline__ int ltid() { int t = threadIdx.x; asm volatile("" : "+v"(t)); return t; }
typedef const Params __attribute__((address_space(4))) * KParamsPtr;
__device__ __forceinline__ const Params& getp() {
    KParamsPtr kp = (KParamsPtr)__builtin_amdgcn_kernarg_segment_ptr();
    asm volatile("" : "+s"(kp));
    return *(const Params*)kp;
}
__device__ __forceinline__ void ph_rope(const Params& p) {
    for (int idx = blockIdx.x * 256 + ltid(); idx < T_ * 32; idx += gridDim.x * 256) {
        int t = idx >> 5, i = idx & 31;
        float ang = (float)p.positions[t] * INVF[i];
        double rev = (double)ang * 0.15915494309189535;
        double fr = rev - rint(rev);
        float r = (float)(fr * 6.283185307179586);
        f32x2 cs; cs.x = __cosf(r); cs.y = __sinf(r);
        ((f32x2*)(p.ws + OFF_ROPE))[idx] = cs;
    }
}

__device__ __forceinline__ void ph_mod(const Params& p, unsigned char* smem) {
    float* sc = (float*)smem;
    float* part = sc + 8 * 1024;
    const int tid = ltid();
    if ((int)blockIdx.x >= 192) return;
    __syncthreads();
    for (int i = tid; i < 8192; i += 256) sc[i] = siluf_(p.c[i]);
    __syncthreads();
    for (int it = blockIdx.x; it < 192; it += gridDim.x) {
        const int l = it / 96, jb = (it % 96) * 64;
        const int c4 = (tid & 15) * 4, kg = tid >> 4;
        f32x4 acc[8];
#pragma unroll
        for (int b = 0; b < 8; ++b) acc[b] = (f32x4){0.f, 0.f, 0.f, 0.f};
        const float* w = p.ada_w + (size_t)l * 1024 * 6144 + jb + c4;
#pragma unroll 4
        for (int k = kg * 64; k < kg * 64 + 64; ++k) {
            const f32x4 wv = *(const f32x4*)(w + (size_t)k * 6144);
#pragma unroll
            for (int b = 0; b < 8; ++b) acc[b] += wv * sc[b * 1024 + k];
        }
        if (kg >= 8) {
#pragma unroll
            for (int b = 0; b < 8; ++b) *(f32x4*)(part + ((kg - 8) * 8 + b) * 64 + c4) = acc[b];
        }
        __syncthreads();
        if (kg < 8) {
#pragma unroll
            for (int b = 0; b < 8; ++b) { f32x4* q = (f32x4*)(part + (kg * 8 + b) * 64 + c4); *q = *q + acc[b]; }
        }
        __syncthreads();
        {
            float* mod = (float*)(p.ws + OFF_MOD);
#pragma unroll
            for (int o = 0; o < 2; ++o) {
                const int idx = tid + 256 * o, b = idx >> 6, jj = idx & 63;
                float r = 0.f;
#pragma unroll
                for (int g = 0; g < 8; ++g) r += part[(g * 8 + b) * 64 + jj];
                mod[(size_t)(l * 8 + b) * 6144 + jb + jj] = r + p.ada_b[l * 6144 + jb + jj];
            }
        }
        __syncthreads();
    }
}

struct TJob {
    const float* src; bf16_t* dst;
    int K, NQ, src_ld, dst_ld, mode, p0, nbatch, pad;
    size_t src_bs, dst_bs;
};
__device__ __forceinline__ int tj_src_col(int mode, int p0, int q) {
    if (mode == 0) return q + p0;
    if (mode == 1) return q < 1092 ? q : (q < 1152 ? -1 : q - 60);
    if (mode == 2) return q;
    return q < 64 ? q : -1;
}
__device__ __forceinline__ int tj_dst_row(int mode, int p0, int q) {
    if (mode == 2) return (q >> 5) * 64 + p0 + (q & 31);
    return q;
}
__device__ __forceinline__ void tconv_load(const TJob& j, int it, int tid, f32x4 (&r)[4]) {
    const int nk = j.K / 64;
    const int per = (j.NQ / 64) * nk;
    const int b = it / per, rr = it % per, qt = rr / nk, kt = rr % nk;
    const float* src = j.src + (size_t)b * j.src_bs;
    const int tx4 = (tid & 15) * 4, ty = tid >> 4;
    const int sc = tj_src_col(j.mode, j.p0, qt * 64 + tx4);
#pragma unroll
    for (int i = 0; i < 4; ++i) {
        if (sc >= 0) r[i] = *(const f32x4*)(src + (size_t)(kt * 64 + ty + 16 * i) * j.src_ld + sc);
        else r[i] = (f32x4){0.f, 0.f, 0.f, 0.f};
    }
}
constexpr int TCS = 68;
__device__ __forceinline__ void tconv_put(int tid, const f32x4 (&r)[4], float* tile) {
    const int tx4 = (tid & 15) * 4, ty = tid >> 4;
#pragma unroll
    for (int i = 0; i < 4; ++i) {
        const int k = ty + 16 * i;
        *(f32x4*)(tile + k * TCS + (tx4 ^ (((k >> 4) & 1) * 16))) = r[i];
    }
}
__device__ __forceinline__ void tconv_emit(const TJob& j, int it, int tid, const float* tile) {
    const int nk = j.K / 64;
    const int per = (j.NQ / 64) * nk;
    const int b = it / per, rr = it % per, qt = rr / nk, kt = rr % nk;
    bf16_t* dst = j.dst + (size_t)b * j.dst_bs;
    const int nn = tid >> 2, kc = (tid & 3) * 16;
    const int dr = tj_dst_row(j.mode, j.p0, qt * 64 + nn);
    const int col = nn ^ (((kc >> 4) & 1) * 16);
    unsigned w[8];
#pragma unroll
    for (int i = 0; i < 8; ++i) w[i] = pack2(tile[(kc + 2 * i) * TCS + col], tile[(kc + 2 * i + 1) * TCS + col]);
    u32x4* d = (u32x4*)(dst + (size_t)dr * j.dst_ld + kt * 64 + kc);
    d[0] = (u32x4){w[0], w[1], w[2], w[3]};
    d[1] = (u32x4){w[4], w[5], w[6], w[7]};
}

__device__ __forceinline__ void ph_wcomp(const Params& p, int l, unsigned char* smem) {
    float (*row)[256] = (float (*)[256])smem;
    const int tid = ltid();
    for (int it = blockIdx.x; it < 512; it += gridDim.x) {
    const int k0 = it * 2;
    __syncthreads();
    {
        const int kk = tid >> 7, jj = tid & 127;
        const float* wi = p.w_in + ((size_t)l * 1024 + k0 + kk) * NIN_ + 512;
        row[kk][jj] = wi[jj] * p.g_kv[l * 256 + jj];
        row[kk][jj + 128] = wi[jj + 128] * p.g_kv[l * 256 + jj + 128];
    }
    __syncthreads();
    const int kk = tid >> 7, n = tid & 127;
    const float* wu = (n < 64) ? (p.w_uk + (size_t)l * 256 * 64 + n) : (p.w_uv + (size_t)l * 256 * 64 + (n - 64));
    float acc = 0.f;
    for (int jx = 0; jx < 256; ++jx) acc += row[kk][jx] * wu[jx * 64];
    bf16_t* WinT = (bf16_t*)(p.ws + OFF_WB) + WB_WIN;
    WinT[(size_t)(C_KA + n) * 1024 + k0 + kk] = f2bf(acc);
    }
}

struct NormArgs {
    const float* xin; const bf16_t* Y; const bf16_t* slots;
    const float* gpost; const float* gt;
    const float* gpre; const float* sc; const float* sh;
    int mode;
};
__device__ __forceinline__ void ph_norm(const Params& p, const NormArgs& a) {
    const int lane = ltid() & 63;
    for (int row = blockIdx.x * 4 + (ltid() >> 6); row < T_; row += gridDim.x * 4) {
    const int b = row >> 11;
    float* xo = p.out + (size_t)row * 1024;
    f32x4 xv[4];
    if (a.mode == 0) {
#pragma unroll
        for (int i = 0; i < 4; ++i) xv[i] = *(const f32x4*)(a.xin + (size_t)row * 1024 + i * 256 + lane * 4);
    } else {
        f32x4 yv[4];
        if (a.mode == 1) {
#pragma unroll
            for (int i = 0; i < 4; ++i) {
                u32x2 u = *(const u32x2*)(a.Y + (size_t)row * 1024 + i * 256 + lane * 4);
                yv[i][0] = __uint_as_float(u.x << 16); yv[i][1] = __uint_as_float(u.x & 0xffff0000u);
                yv[i][2] = __uint_as_float(u.y << 16); yv[i][3] = __uint_as_float(u.y & 0xffff0000u);
            }
        } else {
#pragma unroll
            for (int i = 0; i < 4; ++i) yv[i] = (f32x4){0.f, 0.f, 0.f, 0.f};
#pragma unroll
            for (int k = 0; k < 9; ++k) {
                const bf16_t* sp = a.slots + (k < 8 ? ((size_t)row * 8 + k) : ((size_t)8 * T_ + row)) * 1024;
#pragma unroll
                for (int i = 0; i < 4; ++i) {
                    u32x2 u = *(const u32x2*)(sp + i * 256 + lane * 4);
                    yv[i][0] += __uint_as_float(u.x << 16); yv[i][1] += __uint_as_float(u.x & 0xffff0000u);
                    yv[i][2] += __uint_as_float(u.y << 16); yv[i][3] += __uint_as_float(u.y & 0xffff0000u);
                }
            }
        }
        float ss = 0.f;
#pragma unroll
        for (int i = 0; i < 4; ++i) ss += yv[i][0] * yv[i][0] + yv[i][1] * yv[i][1] + yv[i][2] * yv[i][2] + yv[i][3] * yv[i][3];
        ss = wave_sum(ss);
        const float rs = rsqrtf(ss * (1.0f / 1024.0f) + EPS_);
#pragma unroll
        for (int i = 0; i < 4; ++i) {
            const int col = i * 256 + lane * 4;
            f32x4 xo4 = *(const f32x4*)(xo + col);
            f32x4 g4 = *(const f32x4*)(a.gpost + col);
            f32x4 gt4 = *(const f32x4*)(a.gt + (size_t)b * 6144 + col);
            xv[i] = xo4 + gt4 * (yv[i] * rs * g4);
        }
    }
#pragma unroll
    for (int i = 0; i < 4; ++i) *(f32x4*)(xo + i * 256 + lane * 4) = xv[i];
    if (a.gpre) {
        float ss = 0.f;
#pragma unroll
        for (int i = 0; i < 4; ++i) ss += xv[i][0] * xv[i][0] + xv[i][1] * xv[i][1] + xv[i][2] * xv[i][2] + xv[i][3] * xv[i][3];
        ss = wave_sum(ss);
        const float rs = rsqrtf(ss * (1.0f / 1024.0f) + EPS_);
        bf16_t* H = (bf16_t*)(p.ws + OFF_H) + (size_t)row * 1024;
#pragma unroll
        for (int i = 0; i < 4; ++i) {
            const int col = i * 256 + lane * 4;
            f32x4 g4 = *(const f32x4*)(a.gpre + col);
            f32x4 sc4 = *(const f32x4*)(a.sc + (size_t)b * 6144 + col);
            f32x4 sh4 = *(const f32x4*)(a.sh + (size_t)b * 6144 + col);
            f32x4 h = (xv[i] * rs * g4) * (sc4 + 1.0f) + sh4;
            u32x2 u; u.x = pack2(h[0], h[1]); u.y = pack2(h[2], h[3]);
            *(u32x2*)(H + col) = u;
        }
    }
    }
}

#define LAS __attribute__((address_space(3)))
constexpr int STG = 32768;
constexpr int MISC = 49152;
constexpr int DYN_LDS = 49152 + 1280;
__device__ __forceinline__ int stg_row(int tid, int i, int pieces) { return ((tid >> 6) * pieces + i) * 8 + ((tid & 63) >> 3); }
__device__ __forceinline__ int stg_chunk(int tid, int i) { return (tid & 7) ^ ((4 * i + ((tid & 63) >> 4)) & 7); }
template <int NW>
__device__ __forceinline__ void gemm_kloop2(f32x4 (&acc)[4][NW], const bf16_t* abase, const unsigned (&aoff)[4], const bf16_t* bbase, const unsigned (&boff)[NW], int K, unsigned char* smem, int tid) {
    const int lane = tid & 63, wid = __builtin_amdgcn_readfirstlane(tid >> 6), wr = wid >> 1, wc = wid & 1, fr = lane & 15, fq = lane >> 4;
    LAS unsigned char* lds = (LAS unsigned char*)smem;
    const int nt = K >> 6;
    const int offA = (wr * 64 + fr) * 128, offB = 16384 + (wc * (16 * NW) + fr) * 128;
    const int sw = fr >> 1;
    for (int t = 0; t < nt; ++t) {
        __syncthreads();
#pragma unroll
        for (int i = 0; i < 4; ++i) __builtin_amdgcn_global_load_lds((const unsigned*)(abase + aoff[i] + t * 64), (LAS unsigned*)(lds + (wid * 4 + i) * 1024), 16, 0, 0);
#pragma unroll
        for (int i = 0; i < NW; ++i) __builtin_amdgcn_global_load_lds((const unsigned*)(bbase + boff[i] + t * 64), (LAS unsigned*)(lds + 16384 + (wid * NW + i) * 1024), 16, 0, 0);
        asm volatile("s_waitcnt vmcnt(0)" ::: "memory");
        __syncthreads();
#pragma unroll
        for (int ks = 0; ks < 2; ++ks) {
            const int ch = ((ks * 4 + fq) ^ sw) << 4;
            bf16x8 af[4], bfv[NW];
#pragma unroll
            for (int m = 0; m < 4; ++m) af[m] = *(const LAS bf16x8*)(lds + offA + m * 2048 + ch);
#pragma unroll
            for (int n = 0; n < NW; ++n) bfv[n] = *(const LAS bf16x8*)(lds + offB + n * 2048 + ch);
            __builtin_amdgcn_s_setprio(1);
#pragma unroll
            for (int m = 0; m < 4; ++m)
#pragma unroll
                for (int n = 0; n < NW; ++n) acc[m][n] = __builtin_amdgcn_mfma_f32_16x16x32_bf16(af[m], bfv[n], acc[m][n], 0, 0, 0);
            __builtin_amdgcn_s_setprio(0);
        }
    }
}

constexpr int LDT = 72;
struct __attribute__((aligned(16))) GemmLds { bf16_t A[128 * LDT]; bf16_t B[128 * LDT]; };

template <int NW>
__device__ __forceinline__ void gemm_kloop(f32x4 (&acc)[4][NW], const bf16_t* const (&ap)[4], const bf16_t* const (&bp)[NW], int K,
                                           bf16_t* sA, bf16_t* sB, int tid) {
    const int lane = tid & 63, wid = __builtin_amdgcn_readfirstlane(tid >> 6), wr = wid >> 1, wc = wid & 1, fr = lane & 15, fq = lane >> 4;
    u32x4 ra[4], rb[NW];
#pragma unroll
    for (int i = 0; i < 4; ++i) ra[i] = *(const u32x4*)(ap[i]);
#pragma unroll
    for (int i = 0; i < NW; ++i) rb[i] = *(const u32x4*)(bp[i]);
    const int srow = tid >> 3, scol = (tid & 7) * 8;
    for (int k0 = 0; k0 < K; k0 += 64) {
        __syncthreads();
#pragma unroll
        for (int i = 0; i < 4; ++i) *(u32x4*)(sA + (srow + 32 * i) * LDT + scol) = ra[i];
#pragma unroll
        for (int i = 0; i < NW; ++i) *(u32x4*)(sB + (srow + 32 * i) * LDT + scol) = rb[i];
        __syncthreads();
        if (k0 + 64 < K) {
#pragma unroll
            for (int i = 0; i < 4; ++i) ra[i] = *(const u32x4*)(ap[i] + k0 + 64);
#pragma unroll
            for (int i = 0; i < NW; ++i) rb[i] = *(const u32x4*)(bp[i] + k0 + 64);
        }
#pragma unroll
        for (int ks = 0; ks < 2; ++ks) {
            bf16x8 af[4], bfv[NW];
#pragma unroll
            for (int m = 0; m < 4; ++m) af[m] = *(const bf16x8*)(sA + (wr * 64 + m * 16 + fr) * LDT + ks * 32 + fq * 8);
#pragma unroll
            for (int n = 0; n < NW; ++n) bfv[n] = *(const bf16x8*)(sB + (wc * (16 * NW) + n * 16 + fr) * LDT + ks * 32 + fq * 8);
#pragma unroll
            for (int m = 0; m < 4; ++m)
#pragma unroll
                for (int n = 0; n < NW; ++n) acc[m][n] = __builtin_amdgcn_mfma_f32_16x16x32_bf16(af[m], bfv[n], acc[m][n], 0, 0, 0);
        }
    }
}
template <int NW>
__device__ __forceinline__ void zero_acc(f32x4 (&acc)[4][NW]) {
#pragma unroll
    for (int m = 0; m < 4; ++m)
#pragma unroll
        for (int n = 0; n < NW; ++n) acc[m][n] = (f32x4){0.f, 0.f, 0.f, 0.f};
}

__device__ __forceinline__ void store_rope(const f32x4 (&acc)[4][4], bf16_t* dst, int ld, int dcol, float scale, const f32x2* rope, int rowbase, int fr, int fq) {
#pragma unroll
    for (int m = 0; m < 4; ++m)
#pragma unroll
        for (int j = 0; j < 4; ++j) {
            const int t = rowbase + m * 16 + fq * 4 + j;
#pragma unroll
            for (int nn = 0; nn < 2; ++nn) {
                const f32x2 cs = rope[(size_t)t * 32 + nn * 16 + fr];
                const float x1 = acc[m][nn][j], x2 = acc[m][nn + 2][j];
                dst[(size_t)t * ld + dcol + nn * 16 + fr] = f2bf((x1 * cs.x - x2 * cs.y) * scale);
                dst[(size_t)t * ld + dcol + (nn + 2) * 16 + fr] = f2bf((x2 * cs.x + x1 * cs.y) * scale);
            }
        }
}
__device__ __forceinline__ void store_plain(const f32x4 (&acc)[4][4], bf16_t* dst, int ld, int dcol, float scale, int act, int rowbase, int fr, int fq) {
#pragma unroll
    for (int m = 0; m < 4; ++m)
#pragma unroll
        for (int j = 0; j < 4; ++j) {
            const int t = rowbase + m * 16 + fq * 4 + j;
#pragma unroll
            for (int n = 0; n < 4; ++n) {
                float v = acc[m][n][j] * scale;
                if (act == 1) v = sigmoidf_(v);
                else if (act == 2) v = siluf_(v);
                dst[(size_t)t * ld + dcol + n * 16 + fr] = f2bf(v);
            }
        }
}
__device__ __forceinline__ void store_trans(const f32x4 (&acc)[4][4], bf16_t* dstT, int rows_per_b, int rowoff, int rowbase, int fr, int fq) {
#pragma unroll
    for (int m = 0; m < 4; ++m) {
        const int t = rowbase + m * 16 + fq * 4;
        const int b = t >> 11, s = t & 2047;
#pragma unroll
        for (int n = 0; n < 4; ++n) {
            u32x2 u; u.x = pack2(acc[m][n][0], acc[m][n][1]); u.y = pack2(acc[m][n][2], acc[m][n][3]);
            *(u32x2*)(dstT + ((size_t)b * rows_per_b + rowoff + n * 16 + fr) * 2048 + s) = u;
        }
    }
}

constexpr int LDE = 136;
template <int NW>
__device__ __forceinline__ void lds_put_tile(bf16_t* sT, const f32x4 (&acc)[4][NW], int wr, int wc, int fr, int fq) {
#pragma unroll
    for (int m = 0; m < 4; ++m)
#pragma unroll
        for (int j = 0; j < 4; ++j)
#pragma unroll
            for (int n = 0; n < NW; ++n) sT[(wr * 64 + m * 16 + fq * 4 + j) * LDE + wc * (16 * NW) + n * 16 + fr] = f2bf(acc[m][n][j]);
}
__device__ __forceinline__ void lds_put_tile_t(bf16_t* sT, const f32x4 (&acc)[4][4], int wr, int wc, int fr, int fq) {
#pragma unroll
    for (int m = 0; m < 4; ++m)
#pragma unroll
        for (int n = 0; n < 4; ++n) {
            u32x2 u; u.x = pack2(acc[m][n][0], acc[m][n][1]); u.y = pack2(acc[m][n][2], acc[m][n][3]);
            *(u32x2*)(sT + (wc * 64 + n * 16 + fr) * LDE + wr * 64 + m * 16 + fq * 4) = u;
        }
}
__device__ __forceinline__ void rope_acc(f32x4 (&acc)[4][4], float scale, const f32x2* rope, int rowbase, int fr, int fq) {
    const f32x2* rp = rope + (size_t)(rowbase + fq * 4) * 32 + fr;
#pragma unroll
    for (int m = 0; m < 4; ++m) {
#pragma unroll
        for (int j = 0; j < 4; ++j) {
#pragma unroll
            for (int nn = 0; nn < 2; ++nn) {
                const f32x2 cs = rp[(m * 16 + j) * 32 + nn * 16];
                const float cc = cs.x * scale, sn = cs.y * scale;
                const float x1 = acc[m][nn][j], x2 = acc[m][nn + 2][j];
                acc[m][nn][j] = __fmaf_rn(x1, cc, -(x2 * sn));
                acc[m][nn + 2][j] = __fmaf_rn(x2, cc, x1 * sn);
            }
            if (j & 1) __builtin_amdgcn_sched_barrier(0);
        }
    }
}
__device__ __forceinline__ void scale_act_acc(f32x4 (&acc)[4][4], float scale, int act) {
#pragma unroll
    for (int m = 0; m < 4; ++m)
#pragma unroll
        for (int n = 0; n < 4; ++n)
#pragma unroll
            for (int j = 0; j < 4; ++j) {
                float v = acc[m][n][j] * scale;
                if (act == 1) v = sigmoidf_(v);
                else if (act == 2) v = siluf_(v);
                acc[m][n][j] = v;
            }
}
struct SegDst { bf16_t* rm; int ld; int dcol; bf16_t* tr; int tr_rows; int tr_off; int kind; };
__device__ __forceinline__ SegDst seg_dst(unsigned char* r1, int c0) {
    SegDst d; d.rm = nullptr; d.ld = 0; d.dcol = 0; d.tr = nullptr; d.tr_rows = 0; d.tr_off = 0; d.kind = 0;
    if (c0 < C_CKV) { d.rm = (bf16_t*)(r1 + R1_QA); d.ld = 512; d.dcol = c0 - C_QA; d.kind = 1; }
    else if (c0 < C_IQ) { d.kind = 0; }
    else if (c0 < C_IK) { d.rm = (bf16_t*)(r1 + R1_IQ); d.ld = 256; d.dcol = c0 - C_IQ; d.kind = 1; }
    else if (c0 < C_IW) { d.rm = (bf16_t*)(r1 + R1_IK); d.ld = 64; d.dcol = 0; d.kind = 1; }
    else if (c0 < C_QB) { d.kind = 0; }
    else if (c0 < C_KB) { d.rm = (bf16_t*)(r1 + R1_QB); d.ld = 512; d.dcol = c0 - C_QB; d.kind = 1; }
    else if (c0 < C_VB) { d.rm = (bf16_t*)(r1 + R1_KB); d.ld = 512; d.dcol = c0 - C_KB; d.kind = 1; }
    else if (c0 < C_QC) { d.tr = (bf16_t*)(r1 + R1_VBT); d.tr_rows = 512; d.tr_off = c0 - C_VB; d.kind = 2; }
    else if (c0 < C_KC) { d.rm = (bf16_t*)(r1 + R1_QC); d.ld = 512; d.dcol = c0 - C_QC; d.kind = 1; }
    else if (c0 < C_VC) { d.rm = (bf16_t*)(r1 + R1_KC); d.ld = 512; d.dcol = c0 - C_KC; d.tr = (bf16_t*)(r1 + R1_KCT); d.tr_rows = 512; d.tr_off = c0 - C_KC; d.kind = 3; }
    else if (c0 < C_GC) { d.tr = (bf16_t*)(r1 + R1_VCT); d.tr_rows = 1024; d.tr_off = c0 - C_VC; d.kind = 2; }
    else if (c0 < C_GATES) { d.rm = (bf16_t*)(r1 + R1_GC); d.ld = 1024; d.dcol = c0 - C_GC; d.kind = 1; }
    else if (c0 < C_KA) { d.tr = (bf16_t*)(r1 + R1_GATES); d.tr_rows = 3072; d.tr_off = c0 - C_GATES; d.kind = 2; }
    else if (c0 < C_VA) { d.rm = (bf16_t*)(r1 + R1_KA); d.ld = 64; d.dcol = 0; d.kind = 1; }
    else { d.tr = (bf16_t*)(r1 + R1_VAT); d.tr_rows = 64; d.tr_off = 0; d.kind = 2; }
    return d;
}

__device__ __forceinline__ void ph_gemm_z(const Params& p, unsigned char* smem) {
    bf16_t* sT = (bf16_t*)smem;
    const int tid = ltid(), lane = tid & 63, wid = __builtin_amdgcn_readfirstlane(tid >> 6), wr = wid >> 1, wc = wid & 1, fr = lane & 15, fq = lane >> 4;
    const bf16_t* H = (const bf16_t*)(p.ws + OFF_H);
    const bf16_t* WinT = (const bf16_t*)(p.ws + OFF_WB) + WB_WIN;
    const int xcd = blockIdx.x & 7, jb = blockIdx.x >> 3, nper = gridDim.x >> 3;
    for (int q = jb; q < 1120; q += nper) {
        const int half = q / 560, rem = q % 560, nt = rem >> 3, mtl = rem & 7;
        const int mt = 16 * xcd + 8 * half + mtl;
        const int m0 = mt * 128, n0 = nt * 128;
        unsigned ao[4], bo[4];
#pragma unroll
        for (int i = 0; i < 4; ++i) {
            const int R = stg_row(tid, i, 4), g = stg_chunk(tid, i);
            ao[i] = (unsigned)(m0 + R) * 1024u + g * 8;
            bo[i] = (unsigned)(n0 + R) * 1024u + g * 8;
        }
        f32x4 acc[4][4];
        zero_acc<4>(acc);
        gemm_kloop2<4>(acc, H, ao, WinT, bo, 1024, smem, tid);
        int te = tid; asm volatile("" : "+v"(te));
        const int fre = te & 15, fqe = (te & 63) >> 4;
        const Params& pe = getp();
        unsigned char* r1 = pe.ws + OFF_R1;
        const f32x2* rope = (const f32x2*)(pe.ws + OFF_ROPE);
        const int c0 = n0 + wc * 64;
        const int rowbase = m0 + wr * 64;
        if (c0 < C_CKV) rope_acc(acc, 0.125f, rope, rowbase, fre, fqe);
        else if (c0 < C_IQ) {
            float* ss = (float*)(pe.ws + OFF_CKVSS);
            const int blk = (c0 - C_CKV) >> 6;
#pragma unroll
            for (int m = 0; m < 4; ++m)
#pragma unroll
                for (int j = 0; j < 4; ++j) {
                    float sq = 0.f;
#pragma unroll
                    for (int n = 0; n < 4; ++n) sq += acc[m][n][j] * acc[m][n][j];
                    sq += __shfl_xor(sq, 1); sq += __shfl_xor(sq, 2); sq += __shfl_xor(sq, 4); sq += __shfl_xor(sq, 8);
                    if (fre == 0) ss[(size_t)(rowbase + m * 16 + fqe * 4 + j) * 4 + blk] = sq;
                }
        }
        else if (c0 < C_IK) rope_acc(acc, 1.0f, rope, rowbase, fre, fqe);
        else if (c0 < C_IW) rope_acc(acc, 1.0f, rope, rowbase, fre, fqe);
        else if (c0 < C_QB) {
            float* iw = (float*)(pe.ws + OFF_IW);
            if (fre < 4) {
#pragma unroll
                for (int m = 0; m < 4; ++m)
#pragma unroll
                    for (int j = 0; j < 4; ++j) iw[(size_t)(rowbase + m * 16 + fqe * 4 + j) * 4 + fre] = acc[m][0][j] * 0.0625f;
            }
        }
        else if (c0 < C_KB) scale_act_acc(acc, 0.125f, 0);
        else if (c0 < C_QC) { }
        else if (c0 < C_KC) rope_acc(acc, 1.0f, rope, rowbase, fre, fqe);
        else if (c0 < C_VC) rope_acc(acc, 0.125f, rope, rowbase, fre, fqe);
        else if (c0 < C_GC) { }
        else if (c0 < C_GATES) scale_act_acc(acc, 1.0f, 2);
        else if (c0 < C_KA) scale_act_acc(acc, 1.0f, 1);
        else if (c0 < C_VA) rope_acc(acc, 1.0f, rope, rowbase, fre, fqe);
        const SegDst dw = seg_dst(r1, c0);
        const SegDst d0 = seg_dst(r1, n0), d1 = seg_dst(r1, n0 + 64);
        const int anyrm = (d0.kind | d1.kind) & 1, anytr = (d0.kind | d1.kind) & 2;
        __syncthreads();
        if (anyrm) {
            if (dw.kind & 1) lds_put_tile<4>(sT, acc, wr, wc, fre, fqe);
            __syncthreads();
#pragma unroll
            for (int hh = 0; hh < 2; ++hh) {
                const SegDst& d = hh ? d1 : d0;
                if (d.kind & 1) {
#pragma unroll
                    for (int i = 0; i < 4; ++i) {
                        const int c = te + 256 * i, row = c >> 3, ch = c & 7;
                        *(u32x4*)(d.rm + (size_t)(m0 + row) * d.ld + d.dcol + ch * 8) = *(const u32x4*)(sT + row * LDE + hh * 64 + ch * 8);
                    }
                }
            }
        }
        if (anytr) {
            __syncthreads();
            if (dw.kind & 2) lds_put_tile_t(sT, acc, wr, wc, fre, fqe);
            __syncthreads();
            const int b = m0 >> 11, s0 = m0 & 2047;
#pragma unroll
            for (int hh = 0; hh < 2; ++hh) {
                const SegDst& d = hh ? d1 : d0;
                if (d.kind & 2) {
#pragma unroll
                    for (int i = 0; i < 4; ++i) {
                        const int c = te + 256 * i, erow = c >> 4, ch = c & 15;
                        *(u32x4*)(d.tr + ((size_t)b * d.tr_rows + d.tr_off + erow) * 2048 + s0 + ch * 8) = *(const u32x4*)(sT + (hh * 64 + erow) * LDE + ch * 8);
                    }
                }
            }
        }
    }
}

struct __attribute__((aligned(16))) AttnLds { bf16_t K[64 * LDT]; bf16_t Vt[64 * LDT]; float rs[64]; };

__device__ __forceinline__ void tile64_load(u32x4 (&r)[2], const bf16_t* src, size_t src_ld, int tid) {
#pragma unroll
    for (int i = 0; i < 2; ++i) {
        const int c = tid + 256 * i, row = c >> 3, col8 = (c & 7) * 8;
        r[i] = *(const u32x4*)(src + (size_t)row * src_ld + col8);
    }
}
__device__ __forceinline__ void tile64_put(bf16_t* dst, const u32x4 (&r)[2], int tid) {
#pragma unroll
    for (int i = 0; i < 2; ++i) {
        const int c = tid + 256 * i, row = c >> 3, col8 = (c & 7) * 8;
        *(u32x4*)(dst + row * LDT + col8) = r[i];
    }
}
__device__ __forceinline__ void stage_tile64(bf16_t* dst, const bf16_t* src, size_t src_ld, int tid) {
#pragma unroll
    for (int i = 0; i < 2; ++i) {
        const int c = tid + 256 * i, row = c >> 3, col8 = (c & 7) * 8;
        *(u32x4*)(dst + row * LDT + col8) = *(const u32x4*)(src + (size_t)row * src_ld + col8);
    }
}

__device__ __forceinline__ void sb_tile(const AttnLds& sm, const bf16x8 (&qf)[2], f32x4 (&O)[4], float& R, bool diag, int tl, int fr, int fq) {
    f32x4 st[4];
#pragma unroll
    for (int mk = 0; mk < 4; ++mk) {
        st[mk] = (f32x4){0.f, 0.f, 0.f, 0.f};
#pragma unroll
        for (int ks = 0; ks < 2; ++ks) {
            bf16x8 kf = *(const bf16x8*)(sm.K + (mk * 16 + fr) * LDT + ks * 32 + fq * 8);
            st[mk] = __builtin_amdgcn_mfma_f32_16x16x32_bf16(kf, qf[ks], st[mk], 0, 0, 0);
        }
    }
    float Bv[4][4], Om[4][4], P[4];
#pragma unroll
    for (int mk = 0; mk < 4; ++mk) {
        P[mk] = 1.f;
#pragma unroll
        for (int r = 0; r < 4; ++r) {
            const float z = st[mk][r];
            const bool valid = !diag || (16 * mk + 4 * fq + r < tl);
            const float e = __expf(-fabsf(z));
            const float sg = __builtin_amdgcn_rcpf(1.0f + e);
            const float es = e * sg;
            const float beta = (z >= 0.f) ? sg : es, om = (z >= 0.f) ? es : sg;
            Bv[mk][r] = valid ? beta : 0.f;
            Om[mk][r] = valid ? om : 1.f;
            P[mk] *= Om[mk][r];
        }
    }
    float tot[4], above[4];
#pragma unroll
    for (int mk = 0; mk < 4; ++mk) {
        auto sw = __builtin_amdgcn_permlane16_swap(__float_as_uint(P[mk]), __float_as_uint(P[mk]), false, false);
        const float po = __uint_as_float(sw[1]);
        const float pair = __uint_as_float(sw[0]) * po;
        auto tw = __builtin_amdgcn_permlane32_swap(__float_as_uint(pair), __float_as_uint(pair), false, false);
        const float hi = __uint_as_float(tw[1]);
        tot[mk] = __uint_as_float(tw[0]) * hi;
        above[mk] = ((fq & 1) ? 1.f : po) * ((fq < 2) ? hi : 1.f);
    }
    float higher[4];
    higher[3] = 1.f; higher[2] = tot[3]; higher[1] = tot[3] * tot[2]; higher[0] = tot[3] * tot[2] * tot[1];
    float A[4][4];
#pragma unroll
    for (int mk = 0; mk < 4; ++mk) {
        float suf = above[mk] * higher[mk] * R;
#pragma unroll
        for (int r = 3; r >= 0; --r) {
            A[mk][r] = Bv[mk][r] * suf;
            suf *= Om[mk][r];
        }
    }
    R *= (tot[0] * tot[1]) * (tot[2] * tot[3]);
#pragma unroll
    for (int ks = 0; ks < 2; ++ks) {
        u32x4 uu = (u32x4){pack2(A[2 * ks][0], A[2 * ks][1]), pack2(A[2 * ks][2], A[2 * ks][3]),
                           pack2(A[2 * ks + 1][0], A[2 * ks + 1][1]), pack2(A[2 * ks + 1][2], A[2 * ks + 1][3])};
        bf16x8 pf = *(bf16x8*)&uu;
#pragma unroll
        for (int me = 0; me < 4; ++me) {
            const bf16_t* vp = sm.Vt + (me * 16 + fr) * LDT + ks * 32 + 4 * fq;
            u32x2 lo = *(const u32x2*)vp, hi = *(const u32x2*)(vp + 16);
            u32x4 vv = (u32x4){lo.x, lo.y, hi.x, hi.y};
            O[me] = __builtin_amdgcn_mfma_f32_16x16x32_bf16(*(bf16x8*)&vv, pf, O[me], 0, 0, 0);
        }
    }
}
__device__ __forceinline__ void mixb_item(const Params& p, int item, unsigned char* smem) {
    AttnLds& sm = *(AttnLds*)smem;
    const int tid = ltid(), lane = tid & 63, w = __builtin_amdgcn_readfirstlane(tid >> 6), fr = lane & 15, fq = lane >> 4;
    unsigned char* r1 = p.ws + OFF_R1;
    bf16_t* QB = (bf16_t*)(r1 + R1_QB);
    const bf16_t* KB = (const bf16_t*)(r1 + R1_KB);
    const bf16_t* VBT = (const bf16_t*)(r1 + R1_VBT);
    {
        const int qt2 = 15 - (item >> 6), bh = item & 63, b = bh >> 3, h = bh & 7;
        const int tl = 16 * w + fr;
        const int tq0 = b * 2048 + qt2 * 128 + tl, tq1 = tq0 + 64;
        bf16x8 qf0[2], qf1[2];
#pragma unroll
        for (int ks = 0; ks < 2; ++ks) {
            qf0[ks] = *(const bf16x8*)(QB + (size_t)tq0 * 512 + h * 64 + ks * 32 + fq * 8);
            qf1[ks] = *(const bf16x8*)(QB + (size_t)tq1 * 512 + h * 64 + ks * 32 + fq * 8);
        }
        f32x4 O0[4], O1[4];
#pragma unroll
        for (int me = 0; me < 4; ++me) { O0[me] = (f32x4){0.f, 0.f, 0.f, 0.f}; O1[me] = (f32x4){0.f, 0.f, 0.f, 0.f}; }
        float R0 = 1.f, R1 = 1.f;
        const int ktop = 2 * qt2 + 1;
        for (int kt = ktop; kt >= 0; --kt) {
            __syncthreads();
            stage_tile64(sm.K, KB + (size_t)(b * 2048 + kt * 64) * 512 + h * 64, 512, tid);
            stage_tile64(sm.Vt, VBT + ((size_t)(b * 8 + h) * 64) * 2048 + kt * 64, 2048, tid);
            __syncthreads();
            sb_tile(sm, qf1, O1, R1, kt == ktop, tl, fr, fq);
            if (kt < ktop) sb_tile(sm, qf0, O0, R0, kt == ktop - 1, tl, fr, fq);
        }
        const int ts = ltid();
        const int fqs = (ts & 63) >> 4;
        const int tqs0 = b * 2048 + qt2 * 128 + 16 * (ts >> 6) + (ts & 15), tqs1 = tqs0 + 64;
#pragma unroll
        for (int me = 0; me < 4; ++me) {
            u32x2 u; u.x = pack2(O0[me][0], O0[me][1]); u.y = pack2(O0[me][2], O0[me][3]);
            *(u32x2*)(QB + (size_t)tqs0 * 512 + h * 64 + me * 16 + 4 * fqs) = u;
            u32x2 v; v.x = pack2(O1[me][0], O1[me][1]); v.y = pack2(O1[me][2], O1[me][3]);
            *(u32x2*)(QB + (size_t)tqs1 * 512 + h * 64 + me * 16 + 4 * fqs) = v;
        }
    }
}

struct __attribute__((aligned(16))) RetLds { bf16_t K[64 * LDT]; bf16_t KT[64 * LDT]; bf16_t VT[128 * LDT]; bf16_t ST[128 * LDT]; };
struct __attribute__((aligned(16))) RetLds3 { bf16_t K[64 * LDT]; bf16_t VT[128 * LDT]; bf16_t ST[128 * LDT]; };

__device__ __forceinline__ void mixc1_item(const Params& p, int item, unsigned char* smem) {
    RetLds& sm = *(RetLds*)smem;
    const int tid = ltid(), lane = tid & 63, w = __builtin_amdgcn_readfirstlane(tid >> 6), fr = lane & 15, fq = lane >> 4;
    unsigned char* r1 = p.ws + OFF_R1;
    const bf16_t* KCT = (const bf16_t*)(r1 + R1_KCT);
    const bf16_t* VCT = (const bf16_t*)(r1 + R1_VCT);
    bf16_t* KVT = (bf16_t*)(p.ws + OFF_H);
    const int bh = item >> 5, n = item & 31, h = bh & 7;
    const float lg = LOGG[h];
    u32x4 rkt[2], rvt[4];
#pragma unroll
    for (int i = 0; i < 2; ++i) {
        const int c = tid + 256 * i, row = c >> 3, col8 = (c & 7) * 8;
        rkt[i] = *(const u32x4*)(KCT + ((size_t)bh * 64 + row) * 2048 + n * 64 + col8);
    }
#pragma unroll
    for (int i = 0; i < 4; ++i) {
        const int c = tid + 256 * i, row = c >> 3, col8 = (c & 7) * 8;
        rvt[i] = *(const u32x4*)(VCT + ((size_t)bh * 128 + row) * 2048 + n * 64 + col8);
    }
    __syncthreads();
#pragma unroll
    for (int i = 0; i < 2; ++i) {
        const int c = tid + 256 * i, row = c >> 3, col8 = (c & 7) * 8;
        unsigned uu[4] = {rkt[i].x, rkt[i].y, rkt[i].z, rkt[i].w};
#pragma unroll
        for (int q = 0; q < 4; ++q) {
            const float z0 = __expf(lg * (float)(63 - (col8 + 2 * q))), z1 = __expf(lg * (float)(63 - (col8 + 2 * q + 1)));
            uu[q] = pack2(__uint_as_float(uu[q] << 16) * z0, __uint_as_float(uu[q] & 0xffff0000u) * z1);
        }
        *(u32x4*)(sm.KT + row * LDT + col8) = (u32x4){uu[0], uu[1], uu[2], uu[3]};
    }
#pragma unroll
    for (int i = 0; i < 4; ++i) {
        const int c = tid + 256 * i, row = c >> 3, col8 = (c & 7) * 8;
        *(u32x4*)(sm.VT + row * LDT + col8) = rvt[i];
    }
    __syncthreads();
    f32x4 sacc[4][2];
#pragma unroll
    for (int md = 0; md < 4; ++md)
#pragma unroll
        for (int ne = 0; ne < 2; ++ne) sacc[md][ne] = (f32x4){0.f, 0.f, 0.f, 0.f};
#pragma unroll
    for (int ks = 0; ks < 2; ++ks) {
        bf16x8 vf[2];
#pragma unroll
        for (int ne = 0; ne < 2; ++ne) vf[ne] = *(const bf16x8*)(sm.VT + (32 * w + ne * 16 + fr) * LDT + ks * 32 + fq * 8);
#pragma unroll
        for (int md = 0; md < 4; ++md) {
            bf16x8 kf = *(const bf16x8*)(sm.KT + (md * 16 + fr) * LDT + ks * 32 + fq * 8);
#pragma unroll
            for (int ne = 0; ne < 2; ++ne) sacc[md][ne] = __builtin_amdgcn_mfma_f32_16x16x32_bf16(kf, vf[ne], sacc[md][ne], 0, 0, 0);
        }
    }
    bf16_t* dst = KVT + (size_t)item * 128 * 64;
#pragma unroll
    for (int md = 0; md < 4; ++md)
#pragma unroll
        for (int ne = 0; ne < 2; ++ne) {
            u32x2 u; u.x = pack2(sacc[md][ne][0], sacc[md][ne][1]); u.y = pack2(sacc[md][ne][2], sacc[md][ne][3]);
            *(u32x2*)(dst + (32 * w + ne * 16 + fr) * 64 + md * 16 + 4 * fq) = u;
        }
}
__device__ __forceinline__ void ph_mixc2(const Params& p) {
    bf16_t* KVT = (bf16_t*)(p.ws + OFF_H);
    for (int idx = blockIdx.x * 256 + ltid(); idx < 64 * 128 * 16; idx += gridDim.x * 256) {
        const int bh = idx >> 11, ed = idx & 2047;
        const float g64 = __expf(LOGG[bh & 7] * 64.0f);
        bf16_t* pp = KVT + (size_t)bh * 32 * 8192 + (size_t)ed * 4;
        float s0 = 0.f, s1 = 0.f, s2 = 0.f, s3 = 0.f;
#pragma unroll 4
        for (int n = 0; n < 32; ++n) {
            u32x2 kv = *(const u32x2*)(pp + (size_t)n * 8192);
            u32x2 o; o.x = pack2(s0, s1); o.y = pack2(s2, s3);
            *(u32x2*)(pp + (size_t)n * 8192) = o;
            s0 = s0 * g64 + __uint_as_float(kv.x << 16); s1 = s1 * g64 + __uint_as_float(kv.x & 0xffff0000u);
            s2 = s2 * g64 + __uint_as_float(kv.y << 16); s3 = s3 * g64 + __uint_as_float(kv.y & 0xffff0000u);
        }
    }
}
__device__ __forceinline__ void mixc3_item(const Params& p, int l, int item, unsigned char* smem) {
    RetLds3& sm = *(RetLds3*)smem;
    const int tid = ltid(), lane = tid & 63, w = __builtin_amdgcn_readfirstlane(tid >> 6), fr = lane & 15, fq = lane >> 4;
    unsigned char* r1 = p.ws + OFF_R1;
    const bf16_t* QC = (const bf16_t*)(r1 + R1_QC);
    const bf16_t* KC = (const bf16_t*)(r1 + R1_KC);
    const bf16_t* VCT = (const bf16_t*)(r1 + R1_VCT);
    const bf16_t* KVT = (const bf16_t*)(p.ws + OFF_H);
    bf16_t* GC = (bf16_t*)(r1 + R1_GC);
    {
        const int bh = item >> 5, n = item & 31, b = bh >> 3, h = bh & 7;
        const float lg = LOGG[h];
        const int al = 16 * w + fr;
        const float xi = __expf(lg * (float)(al + 1));
        {
            const int tok0 = b * 2048 + n * 64;
            u32x4 rk[2], rvt[4], rst[4];
            bf16x8 qf[2];
#pragma unroll
            for (int ks = 0; ks < 2; ++ks) qf[ks] = *(const bf16x8*)(QC + (size_t)(tok0 + 16 * w + fr) * 512 + h * 64 + ks * 32 + fq * 8);
            tile64_load(rk, KC + (size_t)tok0 * 512 + h * 64, 512, tid);
#pragma unroll
            for (int i = 0; i < 4; ++i) {
                const int c = tid + 256 * i, row = c >> 3, col8 = (c & 7) * 8;
                rvt[i] = *(const u32x4*)(VCT + ((size_t)bh * 128 + row) * 2048 + n * 64 + col8);
                rst[i] = *(const u32x4*)(KVT + (size_t)item * 8192 + row * 64 + col8);
            }
            __syncthreads();
            tile64_put(sm.K, rk, tid);
#pragma unroll
            for (int i = 0; i < 4; ++i) {
                const int c = tid + 256 * i, row = c >> 3, col8 = (c & 7) * 8;
                *(u32x4*)(sm.VT + row * LDT + col8) = rvt[i];
                *(u32x4*)(sm.ST + row * LDT + col8) = rst[i];
            }
            __syncthreads();
            f32x4 st[4];
#pragma unroll
            for (int mc = 0; mc < 4; ++mc) {
                st[mc] = (f32x4){0.f, 0.f, 0.f, 0.f};
#pragma unroll
                for (int ks = 0; ks < 2; ++ks) {
                    bf16x8 kf = *(const bf16x8*)(sm.K + (mc * 16 + fr) * LDT + ks * 32 + fq * 8);
                    st[mc] = __builtin_amdgcn_mfma_f32_16x16x32_bf16(kf, qf[ks], st[mc], 0, 0, 0);
                }
#pragma unroll
                for (int r = 0; r < 4; ++r) {
                    const int cc = 16 * mc + 4 * fq + r;
                    st[mc][r] *= __expf(lg * fabsf((float)(al - cc)));
                }
            }
            f32x4 o[8];
#pragma unroll
            for (int me = 0; me < 8; ++me) {
                o[me] = (f32x4){0.f, 0.f, 0.f, 0.f};
#pragma unroll
                for (int ks = 0; ks < 2; ++ks) {
                    bf16x8 sf = *(const bf16x8*)(sm.ST + (me * 16 + fr) * LDT + ks * 32 + fq * 8);
                    o[me] = __builtin_amdgcn_mfma_f32_16x16x32_bf16(sf, qf[ks], o[me], 0, 0, 0);
                }
                o[me] *= xi;
            }
#pragma unroll
            for (int ks = 0; ks < 2; ++ks) {
                bf16x8 pf;
                {
                    u32x4 uu = (u32x4){pack2(st[2 * ks][0], st[2 * ks][1]), pack2(st[2 * ks][2], st[2 * ks][3]),
                                          pack2(st[2 * ks + 1][0], st[2 * ks + 1][1]), pack2(st[2 * ks + 1][2], st[2 * ks + 1][3])};
                    pf = *(bf16x8*)&uu;
                }
#pragma unroll
                for (int me = 0; me < 8; ++me) {
                    const bf16_t* vp = sm.VT + (me * 16 + fr) * LDT + ks * 32 + 4 * fq;
                    u32x2 lo = *(const u32x2*)vp, hi = *(const u32x2*)(vp + 16);
                    u32x4 vv = (u32x4){lo.x, lo.y, hi.x, hi.y};
                    o[me] = __builtin_amdgcn_mfma_f32_16x16x32_bf16(*(bf16x8*)&vv, pf, o[me], 0, 0, 0);
                }
            }
            {
                float s1 = 0.f;
#pragma unroll
                for (int me = 0; me < 8; ++me) s1 += (o[me][0] + o[me][1]) + (o[me][2] + o[me][3]);
                s1 = xrow16_sum(s1);
                const float mu = s1 * (1.0f / 128.0f);
                float s2 = 0.f;
#pragma unroll
                for (int me = 0; me < 8; ++me)
#pragma unroll
                    for (int r = 0; r < 4; ++r) { const float d = o[me][r] - mu; s2 += d * d; }
                s2 = xrow16_sum(s2);
                const float rstd = rsqrtf(s2 * (1.0f / 128.0f) + EPS_);
                bf16_t* gp = GC + (size_t)(tok0 + al) * 1024 + h * 128;
                const float* gr = p.g_ret + (size_t)l * 1024 + h * 128;
#pragma unroll
                for (int me = 0; me < 8; ++me) {
                    const int e0 = me * 16 + 4 * fq;
                    u32x2 gu = *(const u32x2*)(gp + e0);
                    f32x4 g4 = *(const f32x4*)(gr + e0);
                    const float y0 = (o[me][0] - mu) * rstd * g4[0] * __uint_as_float(gu.x << 16);
                    const float y1 = (o[me][1] - mu) * rstd * g4[1] * __uint_as_float(gu.x & 0xffff0000u);
                    const float y2 = (o[me][2] - mu) * rstd * g4[2] * __uint_as_float(gu.y << 16);
                    const float y3 = (o[me][3] - mu) * rstd * g4[3] * __uint_as_float(gu.y & 0xffff0000u);
                    u32x2 ou; ou.x = pack2(y0, y1); ou.y = pack2(y2, y3);
                    *(u32x2*)(gp + e0) = ou;
                }
            }
        }
    }
}

__device__ __forceinline__ void mixa1_item(const Params& p, int item, unsigned char* smem) {
    float* tau_s = (float*)smem;
    int* stau_s = (int*)(smem + 64);
    const int tid = ltid(), lane = tid & 63, w = __builtin_amdgcn_readfirstlane(tid >> 6), fr = lane & 15, fq = lane >> 4;
    unsigned char* r1 = p.ws + OFF_R1;
    const bf16_t* IQ = (const bf16_t*)(r1 + R1_IQ);
    const bf16_t* IK = (const bf16_t*)(r1 + R1_IK);
    const float* IW = (const float*)(p.ws + OFF_IW);
    float* SC = (float*)(p.ws + OFF_R3);
    unsigned long long* MASKB = (unsigned long long*)(p.ws + OFF_MASKB);
    {
        const int c = 31 - (item >> 5), b = (item >> 2) & 7, qq = item & 3;
        __syncthreads();
        const int nj = c + 1, n = 64 * nj;
        const int tq = b * 2048 + c * 64 + 16 * qq + fr;
        float* scrow = SC + (size_t)b * SC_PER_BATCH + (size_t)2048 * c * (c + 1) + (size_t)(16 * qq + fr) * n;
        bf16x8 iqf[4][2];
        float iw[4];
#pragma unroll
        for (int hh = 0; hh < 4; ++hh) {
            iw[hh] = IW[(size_t)tq * 4 + hh];
#pragma unroll
            for (int ks = 0; ks < 2; ++ks) iqf[hh][ks] = *(const bf16x8*)(IQ + (size_t)tq * 256 + hh * 64 + ks * 32 + fq * 8);
        }
        for (int kt = w; kt < nj; kt += 4) {
            bf16x8 ikf[4][2];
#pragma unroll
            for (int mk = 0; mk < 4; ++mk)
#pragma unroll
                for (int ks = 0; ks < 2; ++ks) ikf[mk][ks] = *(const bf16x8*)(IK + (size_t)(b * 2048 + kt * 64 + mk * 16 + fr) * 64 + ks * 32 + fq * 8);
            f32x4 sc[4];
#pragma unroll
            for (int mk = 0; mk < 4; ++mk) sc[mk] = (f32x4){0.f, 0.f, 0.f, 0.f};
#pragma unroll
            for (int hh = 0; hh < 4; ++hh) {
#pragma unroll
                for (int mk = 0; mk < 4; ++mk) {
                    f32x4 a = (f32x4){0.f, 0.f, 0.f, 0.f};
#pragma unroll
                    for (int ks = 0; ks < 2; ++ks) a = __builtin_amdgcn_mfma_f32_16x16x32_bf16(ikf[mk][ks], iqf[hh][ks], a, 0, 0, 0);
#pragma unroll
                    for (int r = 0; r < 4; ++r) sc[mk][r] = __fmaf_rn(iw[hh], fmaxf(a[r], 0.f), sc[mk][r]);
                }
            }
#pragma unroll
            for (int mk = 0; mk < 4; ++mk) *(f32x4*)(scrow + kt * 64 + 16 * mk + 4 * fq) = sc[mk];
        }
        __syncthreads();
        for (int i = 0; i < 4; ++i) {
            const int r16 = 4 * w + i;
            float tau = -__builtin_inff();
            int stau = 1 << 30;
            if (nj > 4) {
                const float* rowp = SC + (size_t)b * SC_PER_BATCH + (size_t)2048 * c * (c + 1) + (size_t)(16 * qq + r16) * n;
                unsigned key[32];
#pragma unroll
                for (int j = 0; j < 32; ++j) key[j] = __float_as_uint(rowp[j * 64 + lane]);
#pragma unroll
                for (int j = 0; j < 32; ++j) {
                    const unsigned u = key[j];
                    const unsigned k = u ^ ((unsigned)((int)u >> 31) | 0x80000000u);
                    key[j] = (j < nj) ? k : 0u;
                }
                unsigned X = 0u;
                for (int bit = 31; bit >= 0; --bit) {
                    const unsigned cand = X | (1u << bit);
                    int cnt = 0;
                    int c0 = 0, c1 = 0;
#pragma unroll
                    for (int j = 0; j < 32; j += 4) {
                        if (j < nj) {
                            c0 = cnt_ge(c0, key[j], cand); c1 = cnt_ge(c1, key[j + 1], cand);
                            c0 = cnt_ge(c0, key[j + 2], cand); c1 = cnt_ge(c1, key[j + 3], cand);
                        }
                    }
                    cnt = wave_total6(c0 + c1);
                    if (cnt >= 256) X = cand;
                    if (cnt == 256) break;
                }
                int cgt = 0;
                {
                    const unsigned candp = X + 1u;
                    int c0 = 0, c1 = 0;
#pragma unroll
                    for (int j = 0; j < 32; j += 2) { c0 = cnt_ge(c0, key[j], candp); c1 = cnt_ge(c1, key[j + 1], candp); }
                    cgt = wave_total6(c0 + c1);
                }
                const int need = 256 - cgt;
                unsigned eqbits = 0u;
#pragma unroll
                for (int j = 0; j < 32; ++j) {
                    const unsigned ne = min(key[j] ^ X, 1u);
                    eqbits |= (1u - ne) << j;
                }
                const int teq = wave_sum_i(__popc(eqbits));
                if (teq == need) {
                    stau = 1 << 30;
                } else {
                    int lo = 0, hi = n - 1;
                    while (lo < hi) {
                        const int mid = (lo + hi) >> 1;
                        const int jmax = (mid - lane) >> 6;
                        const unsigned msk = jmax < 0 ? 0u : (jmax >= 31 ? 0xffffffffu : ((2u << jmax) - 1u));
                        const int cc = wave_sum_i(__popc(eqbits & msk));
                        if (cc >= need) hi = mid; else lo = mid + 1;
                    }
                    stau = lo;
                }
                const unsigned ux = (X & 0x80000000u) ? (X & 0x7fffffffu) : ~X;
                tau = __uint_as_float(ux);
            }
            if (lane == 0) { tau_s[r16] = tau; stau_s[r16] = stau; }
        }
        __syncthreads();
        {
            const float tau = tau_s[fr];
            const int stau = stau_s[fr];
            for (int kt = w; kt < nj; kt += 4) {
                unsigned lo = 0u, hi = 0u;
#pragma unroll
                for (int mk = 0; mk < 4; ++mk) {
                    const f32x4 v = *(const f32x4*)(scrow + kt * 64 + 16 * mk + 4 * fq);
#pragma unroll
                    for (int r = 0; r < 4; ++r) {
                        const int kl = 16 * mk + 4 * fq + r;
                        const bool sel = (v[r] > tau) || (v[r] == tau && (kt * 64 + kl) <= stau);
                        if (sel) { if (mk < 2) lo |= 1u << kl; else hi |= 1u << (kl - 32); }
                    }
                }
                lo |= __shfl_xor(lo, 16); lo |= __shfl_xor(lo, 32);
                hi |= __shfl_xor(hi, 16); hi |= __shfl_xor(hi, 32);
                if (fq == 0) MASKB[(size_t)tq * 32 + kt] = ((unsigned long long)hi << 32) | lo;
            }
        }
        __syncthreads();
    }
}

__device__ __forceinline__ void a2_tile(const AttnLds& sm, const bf16x8 (&qf)[2], f32x4 (&O)[4], float& mrun, float& lrun, unsigned long long W, int fr, int fq) {
    f32x4 st[4];
    float mx = -1e30f;
    f32x4 rsv[4];
#pragma unroll
    for (int mk = 0; mk < 4; ++mk) {
        st[mk] = (f32x4){0.f, 0.f, 0.f, 0.f};
#pragma unroll
        for (int ks = 0; ks < 2; ++ks) {
            bf16x8 kf = *(const bf16x8*)(sm.K + (mk * 16 + fr) * LDT + ks * 32 + fq * 8);
            st[mk] = __builtin_amdgcn_mfma_f32_16x16x32_bf16(kf, qf[ks], st[mk], 0, 0, 0);
        }
        rsv[mk] = *(const f32x4*)(sm.rs + 16 * mk + 4 * fq);
        const unsigned nib = (unsigned)(W >> (16 * mk + 4 * fq)) & 0xfu;
#pragma unroll
        for (int r = 0; r < 4; ++r) {
            st[mk][r] *= rsv[mk][r];
            if ((nib >> r) & 1u) mx = fmaxf(mx, st[mk][r]);
        }
    }
    mx = xrow16_max(mx);
    const float mnew = fmaxf(mrun, mx);
    const float alpha = __expf(mrun - mnew);
    float ps = 0.f;
    float P[4][4];
#pragma unroll
    for (int mk = 0; mk < 4; ++mk) {
        const unsigned nib = (unsigned)(W >> (16 * mk + 4 * fq)) & 0xfu;
#pragma unroll
        for (int r = 0; r < 4; ++r) {
            const float pv = ((nib >> r) & 1u) ? __expf(st[mk][r] - mnew) : 0.f;
            ps += pv;
            P[mk][r] = pv * rsv[mk][r];
        }
    }
    ps = xrow16_sum(ps);
    lrun = lrun * alpha + ps;
    mrun = mnew;
#pragma unroll
    for (int me = 0; me < 4; ++me) O[me] *= alpha;
#pragma unroll
    for (int ks = 0; ks < 2; ++ks) {
        u32x4 uu = (u32x4){pack2(P[2 * ks][0], P[2 * ks][1]), pack2(P[2 * ks][2], P[2 * ks][3]),
                           pack2(P[2 * ks + 1][0], P[2 * ks + 1][1]), pack2(P[2 * ks + 1][2], P[2 * ks + 1][3])};
        bf16x8 pf = *(bf16x8*)&uu;
#pragma unroll
        for (int me = 0; me < 4; ++me) {
            const bf16_t* vp = sm.Vt + (me * 16 + fr) * LDT + ks * 32 + 4 * fq;
            u32x2 lo = *(const u32x2*)vp, hi = *(const u32x2*)(vp + 16);
            u32x4 vv = (u32x4){lo.x, lo.y, hi.x, hi.y};
            O[me] = __builtin_amdgcn_mfma_f32_16x16x32_bf16(*(bf16x8*)&vv, pf, O[me], 0, 0, 0);
        }
    }
}
__device__ __forceinline__ void ph_mix_a2(const Params& p, unsigned char* smem) {
    AttnLds& sm = *(AttnLds*)smem;
    const int tid = ltid(), lane = tid & 63, w = __builtin_amdgcn_readfirstlane(tid >> 6), fr = lane & 15, fq = lane >> 4;
    unsigned char* r1 = p.ws + OFF_R1;
    bf16_t* QA = (bf16_t*)(r1 + R1_QA);
    const bf16_t* KA = (const bf16_t*)(r1 + R1_KA);
    const bf16_t* VAT = (const bf16_t*)(r1 + R1_VAT);
    const float* CKVSS = (const float*)(p.ws + OFF_CKVSS);
    const unsigned long long* MASKB = (const unsigned long long*)(p.ws + OFF_MASKB);
    for (int item = blockIdx.x; item < 1024; item += gridDim.x) {
        const int c = 31 - (item >> 5), b = (item >> 2) & 7, h0 = (item & 3) * 2;
        const int tq = b * 2048 + c * 64 + 16 * w + fr;
        bf16x8 qf0[2], qf1[2];
#pragma unroll
        for (int ks = 0; ks < 2; ++ks) {
            qf0[ks] = *(const bf16x8*)(QA + (size_t)tq * 512 + h0 * 64 + ks * 32 + fq * 8);
            qf1[ks] = *(const bf16x8*)(QA + (size_t)tq * 512 + (h0 + 1) * 64 + ks * 32 + fq * 8);
        }
        f32x4 O0[4], O1[4];
#pragma unroll
        for (int me = 0; me < 4; ++me) { O0[me] = (f32x4){0.f, 0.f, 0.f, 0.f}; O1[me] = (f32x4){0.f, 0.f, 0.f, 0.f}; }
        float m0r = -1e30f, l0r = 0.f, m1r = -1e30f, l1r = 0.f;
        for (int kt = 0; kt <= c; ++kt) {
            __syncthreads();
            stage_tile64(sm.K, KA + (size_t)(b * 2048 + kt * 64) * 64, 64, tid);
            stage_tile64(sm.Vt, VAT + ((size_t)b * 64) * 2048 + kt * 64, 2048, tid);
            if (tid < 64) {
                const f32x4 s4 = *(const f32x4*)(CKVSS + (size_t)(b * 2048 + kt * 64 + tid) * 4);
                sm.rs[tid] = rsqrtf(((s4[0] + s4[1]) + (s4[2] + s4[3])) * (1.0f / 256.0f) + EPS_);
            }
            const unsigned long long W = MASKB[(size_t)tq * 32 + kt];
            __syncthreads();
            a2_tile(sm, qf0, O0, m0r, l0r, W, fr, fq);
            __builtin_amdgcn_sched_barrier(0);
            a2_tile(sm, qf1, O1, m1r, l1r, W, fr, fq);
        }
        const float inv0 = 1.0f / l0r, inv1 = 1.0f / l1r;
        const int ts = ltid();
        const int fqs = (ts & 63) >> 4;
        const int tqs = b * 2048 + c * 64 + 16 * (ts >> 6) + (ts & 15);
#pragma unroll
        for (int me = 0; me < 4; ++me) {
            u32x2 u; u.x = pack2(O0[me][0] * inv0, O0[me][1] * inv0); u.y = pack2(O0[me][2] * inv0, O0[me][3] * inv0);
            *(u32x2*)(QA + (size_t)tqs * 512 + h0 * 64 + me * 16 + 4 * fqs) = u;
            u32x2 v; v.x = pack2(O1[me][0] * inv1, O1[me][1] * inv1); v.y = pack2(O1[me][2] * inv1, O1[me][3] * inv1);
            *(u32x2*)(QA + (size_t)tqs * 512 + (h0 + 1) * 64 + me * 16 + 4 * fqs) = v;
        }
    }
}

__device__ __forceinline__ void ph_merge(const Params& p, unsigned char* smem) {
    bf16_t* sT = (bf16_t*)smem;
    const int tid = ltid(), lane = tid & 63, wid = __builtin_amdgcn_readfirstlane(tid >> 6), wr = wid >> 1, wc = wid & 1, fr = lane & 15, fq = lane >> 4;
    unsigned char* r1 = p.ws + OFF_R1;
    const bf16_t* WB = (const bf16_t*)(p.ws + OFF_WB);
    const bf16_t* GATES = (const bf16_t*)(r1 + R1_GATES);
    bf16_t* MG = (bf16_t*)(p.ws + OFF_H);
    const int xcd = blockIdx.x & 7, jb = blockIdx.x >> 3, nper = gridDim.x >> 3;
    for (int q = jb; q < 256; q += nper) {
        const int nt = q >> 4, mtl = q & 15;
        const int mt = 16 * xcd + mtl, m0 = mt * 128, n0 = nt * 64;
        f32x4 macc[4][2];
        zero_acc<2>(macc);
#pragma unroll 1
        for (int br = 0; br < 3; ++br) {
            const bf16_t* A = (const bf16_t*)(r1 + (br == 0 ? R1_QA : (br == 1 ? R1_QB : R1_GC)));
            const int K = (br == 2) ? 1024 : 512;
            const bf16_t* Bt = WB + (br == 0 ? WB_WOA : (br == 1 ? WB_WOB : WB_WOC));
            unsigned ao[4], bo[2];
#pragma unroll
            for (int i = 0; i < 4; ++i) ao[i] = (unsigned)(m0 + stg_row(tid, i, 4)) * (unsigned)K + stg_chunk(tid, i) * 8;
#pragma unroll
            for (int i = 0; i < 2; ++i) bo[i] = (unsigned)(n0 + stg_row(tid, i, 2)) * (unsigned)K + stg_chunk(tid, i) * 8;
            f32x4 acc[4][2];
            zero_acc<2>(acc);
            gemm_kloop2<2>(acc, A, ao, Bt, bo, K, smem, tid);
            {
                const int bb = m0 >> 11, s0 = (m0 & 2047) + wr * 64 + fq * 4;
#pragma unroll
                for (int n = 0; n < 2; ++n) {
                    const bf16_t* gp = GATES + ((size_t)bb * 3072 + br * 1024 + n0 + wc * 32 + n * 16 + fr) * 2048 + s0;
#pragma unroll
                    for (int m = 0; m < 4; ++m) {
                        const u32x2 gu = *(const u32x2*)(gp + m * 16);
                        macc[m][n][0] += __uint_as_float(gu.x << 16) * acc[m][n][0];
                        macc[m][n][1] += __uint_as_float(gu.x & 0xffff0000u) * acc[m][n][1];
                        macc[m][n][2] += __uint_as_float(gu.y << 16) * acc[m][n][2];
                        macc[m][n][3] += __uint_as_float(gu.y & 0xffff0000u) * acc[m][n][3];
                    }
                }
            }
        }
        __syncthreads();
        lds_put_tile<2>(sT, macc, wr, wc, fr, fq);
        __syncthreads();
#pragma unroll
        for (int i = 0; i < 4; ++i) {
            const int c = tid + 256 * i, row = c >> 3, ch = c & 7;
            *(u32x4*)(MG + (size_t)(m0 + row) * 1024 + n0 + ch * 8) = *(const u32x4*)(sT + row * LDE + ch * 8);
        }
    }
}

__device__ __forceinline__ void ph_outproj(const Params& p, unsigned char* smem) {
    bf16_t* sT = (bf16_t*)smem;
    const int tid = ltid(), lane = tid & 63, wid = __builtin_amdgcn_readfirstlane(tid >> 6), wr = wid >> 1, wc = wid & 1, fr = lane & 15, fq = lane >> 4;
    const bf16_t* MG = (const bf16_t*)(p.ws + OFF_H);
    const bf16_t* Bt = (const bf16_t*)(p.ws + OFF_WB) + WB_WOUT;
    bf16_t* Y = (bf16_t*)(p.ws + OFF_R1 + R1_QC);
    for (int tile = blockIdx.x; tile < 128 * 8; tile += gridDim.x) {
        const int mt = tile >> 3, nt = tile & 7, m0 = mt * 128, n0 = nt * 128;
        unsigned ao[4], bo[4];
#pragma unroll
        for (int i = 0; i < 4; ++i) {
            const int R = stg_row(tid, i, 4), g = stg_chunk(tid, i);
            ao[i] = (unsigned)(m0 + R) * 1024u + g * 8;
            bo[i] = (unsigned)(n0 + R) * 1024u + g * 8;
        }
        f32x4 acc[4][4];
        zero_acc<4>(acc);
        gemm_kloop2<4>(acc, MG, ao, Bt, bo, 1024, smem, tid);
        __syncthreads();
        lds_put_tile<4>(sT, acc, wr, wc, fr, fq);
        __syncthreads();
#pragma unroll
        for (int i = 0; i < 8; ++i) {
            const int c = tid + 256 * i, row = c >> 4, ch = c & 15;
            *(u32x4*)(Y + (size_t)(m0 + row) * 1024 + n0 + ch * 8) = *(const u32x4*)(sT + row * LDE + ch * 8);
        }
    }
}

__device__ __forceinline__ void ph_router(const Params& p, int l, unsigned char* smem) {
    const int tid = ltid(), lane = tid & 63, wid = __builtin_amdgcn_readfirstlane(tid >> 6), wr = wid >> 1, wc = wid & 1, fr = lane & 15, fq = lane >> 4;
    const bf16_t* H = (const bf16_t*)(p.ws + OFF_H);
    const bf16_t* Bt = (const bf16_t*)(p.ws + OFF_WB) + WB_WR;
    int* cnt = (int*)(p.ws + OFF_CTL) + l * 64;
    int* LIST = (int*)(p.ws + OFF_LIST);
    float* AW = (float*)(p.ws + OFF_AW);
    const float* bias = p.router_bias + l * 64;
    float* lg = (float*)smem;
    int* hist = (int*)(smem + 128 * 65 * 4);
    for (int mt = blockIdx.x; mt < 128; mt += gridDim.x) {
        const int m0 = mt * 128;
        unsigned ao[4], bo[4];
#pragma unroll
        for (int i = 0; i < 4; ++i) {
            const int R = stg_row(tid, i, 4), g = stg_chunk(tid, i);
            ao[i] = (unsigned)(m0 + R) * 1024u + g * 8;
            bo[i] = (unsigned)R * 1024u + g * 8;
        }
        f32x4 acc[4][4];
        zero_acc<4>(acc);
        gemm_kloop2<4>(acc, H, ao, Bt, bo, 1024, smem, tid);
        __syncthreads();
        if (wc == 0) {
#pragma unroll
            for (int m = 0; m < 4; ++m)
#pragma unroll
                for (int j = 0; j < 4; ++j)
#pragma unroll
                    for (int n = 0; n < 4; ++n) lg[(wr * 64 + m * 16 + fq * 4 + j) * 65 + n * 16 + fr] = acc[m][n][j];
        }
        if (tid < 64) hist[tid] = 0;
        int erank[8], ekeep[8];
#pragma unroll
        for (int k = 0; k < 8; ++k) { erank[k] = 0; ekeep[k] = 0; }
        __syncthreads();
        if (tid < 128) {
            float* row = lg + tid * 65;
            const int t = m0 + tid;
            float gs[8];
#pragma unroll
            for (int g = 0; g < 8; ++g) {
                float m1 = -__builtin_inff(), m2 = -__builtin_inff();
#pragma unroll
                for (int e = 0; e < 8; ++e) {
                    const float v = sigmoidf_(row[g * 8 + e]) + bias[g * 8 + e];
                    row[g * 8 + e] = v;
                    if (v > m1) { m2 = m1; m1 = v; } else if (v > m2) m2 = v;
                }
                gs[g] = m1 + m2;
            }
            unsigned gmask = 0u;
#pragma unroll
            for (int g = 0; g < 8; ++g) {
                int rank = 0;
#pragma unroll
                for (int g2 = 0; g2 < 8; ++g2) rank += (gs[g2] > gs[g] || (gs[g2] == gs[g] && g2 < g)) ? 1 : 0;
                if (rank < 4) gmask |= 1u << g;
            }
            unsigned long long taken = 0ull;
            int eidx[8]; float esc[8];
            float ssum = 0.f;
#pragma unroll
            for (int k = 0; k < 8; ++k) {
                float best = -__builtin_inff(); int bi = 0;
                for (int e = 0; e < 64; ++e) {
                    if (!((gmask >> (e >> 3)) & 1u) || ((taken >> e) & 1ull)) continue;
                    const float v = row[e];
                    if (v > best) { best = v; bi = e; }
                }
                taken |= 1ull << bi;
                eidx[k] = bi;
                esc[k] = best - bias[bi];
                ssum += esc[k];
            }
            const float scale = 2.5f / ssum;
#pragma unroll
            for (int k = 0; k < 8; ++k) {
                erank[k] = atomicAdd(&hist[eidx[k]], 1);
                ekeep[k] = eidx[k];
                AW[(size_t)t * 8 + k] = esc[k] * scale;
            }
        }
        __syncthreads();
        if (tid < 64) hist[64 + tid] = atomicAdd(&cnt[tid], hist[tid]);
        __syncthreads();
        if (tid < 128) {
            const int t = m0 + tid;
#pragma unroll
            for (int k = 0; k < 8; ++k) LIST[(size_t)ekeep[k] * T_ + hist[64 + ekeep[k]] + erank[k]] = t * 8 + k;
        }
        __syncthreads();
    }
}

struct __attribute__((aligned(16))) MoeLds { int tstart[66]; int xs[10]; int pad0[20]; int hbase[66]; int pad1[14]; int rowid[128]; };
__device__ __forceinline__ void moe_setup(MoeLds& sm, const int* cnt, int tid) {
    __syncthreads();
    if (tid == 0) {
        int ts = 0, hb = 0;
        for (int e = 0; e < 65; ++e) {
            const int ce = (e < 64) ? cnt[e] : T_;
            sm.tstart[e] = ts; sm.hbase[e] = hb;
            ts += (ce + 127) >> 7; hb += ce;
        }
        sm.tstart[65] = ts; sm.hbase[65] = hb;
        const int xcd = blockIdx.x & 7;
        int acc = 0;
        for (int k = 0; k < 8; ++k) { sm.xs[k] = acc; acc += sm.tstart[k * 8 + xcd + 1] - sm.tstart[k * 8 + xcd]; }
        sm.xs[8] = acc; acc += 16; sm.xs[9] = acc;
    }
    __syncthreads();
}

__device__ __forceinline__ void ph_moe1(const Params& p, int l, unsigned char* smem) {
    MoeLds& sm = *(MoeLds*)(smem + MISC + 64);
    const int tid = ltid(), lane = tid & 63, wid = __builtin_amdgcn_readfirstlane(tid >> 6), wr = wid >> 1, wc = wid & 1, fr = lane & 15, fq = lane >> 4;
    const bf16_t* H = (const bf16_t*)(p.ws + OFF_H);
    const bf16_t* W13 = (const bf16_t*)(p.ws + OFF_WB) + WB_W13;
    const int* cnt = (const int*)(p.ws + OFF_CTL) + l * 64;
    const int* LIST = (const int*)(p.ws + OFF_LIST);
    bf16_t* HID = (bf16_t*)(p.ws + OFF_R3);
    moe_setup(sm, cnt, tid);
    const int xcd = blockIdx.x & 7, jb = blockIdx.x >> 3, nper = gridDim.x >> 3;
    const int nitems = sm.xs[9] * 4;
    for (int item = jb; item < nitems; item += nper) {
        const int rtl = item >> 2, nt = item & 3;
        int k = 0;
        while (sm.xs[k + 1] <= rtl) ++k;
        const int e = (k < 8) ? (k * 8 + xcd) : 64;
        const int mtl = rtl - sm.xs[k] + ((k == 8) ? 16 * xcd : 0);
        const int ce = (e < 64) ? cnt[e] : T_;
        __syncthreads();
        if (tid < 128) {
            const int slot = mtl * 128 + tid;
            int tok = 0;
            if (slot < ce) tok = (e < 64) ? (LIST[(size_t)e * T_ + slot] >> 3) : slot;
            sm.rowid[tid] = tok;
        }
        __syncthreads();
        unsigned ao[4], bo[4];
#pragma unroll
        for (int i = 0; i < 4; ++i) {
            const int R = stg_row(tid, i, 4), g = stg_chunk(tid, i);
            ao[i] = (unsigned)sm.rowid[R] * 1024u + g * 8;
            bo[i] = (unsigned)(e * 512 + nt * 128 + R) * 1024u + g * 8;
        }
        f32x4 acc[4][4];
        zero_acc<4>(acc);
        gemm_kloop2<4>(acc, H, ao, W13, bo, 1024, smem, tid);
        const int hb = sm.hbase[e] + mtl * 128;
        f32x4 hacc[4][2];
#pragma unroll
        for (int m = 0; m < 4; ++m)
#pragma unroll
            for (int nn = 0; nn < 2; ++nn)
#pragma unroll
                for (int j = 0; j < 4; ++j) hacc[m][nn][j] = siluf_(acc[m][nn][j]) * acc[m][nn + 2][j];
        bf16_t* sT = (bf16_t*)smem;
        __syncthreads();
        lds_put_tile<2>(sT, hacc, wr, wc, fr, fq);
        __syncthreads();
        const int ts = ltid();
#pragma unroll
        for (int i = 0; i < 4; ++i) {
            const int c = ts + 256 * i, row = c >> 3, ch = c & 7;
            if (mtl * 128 + row < ce)
                *(u32x4*)(HID + (size_t)(hb + row) * 256 + nt * 64 + ch * 8) = *(const u32x4*)(sT + row * LDE + ch * 8);
        }
    }
}

__device__ __forceinline__ void ph_moe2(const Params& p, int l, unsigned char* smem) {
    MoeLds& sm = *(MoeLds*)(smem + MISC + 64);
    const int tid = ltid(), lane = tid & 63, wid = __builtin_amdgcn_readfirstlane(tid >> 6), wr = wid >> 1, wc = wid & 1, fr = lane & 15, fq = lane >> 4;
    const bf16_t* W2 = (const bf16_t*)(p.ws + OFF_WB) + WB_W2;
    const int* cnt = (const int*)(p.ws + OFF_CTL) + l * 64;
    const int* LIST = (const int*)(p.ws + OFF_LIST);
    const float* AW = (const float*)(p.ws + OFF_AW);
    const bf16_t* HID = (const bf16_t*)(p.ws + OFF_R3);
    bf16_t* SLOTS = (bf16_t*)(p.ws + OFF_R1);
    moe_setup(sm, cnt, tid);
    const int xcd = blockIdx.x & 7, jb = blockIdx.x >> 3, nper = gridDim.x >> 3;
    const int nitems = sm.xs[9] * 8;
    for (int item = jb; item < nitems; item += nper) {
        const int rtl = item >> 3, nt = item & 7;
        int k = 0;
        while (sm.xs[k + 1] <= rtl) ++k;
        const int e = (k < 8) ? (k * 8 + xcd) : 64;
        const int mtl = rtl - sm.xs[k] + ((k == 8) ? 16 * xcd : 0);
        const int ce = (e < 64) ? cnt[e] : T_;
        __syncthreads();
        if (tid < 128) {
            const int slot = mtl * 128 + tid;
            int aid = -1;
            if (slot < ce) aid = (e < 64) ? LIST[(size_t)e * T_ + slot] : (8 * T_ + slot);
            sm.rowid[tid] = aid;
        }
        __syncthreads();
        const int hb = sm.hbase[e] + mtl * 128;
        unsigned ao[4], bo[4];
#pragma unroll
        for (int i = 0; i < 4; ++i) {
            const int R = stg_row(tid, i, 4), g = stg_chunk(tid, i);
            ao[i] = (unsigned)(hb + R) * 256u + g * 8;
            bo[i] = (unsigned)(e * 1024 + nt * 128 + R) * 256u + g * 8;
        }
        f32x4 acc[4][4];
        zero_acc<4>(acc);
        gemm_kloop2<4>(acc, HID, ao, W2, bo, 256, smem, tid);
        const int ts = ltid();
        const int fqs = (ts & 63) >> 4;
#pragma unroll
        for (int m = 0; m < 4; ++m)
#pragma unroll
            for (int j = 0; j < 4; ++j) {
                const int r = wr * 64 + m * 16 + fqs * 4 + j;
                const int aid = sm.rowid[r];
                const float wt = (aid >= 0 && e < 64) ? AW[aid] : 1.0f;
#pragma unroll
                for (int n = 0; n < 4; ++n) acc[m][n][j] *= wt;
            }
        bf16_t* sT = (bf16_t*)smem;
        __syncthreads();
        lds_put_tile<4>(sT, acc, wr, wc, fr, fq);
        __syncthreads();
#pragma unroll
        for (int i = 0; i < 8; ++i) {
            const int c = ts + 256 * i, row = c >> 4, ch = c & 15;
            const int aid = sm.rowid[row];
            if (aid >= 0)
                __builtin_nontemporal_store(*(const u32x4*)(sT + row * LDE + ch * 8), (u32x4*)(SLOTS + (size_t)aid * 1024 + nt * 128 + ch * 8));
        }
    }
}

struct JobDesc { int K, NQ, src_ld, dst_ld, mode, p0, nbatch, which; unsigned src_lstride, src_bs, dst_bs, dst_off; };
constexpr int NJOBS = 12;
__constant__ JobDesc JOBS[NJOBS] = {
    {1024, 8832, NIN_, 1024, 1, 0, 1, 9, 1024u * NIN_, 0u, 0u, (unsigned)WB_WIN},
    {512, 1024, 1024, 512, 0, 0, 1, 14, 512u * 1024u, 0u, 0u, (unsigned)WB_WOA},
    {512, 1024, 1024, 512, 0, 0, 1, 15, 512u * 1024u, 0u, 0u, (unsigned)WB_WOB},
    {1024, 1024, 1024, 1024, 0, 0, 1, 16, 1024u * 1024u, 0u, 0u, (unsigned)WB_WOC},
    {1024, 1024, 1024, 1024, 0, 0, 1, 17, 1024u * 1024u, 0u, 0u, (unsigned)WB_WOUT},
    {1024, 128, 64, 1024, 3, 0, 1, 18, 1024u * 64u, 0u, 0u, (unsigned)WB_WR},
    {1024, 256, 256, 1024, 2, 0, 64, 20, 64u * 1024u * 256u, 1024u * 256u, 512u * 1024u, (unsigned)WB_W13},
    {1024, 256, 256, 1024, 2, 32, 64, 21, 64u * 1024u * 256u, 1024u * 256u, 512u * 1024u, (unsigned)WB_W13},
    {1024, 256, 256, 1024, 2, 0, 1, 23, 1024u * 256u, 0u, 0u, (unsigned)(WB_W13 + (size_t)64 * 512 * 1024)},
    {1024, 256, 256, 1024, 2, 32, 1, 24, 1024u * 256u, 0u, 0u, (unsigned)(WB_W13 + (size_t)64 * 512 * 1024)},
    {256, 1024, 1024, 256, 0, 0, 64, 22, 64u * 256u * 1024u, 256u * 1024u, 1024u * 256u, (unsigned)WB_W2},
    {256, 1024, 1024, 256, 0, 0, 1, 25, 256u * 1024u, 0u, 0u, (unsigned)(WB_W2 + (size_t)64 * 1024 * 256)},
};
__constant__ int JOBPRE[NJOBS + 1] = {0, 2208, 2336, 2464, 2720, 2976, 3008, 7104, 11200, 11264, 11328, 15424, 15488};
__device__ __forceinline__ TJob make_job(const Params& p, int l, int it, int& base) {
    int j = 0;
    while (JOBPRE[j + 1] <= it) ++j;
    const JobDesc d = JOBS[j];
    TJob tj;
    tj.src = ((const float* const*)&p)[d.which] + (size_t)l * d.src_lstride;
    tj.dst = (bf16_t*)(p.ws + OFF_WB) + d.dst_off;
    tj.K = d.K; tj.NQ = d.NQ; tj.src_ld = d.src_ld; tj.dst_ld = d.dst_ld; tj.mode = d.mode; tj.p0 = d.p0; tj.nbatch = d.nbatch; tj.pad = 0;
    tj.src_bs = d.src_bs; tj.dst_bs = d.dst_bs;
    base = JOBPRE[j];
    return tj;
}
__device__ __forceinline__ void tconv_range(const Params& p, int l, unsigned char* smem, int first, int stride, int it0, int it1) {
    float* tile = (float*)smem;
    const int tid = ltid();
    const int total = it1;
    __syncthreads();
    int it = it0 + first;
    f32x4 r[4];
    if (it < total) { int base; const TJob tj = make_job(p, l, it, base); tconv_load(tj, it - base, tid, r); }
    while (it < total) {
        const int nxt = it + stride;
        tconv_put(tid, r, tile);
        __syncthreads();
        if (nxt < total) { int base; const TJob tj = make_job(p, l, nxt, base); tconv_load(tj, nxt - base, tid, r); }
        { int base; const TJob tj = make_job(p, l, it, base); tconv_emit(tj, it - base, tid, tile); }
        __syncthreads();
        it = nxt;
    }
}

constexpr int TC_MIX_END = 3008;
__device__ __forceinline__ void ph_tconv_mix(const Params& p, int l, unsigned char* smem) { tconv_range(p, l, smem, blockIdx.x, gridDim.x, 0, TC_MIX_END); }
constexpr int SMEM_BYTES = DYN_LDS;
__device__ __forceinline__ int next_item(int* ctr, unsigned char* smem) {
    int* s_item = (int*)(smem + MISC);
    __syncthreads();
    if (ltid() == 0) *s_item = atomicAdd(ctr, 1);
    __syncthreads();
    return *s_item;
}
constexpr int TC_CH = 8;
constexpr int TC_NCH = (15488 - TC_MIX_END + TC_CH - 1) / TC_CH;
__device__ __forceinline__ void ph_tconv_moe(const Params& p, int l, unsigned char* smem) {
    int* ctr = (int*)(p.ws + OFF_CTL) + 256 + l * 4;
    for (;;) { const int it = next_item(ctr + 3, smem); if (it >= TC_NCH) break;
        const int a0 = TC_MIX_END + it * TC_CH; tconv_range(p, l, smem, 0, 1, a0, (a0 + TC_CH < JOBPRE[NJOBS]) ? a0 + TC_CH : JOBPRE[NJOBS]); }
}
__device__ __forceinline__ void ph_mix1(const Params& p, int l, unsigned char* smem) {
    int* ctr = (int*)(p.ws + OFF_CTL) + 256 + l * 4;
    for (;;) { const int it = next_item(ctr + 0, smem); if (it >= 2048) break; mixc1_item(p, it, smem); }
    for (;;) { const int it = next_item(ctr + 1, smem); if (it >= 1024) break; mixb_item(p, it, smem); }
    for (;;) { const int it = next_item(ctr + 2, smem); if (it >= 1024) break; mixa1_item(p, it, smem); }
}


constexpr size_t OFF_BAR = 16 * KiB;
#define XB_TMO      128
#define XB_XCNT(j)  (256  + 64 * (j))
#define XB_XSUB(j)  (1280 + 64 * (j))
#define XB_XGEN(j)  (2304 + 64 * (j))
#define XB_TOP      3328
#define XB_TOPGEN   3392
#define XCD_BAR_WORDS 3456
#define XB_SPIN_CAP (1u << 18)
__device__ __forceinline__ unsigned xb_ld(unsigned* p)              { return __hip_atomic_load(p, __ATOMIC_RELAXED, __HIP_MEMORY_SCOPE_AGENT); }
__device__ __forceinline__ unsigned xb_add(unsigned* p, unsigned v) { return __hip_atomic_fetch_add(p, v, __ATOMIC_RELAXED, __HIP_MEMORY_SCOPE_AGENT); }
__device__ __forceinline__ unsigned xb_xcc_id() { return (unsigned)__builtin_amdgcn_s_getreg((3 << 11) | 20) & 0xFu; }
#define XB_SPIN(cond, bar) do { unsigned _sp = 0; while (cond) { __builtin_amdgcn_s_sleep(1); \
    if ((++_sp & 255u) == 0u) { if (xb_ld(&(bar)[XB_TMO])) break; if (_sp > XB_SPIN_CAP) { atomicAdd(&(bar)[XB_TMO], 1u); break; } } } } while (0)
__device__ __forceinline__ void xcd_barrier_post(unsigned* bar) {
    if (threadIdx.x == 0) (void)xb_add(&bar[XB_XCNT(xb_xcc_id())], 1u);
}
__device__ __forceinline__ void xcd_barrier_complete(unsigned* bar, unsigned x, unsigned& nloc, unsigned& nx) {
    const unsigned G = gridDim.x * gridDim.y * gridDim.z;
    unsigned sum, cnt, mine, sp = 0u;
    for (;;) {
        sum = 0u; cnt = 0u; mine = 0u;
#pragma unroll
        for (unsigned j = 0; j < 16; ++j) { const unsigned c = xb_ld(&bar[XB_XCNT(j)]); sum += c; cnt += (c > 0u) ? 1u : 0u; mine = (j == x) ? c : mine; }
        if (sum == G) break;
        __builtin_amdgcn_s_sleep(1);
        if ((++sp & 255u) == 0u) { if (xb_ld(&bar[XB_TMO])) break; if (sp > XB_SPIN_CAP) { atomicAdd(&bar[XB_TMO], 1u); break; } }
    }
    nloc = mine > 0u ? mine : 1u; nx = cnt > 0u ? cnt : 1u;
}
__device__ __forceinline__ void xcd_barrier(unsigned* bar, volatile LAS unsigned* st) {
    asm volatile("s_waitcnt vmcnt(0)" ::: "memory");
    __syncthreads();
    if (threadIdx.x == 0) {
        const unsigned x = xb_xcc_id();
        __builtin_amdgcn_s_waitcnt(0);
        unsigned nloc = st[0], nx = st[1];
        if (nloc == 0u) { xcd_barrier_complete(bar, x, nloc, nx); st[0] = nloc; st[1] = nx; }
        const unsigned old = xb_add(&bar[XB_XSUB(x)], 1u);
        const unsigned gen = old / nloc;
        if (old + 1u == (gen + 1u) * nloc) {
            __builtin_amdgcn_fence(__ATOMIC_RELEASE, "agent");
            asm volatile("s_waitcnt vmcnt(0)" ::: "memory");
            const unsigned og = xb_add(&bar[XB_TOP], 1u);
            const unsigned tg = og / nx;
            if (og + 1u == (tg + 1u) * nx) xb_add(&bar[XB_TOPGEN], 1u);
            else XB_SPIN(xb_ld(&bar[XB_TOPGEN]) == tg, bar);
            __builtin_amdgcn_fence(__ATOMIC_ACQUIRE, "agent");
            xb_add(&bar[XB_XGEN(x)], 1u);
            asm volatile("s_waitcnt vmcnt(0)" ::: "memory");
        } else {
            XB_SPIN(xb_ld(&bar[XB_XGEN(x)]) == gen, bar);
            __builtin_amdgcn_fence(__ATOMIC_ACQUIRE, "agent");
            asm volatile("s_waitcnt vmcnt(0)" ::: "memory");
        }
    }
    __syncthreads();
}

#define LAUNDER()
__global__ void __launch_bounds__(256, 3) mega(Params p_unused) {
    extern __shared__ __attribute__((aligned(16))) unsigned char smem[];
    if (threadIdx.x == 0) *(u32x4*)(smem + MISC + 16) = (u32x4){0u, 0u, 0u, 0u};
    __syncthreads();
    xcd_barrier_post((unsigned*)(getp().ws + OFF_BAR));
#define GSYNC() xcd_barrier((unsigned*)(getp().ws + OFF_BAR), (volatile LAS unsigned*)(smem + MISC + 16))

    ph_rope(getp());
    ph_mod(getp(), smem);
    ph_tconv_mix(getp(), 0, smem);
    ph_wcomp(getp(), 0, smem);
    GSYNC();
    {
        const Params& p = getp();
        const float* mod = (const float*)(p.ws + OFF_MOD);
        NormArgs a;
        a.xin = p.x; a.Y = nullptr; a.slots = nullptr; a.gpost = nullptr; a.gt = nullptr;
        a.mode = 0; a.gpre = p.g_pre_mix; a.sc = mod + 1024; a.sh = mod + 0;
        ph_norm(p, a);
    }
    GSYNC();
#pragma unroll 1
    for (int l = 0; l < DEPTH_; ++l) {
        ph_gemm_z(getp(), smem);
        GSYNC();
        ph_mix1(getp(), l, smem);
        GSYNC();
        ph_mixc2(getp());
        ph_mix_a2(getp(), smem);
        GSYNC();
        { const Params& p = getp(); for (int it = blockIdx.x; it < 2048; it += gridDim.x) mixc3_item(p, l, it, smem); }
        GSYNC();
        ph_merge(getp(), smem);
        GSYNC();
        ph_outproj(getp(), smem);
        GSYNC();
        {
            const Params& p = getp();
        const float* mod = (const float*)(p.ws + OFF_MOD);
        NormArgs a;
            a.xin = nullptr; a.slots = nullptr;
            a.mode = 1; a.Y = (const bf16_t*)(p.ws + OFF_R1 + R1_QC);
            a.gpost = p.g_post_mix + l * 1024; a.gt = mod + (size_t)l * 8 * 6144 + 2048;
            a.gpre = p.g_pre_ffn + l * 1024; a.sc = mod + (size_t)l * 8 * 6144 + 4096; a.sh = mod + (size_t)l * 8 * 6144 + 3072;
            ph_norm(p, a);
        }
        GSYNC();
        ph_router(getp(), l, smem);
        ph_tconv_moe(getp(), l, smem);
        GSYNC();
        ph_moe1(getp(), l, smem);
        GSYNC();
        ph_moe2(getp(), l, smem);
        GSYNC();
        {
            const Params& p = getp();
        const float* mod = (const float*)(p.ws + OFF_MOD);
        NormArgs a;
            a.xin = nullptr; a.Y = nullptr;
            a.mode = 2; a.slots = (const bf16_t*)(p.ws + OFF_R1);
            a.gpost = p.g_post_ffn + l * 1024; a.gt = mod + (size_t)l * 8 * 6144 + 5120;
            a.gpre = nullptr; a.sc = nullptr; a.sh = nullptr;
            if (l + 1 < DEPTH_) { a.gpre = p.g_pre_mix + (l + 1) * 1024; a.sc = mod + (size_t)(l + 1) * 8 * 6144 + 1024; a.sh = mod + (size_t)(l + 1) * 8 * 6144 + 0; }
            ph_norm(p, a);
        }
        if (l + 1 < DEPTH_) {
            ph_tconv_mix(getp(), l + 1, smem);
            ph_wcomp(getp(), l + 1, smem);
            GSYNC();
        }
    }
}

extern "C" void kernel_launch(void* const* d_in, const int* in_sizes, int n_in, void* d_out, int out_size, void* d_ws, size_t ws_size, hipStream_t stream) {
    if (n_in < 26 || ws_size < WS_TOTAL) { fprintf(stderr, "kernel_launch: bad inputs / workspace too small (%zu < %zu)\n", ws_size, (size_t)WS_TOTAL); return; }
    Params p;
    memset(&p, 0, sizeof(p));
    p.x = (const float*)d_in[0]; p.c = (const float*)d_in[1]; p.positions = (const int*)d_in[2]; p.ada_w = (const float*)d_in[3]; p.ada_b = (const float*)d_in[4];
    p.g_pre_mix = (const float*)d_in[5]; p.g_post_mix = (const float*)d_in[6]; p.g_pre_ffn = (const float*)d_in[7]; p.g_post_ffn = (const float*)d_in[8];
    p.w_in = (const float*)d_in[9]; p.g_kv = (const float*)d_in[10]; p.w_uk = (const float*)d_in[11]; p.w_uv = (const float*)d_in[12]; p.g_ret = (const float*)d_in[13];
    p.w_o_a = (const float*)d_in[14]; p.w_o_b = (const float*)d_in[15]; p.w_o_c = (const float*)d_in[16]; p.w_out = (const float*)d_in[17];
    p.w_router = (const float*)d_in[18]; p.router_bias = (const float*)d_in[19]; p.w1 = (const float*)d_in[20]; p.w3 = (const float*)d_in[21]; p.w2 = (const float*)d_in[22];
    p.ws1 = (const float*)d_in[23]; p.ws3 = (const float*)d_in[24]; p.ws2 = (const float*)d_in[25];
    p.out = (float*)d_out; p.ws = (unsigned char*)d_ws;
    static int grid_blocks = 0;
    if (!grid_blocks) {
        int dev = 0, cus = 0, per_cu = 0;
        (void)hipGetDevice(&dev);
        (void)hipDeviceGetAttribute(&cus, hipDeviceAttributeMultiprocessorCount, dev);
        (void)hipFuncSetAttribute((const void*)mega, hipFuncAttributeMaxDynamicSharedMemorySize, DYN_LDS);
        (void)hipOccupancyMaxActiveBlocksPerMultiprocessor(&per_cu, mega, 256, DYN_LDS);
        if (per_cu < 1) per_cu = 1;
        if (per_cu > 3) per_cu = 3;
        grid_blocks = cus * per_cu;
    }
    (void)hipMemsetAsync((unsigned char*)d_ws + OFF_CTL, 0, 32 * 1024, stream);
    void* args[] = {&p};
    hipError_t e = hipLaunchCooperativeKernel((void*)mega, dim3(grid_blocks), dim3(256), args, DYN_LDS, stream);
    if (e != hipSuccess) fprintf(stderr, "cooperative launch failed: %s (grid %d)\n", hipGetErrorString(e), grid_blocks);
}
```

```cpp
#include <hip/hip_runtime.h>
#include <hip/hip_cooperative_groups.h>
namespace cg = cooperative_groups;
#include <stdint.h>
#include <stdio.h>
#include <string.h>

typedef unsigned short bf16_t;
typedef short bf16x8 __attribute__((ext_vector_type(8)));
typedef short bf16x4 __attribute__((ext_vector_type(4)));
typedef float f32x4 __attribute__((ext_vector_type(4)));
typedef float f32x2 __attribute__((ext_vector_type(2)));
typedef unsigned u32x4 __attribute__((ext_vector_type(4)));
typedef unsigned u32x2 __attribute__((ext_vector_type(2)));

constexpr int T_ = 16384, S_ = 2048, NB_ = 8, D_ = 1024, DEPTH_ = 2;
constexpr int NIN_ = 8772;
constexpr int NZ_ = 8960;
constexpr float EPS_ = 1e-6f;

constexpr int C_QA = 0, C_CKV = 512, C_IQ = 768, C_IK = 1024, C_IW = 1088, C_QB = 1152, C_KB = 1664, C_VB = 2176,
              C_QC = 2688, C_KC = 3200, C_VC = 3712, C_GC = 4736, C_GATES = 5760, C_KA = 8832, C_VA = 8896;

constexpr size_t KiB = 1024, MiB = 1024 * 1024;
constexpr size_t OFF_CTL = 0;
constexpr size_t OFF_MOD = 64 * KiB;
constexpr size_t OFF_IW = 512 * KiB;
constexpr size_t OFF_CKVSS = 768 * KiB;
constexpr size_t OFF_AW = 1 * MiB;
constexpr size_t OFF_RS = 1 * MiB + 512 * KiB;
constexpr size_t OFF_ROPE = 2 * MiB;
constexpr size_t OFF_LIST = 6 * MiB;
constexpr size_t OFF_MASKB = 10 * MiB;
constexpr size_t OFF_WB = 14 * MiB;
constexpr size_t WB_WIN = 0;
constexpr size_t WB_WOA = WB_WIN + (size_t)NZ_ * 1024;
constexpr size_t WB_WOB = WB_WOA + 1024 * 512;
constexpr size_t WB_WOC = WB_WOB + 1024 * 512;
constexpr size_t WB_WOUT = WB_WOC + 1024 * 1024;
constexpr size_t WB_WR = WB_WOUT + 1024 * 1024;
constexpr size_t WB_W13 = WB_WR + 128 * 1024;
constexpr size_t WB_W2 = WB_W13 + (size_t)65 * 512 * 1024;
constexpr size_t WB_END = WB_W2 + (size_t)65 * 1024 * 256;
constexpr size_t OFF_H = OFF_WB + ((WB_END * 2 + MiB - 1) / MiB) * MiB;
constexpr size_t OFF_R1 = OFF_H + 32 * MiB;
constexpr size_t R1_QA = 0;
constexpr size_t R1_IQ = R1_QA + 16 * MiB;
constexpr size_t R1_IK = R1_IQ + 8 * MiB;
constexpr size_t R1_KA = R1_IK + 2 * MiB;
constexpr size_t R1_VAT = R1_KA + 2 * MiB;
constexpr size_t R1_QB = R1_VAT + 2 * MiB;
constexpr size_t R1_KB = R1_QB + 16 * MiB;
constexpr size_t R1_VBT = R1_KB + 16 * MiB;
constexpr size_t R1_QC = R1_VBT + 16 * MiB;
constexpr size_t R1_KC = R1_QC + 16 * MiB;
constexpr size_t R1_KCT = R1_KC + 16 * MiB;
constexpr size_t R1_VCT = R1_KCT + 16 * MiB;
constexpr size_t R1_GC = R1_VCT + 32 * MiB;
constexpr size_t R1_GATES = R1_GC + 32 * MiB;
constexpr size_t R1_ZEND = R1_GATES + 96 * MiB;
constexpr size_t R1_SIZE = 288 * MiB;
constexpr size_t OFF_R3 = OFF_R1 + R1_SIZE;
constexpr size_t R3_SIZE = 78 * MiB;
constexpr size_t WS_TOTAL = OFF_R3 + R3_SIZE;
static_assert(R1_ZEND <= R1_SIZE, "r1");
constexpr size_t SC_PER_BATCH = 2162688;

__constant__ float INVF[32] = {
    1.000000000e+00f, 7.498942614e-01f, 5.623413324e-01f, 4.216965139e-01f, 3.162277639e-01f, 2.371373773e-01f, 1.778279394e-01f, 1.333521307e-01f,
    1.000000015e-01f, 7.498941571e-02f, 5.623413250e-02f, 4.216965288e-02f, 3.162277490e-02f, 2.371373773e-02f, 1.778279431e-02f, 1.333521493e-02f,
    9.999999776e-03f, 7.498941850e-03f, 5.623413250e-03f, 4.216964822e-03f, 3.162277630e-03f, 2.371373586e-03f, 1.778279431e-03f, 1.333521446e-03f,
    1.000000047e-03f, 7.498942432e-04f, 5.623413017e-04f, 4.216965172e-04f, 3.162277571e-04f, 2.371373703e-04f, 1.778279402e-04f, 1.333521504e-04f};

__constant__ float LOGG[8] = {-0.0317486983145803f, -0.015748356968139168f, -0.007843177461025893f, -0.003913899321136329f,
                               -0.0019550348358033506f, -0.0009770396478266127f, -0.0004884004981088745f, -0.0002441704321739145f};

__device__ __forceinline__ float bf2f(bf16_t u) { return __uint_as_float(((unsigned)u) << 16); }
__device__ __forceinline__ bf16_t f2bf(float f) {
    unsigned u = __float_as_uint(f);
    u += 0x7fffu + ((u >> 16) & 1u);
    return (bf16_t)(u >> 16);
}
__device__ __forceinline__ unsigned pack2(float a, float b) { return (unsigned)f2bf(a) | ((unsigned)f2bf(b) << 16); }
__device__ __forceinline__ float sigmoidf_(float x) { return __builtin_amdgcn_rcpf(1.0f + __expf(-x)); }
__device__ __forceinline__ float siluf_(float x) { return x * __builtin_amdgcn_rcpf(1.0f + __expf(-x)); }
__device__ __forceinline__ float wave_sum(float v) {
#pragma unroll
    for (int o = 32; o >= 1; o >>= 1) v += __shfl_xor(v, o);
    return v;
}
__device__ __forceinline__ int wave_sum_i(int v) {
#pragma unroll
    for (int o = 32; o >= 1; o >>= 1) v += __shfl_xor(v, o);
    return v;
}

struct Params {
    const float* x; const float* c; const int* positions; const float* ada_w; const float* ada_b;
    const float* g_pre_mix; const float* g_post_mix; const float* g_pre_ffn; const float* g_post_ffn;
    const float* w_in; const float* g_kv; const float* w_uk; const float* w_uv; const float* g_ret;
    const float* w_o_a; const float* w_o_b; const float* w_o_c; const float* w_out;
    const float* w_router; const float* router_bias; const float* w1; const float* w3; const float* w2;
    const float* ws1; const float* ws3; const float* ws2;
    float* out;
    unsigned char* ws;
};

__device__ __forceinline__ int cnt_ge(int cnt, unsigned key, unsigned cand) {
    asm volatile("v_cmp_ge_u32 vcc, %1, %2\n\tv_addc_co_u32 %0, vcc, 0, %0, vcc" : "+v"(cnt) : "v"(key), "v"(cand) : "vcc");
    return cnt;
}
__device__ __forceinline__ int cnt_ge_s(int cnt, unsigned key, unsigned cand) {
    asm volatile("v_cmp_ge_u32 vcc, %1, %2\n\ts_bcnt1_i32_b64 vcc_lo, vcc\n\ts_add_i32 %0, %0, vcc_lo" : "+s"(cnt) : "v"(key), "v"(cand) : "vcc", "scc");
    return cnt;
}
__device__ __forceinline__ int wave_total6(int c) {
    int t = 0;
#pragma unroll
    for (int b = 0; b < 6; ++b) t += __builtin_popcountll(__ballot((c >> b) & 1)) << b;
    return t;
}
__device__ __forceinline__ float xrow16_max(float x) {
    auto s = __builtin_amdgcn_permlane16_swap(__float_as_uint(x), __float_as_uint(x), false, false);
    x = fmaxf(__uint_as_float(s[0]), __uint_as_float(s[1]));
    auto t = __builtin_amdgcn_permlane32_swap(__float_as_uint(x), __float_as_uint(x), false, false);
    return fmaxf(__uint_as_float(t[0]), __uint_as_float(t[1]));
}
__device__ __forceinline__ float xrow16_sum(float x) {
    auto s = __builtin_amdgcn_permlane16_swap(__float_as_uint(x), __float_as_uint(x), false, false);
    x = __uint_as_float(s[0]) + __uint_as_float(s[1]);
    auto t = __builtin_amdgcn_permlane32_swap(__float_as_uint(x), __float_as_uint(x), false, false);
    return __uint_as_float(t[0]) + __uint_as_float(t[1]);
}
__device__ __forceinline__ int ltid() { int t = threadIdx.x; asm volatile("" : "+v"(t)); return t; }
typedef const Params __attribute__((address_space(4))) * KParamsPtr;
__device__ __forceinline__ const Params& getp() {
    KParamsPtr kp = (KParamsPtr)__builtin_amdgcn_kernarg_segment_ptr();
    asm volatile("" : "+s"(kp));
    return *(const Params*)kp;
}
__device__ __forceinline__ void ph_rope(const Params& p) {
    for (int idx = blockIdx.x * 256 + ltid(); idx < T_ * 32; idx += gridDim.x * 256) {
        int t = idx >> 5, i = idx & 31;
        float ang = (float)p.positions[t] * INVF[i];
        double rev = (double)ang * 0.15915494309189535;
        double fr = rev - rint(rev);
        float r = (float)(fr * 6.283185307179586);
        f32x2 cs; cs.x = __cosf(r); cs.y = __sinf(r);
        ((f32x2*)(p.ws + OFF_ROPE))[idx] = cs;
    }
}

__device__ __forceinline__ void ph_mod(const Params& p, unsigned char* smem) {
    float* sc = (float*)smem;
    float* part = sc + 8 * 1024;
    const int tid = ltid();
    if ((int)blockIdx.x >= 192) return;
    __syncthreads();
    for (int i = tid; i < 8192; i += 256) sc[i] = siluf_(p.c[i]);
    __syncthreads();
    for (int it = blockIdx.x; it < 192; it += gridDim.x) {
        const int l = it / 96, jb = (it % 96) * 64;
        const int c4 = (tid & 15) * 4, kg = tid >> 4;
        f32x4 acc[8];
#pragma unroll
        for (int b = 0; b < 8; ++b) acc[b] = (f32x4){0.f, 0.f, 0.f, 0.f};
        const float* w = p.ada_w + (size_t)l * 1024 * 6144 + jb + c4;
#pragma unroll 4
        for (int k = kg * 64; k < kg * 64 + 64; ++k) {
            const f32x4 wv = *(const f32x4*)(w + (size_t)k * 6144);
#pragma unroll
            for (int b = 0; b < 8; ++b) acc[b] += wv * sc[b * 1024 + k];
        }
        if (kg >= 8) {
#pragma unroll
            for (int b = 0; b < 8; ++b) *(f32x4*)(part + ((kg - 8) * 8 + b) * 64 + c4) = acc[b];
        }
        __syncthreads();
        if (kg < 8) {
#pragma unroll
            for (int b = 0; b < 8; ++b) { f32x4* q = (f32x4*)(part + (kg * 8 + b) * 64 + c4); *q = *q + acc[b]; }
        }
        __syncthreads();
        {
            float* mod = (float*)(p.ws + OFF_MOD);
#pragma unroll
            for (int o = 0; o < 2; ++o) {
                const int idx = tid + 256 * o, b = idx >> 6, jj = idx & 63;
                float r = 0.f;
#pragma unroll
                for (int g = 0; g < 8; ++g) r += part[(g * 8 + b) * 64 + jj];
                mod[(size_t)(l * 8 + b) * 6144 + jb + jj] = r + p.ada_b[l * 6144 + jb + jj];
            }
        }
        __syncthreads();
    }
}

struct TJob {
    const float* src; bf16_t* dst;
    int K, NQ, src_ld, dst_ld, mode, p0, nbatch, pad;
    size_t src_bs, dst_bs;
};
__device__ __forceinline__ int tj_src_col(int mode, int p0, int q) {
    if (mode == 0) return q + p0;
    if (mode == 1) return q < 1092 ? q : (q < 1152 ? -1 : q - 60);
    if (mode == 2) return q;
    return q < 64 ? q : -1;
}
__device__ __forceinline__ int tj_dst_row(int mode, int p0, int q) {
    if (mode == 2) return (q >> 5) * 64 + p0 + (q & 31);
    return q;
}
__device__ __forceinline__ void tconv_load(const TJob& j, int it, int tid, f32x4 (&r)[4]) {
    const int nk = j.K / 64;
    const int per = (j.NQ / 64) * nk;
    const int b = it / per, rr = it % per, qt = rr / nk, kt = rr % nk;
    const float* src = j.src + (size_t)b * j.src_bs;
    const int tx4 = (tid & 15) * 4, ty = tid >> 4;
    const int sc = tj_src_col(j.mode, j.p0, qt * 64 + tx4);
#pragma unroll
    for (int i = 0; i < 4; ++i) {
        if (sc >= 0) r[i] = *(const f32x4*)(src + (size_t)(kt * 64 + ty + 16 * i) * j.src_ld + sc);
        else r[i] = (f32x4){0.f, 0.f, 0.f, 0.f};
    }
}
constexpr int TCS = 68;
__device__ __forceinline__ void tconv_put(int tid, const f32x4 (&r)[4], float* tile) {
    const int tx4 = (tid & 15) * 4, ty = tid >> 4;
#pragma unroll
    for (int i = 0; i < 4; ++i) {
        const int k = ty + 16 * i;
        *(f32x4*)(tile + k * TCS + (tx4 ^ (((k >> 4) & 1) * 16))) = r[i];
    }
}
__device__ __forceinline__ void tconv_emit(const TJob& j, int it, int tid, const float* tile) {
    const int nk = j.K / 64;
    const int per = (j.NQ / 64) * nk;
    const int b = it / per, rr = it % per, qt = rr / nk, kt = rr % nk;
    bf16_t* dst = j.dst + (size_t)b * j.dst_bs;
    const int nn = tid >> 2, kc = (tid & 3) * 16;
    const int dr = tj_dst_row(j.mode, j.p0, qt * 64 + nn);
    const int col = nn ^ (((kc >> 4) & 1) * 16);
    unsigned w[8];
#pragma unroll
    for (int i = 0; i < 8; ++i) w[i] = pack2(tile[(kc + 2 * i) * TCS + col], tile[(kc + 2 * i + 1) * TCS + col]);
    u32x4* d = (u32x4*)(dst + (size_t)dr * j.dst_ld + kt * 64 + kc);
    d[0] = (u32x4){w[0], w[1], w[2], w[3]};
    d[1] = (u32x4){w[4], w[5], w[6], w[7]};
}

__device__ __forceinline__ void ph_wcomp(const Params& p, int l, unsigned char* smem) {
    float (*row)[256] = (float (*)[256])smem;
    const int tid = ltid();
    for (int it = blockIdx.x; it < 512; it += gridDim.x) {
    const int k0 = it * 2;
    __syncthreads();
    {
        const int kk = tid >> 7, jj = tid & 127;
        const float* wi = p.w_in + ((size_t)l * 1024 + k0 + kk) * NIN_ + 512;
        row[kk][jj] = wi[jj] * p.g_kv[l * 256 + jj];
        row[kk][jj + 128] = wi[jj + 128] * p.g_kv[l * 256 + jj + 128];
    }
    __syncthreads();
    const int kk = tid >> 7, n = tid & 127;
    const float* wu = (n < 64) ? (p.w_uk + (size_t)l * 256 * 64 + n) : (p.w_uv + (size_t)l * 256 * 64 + (n - 64));
    float acc = 0.f;
    for (int jx = 0; jx < 256; ++jx) acc += row[kk][jx] * wu[jx * 64];
    bf16_t* WinT = (bf16_t*)(p.ws + OFF_WB) + WB_WIN;
    WinT[(size_t)(C_KA + n) * 1024 + k0 + kk] = f2bf(acc);
    }
}

struct NormArgs {
    const float* xin; const bf16_t* Y; const bf16_t* slots;
    const float* gpost; const float* gt;
    const float* gpre; const float* sc; const float* sh;
    int mode;
};
__device__ __forceinline__ void ph_norm(const Params& p, const NormArgs& a) {
    const int lane = ltid() & 63;
    for (int row = blockIdx.x * 4 + (ltid() >> 6); row < T_; row += gridDim.x * 4) {
    const int b = row >> 11;
    float* xo = p.out + (size_t)row * 1024;
    f32x4 xv[4];
    if (a.mode == 0) {
#pragma unroll
        for (int i = 0; i < 4; ++i) xv[i] = *(const f32x4*)(a.xin + (size_t)row * 1024 + i * 256 + lane * 4);
    } else {
        f32x4 yv[4];
        if (a.mode == 1) {
#pragma unroll
            for (int i = 0; i < 4; ++i) {
                u32x2 u = *(const u32x2*)(a.Y + (size_t)row * 1024 + i * 256 + lane * 4);
                yv[i][0] = __uint_as_float(u.x << 16); yv[i][1] = __uint_as_float(u.x & 0xffff0000u);
                yv[i][2] = __uint_as_float(u.y << 16); yv[i][3] = __uint_as_float(u.y & 0xffff0000u);
            }
        } else {
#pragma unroll
            for (int i = 0; i < 4; ++i) yv[i] = (f32x4){0.f, 0.f, 0.f, 0.f};
#pragma unroll
            for (int k = 0; k < 9; ++k) {
                const bf16_t* sp = a.slots + (k < 8 ? ((size_t)row * 8 + k) : ((size_t)8 * T_ + row)) * 1024;
#pragma unroll
                for (int i = 0; i < 4; ++i) {
                    u32x2 u = *(const u32x2*)(sp + i * 256 + lane * 4);
                    yv[i][0] += __uint_as_float(u.x << 16); yv[i][1] += __uint_as_float(u.x & 0xffff0000u);
                    yv[i][2] += __uint_as_float(u.y << 16); yv[i][3] += __uint_as_float(u.y & 0xffff0000u);
                }
            }
        }
        float ss = 0.f;
#pragma unroll
        for (int i = 0; i < 4; ++i) ss += yv[i][0] * yv[i][0] + yv[i][1] * yv[i][1] + yv[i][2] * yv[i][2] + yv[i][3] * yv[i][3];
        ss = wave_sum(ss);
        const float rs = rsqrtf(ss * (1.0f / 1024.0f) + EPS_);
#pragma unroll
        for (int i = 0; i < 4; ++i) {
            const int col = i * 256 + lane * 4;
            f32x4 xo4 = *(const f32x4*)(xo + col);
            f32x4 g4 = *(const f32x4*)(a.gpost + col);
            f32x4 gt4 = *(const f32x4*)(a.gt + (size_t)b * 6144 + col);
            xv[i] = xo4 + gt4 * (yv[i] * rs * g4);
        }
    }
#pragma unroll
    for (int i = 0; i < 4; ++i) *(f32x4*)(xo + i * 256 + lane * 4) = xv[i];
    if (a.gpre) {
        float ss = 0.f;
#pragma unroll
        for (int i = 0; i < 4; ++i) ss += xv[i][0] * xv[i][0] + xv[i][1] * xv[i][1] + xv[i][2] * xv[i][2] + xv[i][3] * xv[i][3];
        ss = wave_sum(ss);
        const float rs = rsqrtf(ss * (1.0f / 1024.0f) + EPS_);
        bf16_t* H = (bf16_t*)(p.ws + OFF_H) + (size_t)row * 1024;
#pragma unroll
        for (int i = 0; i < 4; ++i) {
            const int col = i * 256 + lane * 4;
            f32x4 g4 = *(const f32x4*)(a.gpre + col);
            f32x4 sc4 = *(const f32x4*)(a.sc + (size_t)b * 6144 + col);
            f32x4 sh4 = *(const f32x4*)(a.sh + (size_t)b * 6144 + col);
            f32x4 h = (xv[i] * rs * g4) * (sc4 + 1.0f) + sh4;
            u32x2 u; u.x = pack2(h[0], h[1]); u.y = pack2(h[2], h[3]);
            *(u32x2*)(H + col) = u;
        }
    }
    }
}

#define LAS __attribute__((address_space(3)))
constexpr int STG = 32768;
constexpr int MISC = 49152;
constexpr int DYN_LDS = 49152 + 1280;
__device__ __forceinline__ int stg_row(int tid, int i, int pieces) { return ((tid >> 6) * pieces + i) * 8 + ((tid & 63) >> 3); }
__device__ __forceinline__ int stg_chunk(int tid, int i) { return (tid & 7) ^ ((4 * i + ((tid & 63) >> 4)) & 7); }
template <int NW>
__device__ __forceinline__ void gemm_kloop2(f32x4 (&acc)[4][NW], const bf16_t* abase, const unsigned (&aoff)[4], const bf16_t* bbase, const unsigned (&boff)[NW], int K, unsigned char* smem, int tid) {
    const int lane = tid & 63, wid = __builtin_amdgcn_readfirstlane(tid >> 6), wr = wid >> 1, wc = wid & 1, fr = lane & 15, fq = lane >> 4;
    LAS unsigned char* lds = (LAS unsigned char*)smem;
    const int nt = K >> 6;
    const int offA = (wr * 64 + fr) * 128, offB = 16384 + (wc * (16 * NW) + fr) * 128;
    const int sw = fr >> 1;
    for (int t = 0; t < nt; ++t) {
        __syncthreads();
#pragma unroll
        for (int i = 0; i < 4; ++i) __builtin_amdgcn_global_load_lds((const unsigned*)(abase + aoff[i] + t * 64), (LAS unsigned*)(lds + (wid * 4 + i) * 1024), 16, 0, 0);
#pragma unroll
        for (int i = 0; i < NW; ++i) __builtin_amdgcn_global_load_lds((const unsigned*)(bbase + boff[i] + t * 64), (LAS unsigned*)(lds + 16384 + (wid * NW + i) * 1024), 16, 0, 0);
        asm volatile("s_waitcnt vmcnt(0)" ::: "memory");
        __syncthreads();
#pragma unroll
        for (int ks = 0; ks < 2; ++ks) {
            const int ch = ((ks * 4 + fq) ^ sw) << 4;
            bf16x8 af[4], bfv[NW];
#pragma unroll
            for (int m = 0; m < 4; ++m) af[m] = *(const LAS bf16x8*)(lds + offA + m * 2048 + ch);
#pragma unroll
            for (int n = 0; n < NW; ++n) bfv[n] = *(const LAS bf16x8*)(lds + offB + n * 2048 + ch);
            __builtin_amdgcn_s_setprio(1);
#pragma unroll
            for (int m = 0; m < 4; ++m)
#pragma unroll
                for (int n = 0; n < NW; ++n) acc[m][n] = __builtin_amdgcn_mfma_f32_16x16x32_bf16(af[m], bfv[n], acc[m][n], 0, 0, 0);
            __builtin_amdgcn_s_setprio(0);
        }
    }
}

constexpr int LDT = 72;
struct __attribute__((aligned(16))) GemmLds { bf16_t A[128 * LDT]; bf16_t B[128 * LDT]; };

template <int NW>
__device__ __forceinline__ void gemm_kloop(f32x4 (&acc)[4][NW], const bf16_t* const (&ap)[4], const bf16_t* const (&bp)[NW], int K,
                                           bf16_t* sA, bf16_t* sB, int tid) {
    const int lane = tid & 63, wid = __builtin_amdgcn_readfirstlane(tid >> 6), wr = wid >> 1, wc = wid & 1, fr = lane & 15, fq = lane >> 4;
    u32x4 ra[4], rb[NW];
#pragma unroll
    for (int i = 0; i < 4; ++i) ra[i] = *(const u32x4*)(ap[i]);
#pragma unroll
    for (int i = 0; i < NW; ++i) rb[i] = *(const u32x4*)(bp[i]);
    const int srow = tid >> 3, scol = (tid & 7) * 8;
    for (int k0 = 0; k0 < K; k0 += 64) {
        __syncthreads();
#pragma unroll
        for (int i = 0; i < 4; ++i) *(u32x4*)(sA + (srow + 32 * i) * LDT + scol) = ra[i];
#pragma unroll
        for (int i = 0; i < NW; ++i) *(u32x4*)(sB + (srow + 32 * i) * LDT + scol) = rb[i];
        __syncthreads();
        if (k0 + 64 < K) {
#pragma unroll
            for (int i = 0; i < 4; ++i) ra[i] = *(const u32x4*)(ap[i] + k0 + 64);
#pragma unroll
            for (int i = 0; i < NW; ++i) rb[i] = *(const u32x4*)(bp[i] + k0 + 64);
        }
#pragma unroll
        for (int ks = 0; ks < 2; ++ks) {
            bf16x8 af[4], bfv[NW];
#pragma unroll
            for (int m = 0; m < 4; ++m) af[m] = *(const bf16x8*)(sA + (wr * 64 + m * 16 + fr) * LDT + ks * 32 + fq * 8);
#pragma unroll
            for (int n = 0; n < NW; ++n) bfv[n] = *(const bf16x8*)(sB + (wc * (16 * NW) + n * 16 + fr) * LDT + ks * 32 + fq * 8);
#pragma unroll
            for (int m = 0; m < 4; ++m)
#pragma unroll
                for (int n = 0; n < NW; ++n) acc[m][n] = __builtin_amdgcn_mfma_f32_16x16x32_bf16(af[m], bfv[n], acc[m][n], 0, 0, 0);
        }
    }
}
template <int NW>
__device__ __forceinline__ void zero_acc(f32x4 (&acc)[4][NW]) {
#pragma unroll
    for (int m = 0; m < 4; ++m)
#pragma unroll
        for (int n = 0; n < NW; ++n) acc[m][n] = (f32x4){0.f, 0.f, 0.f, 0.f};
}

__device__ __forceinline__ void store_rope(const f32x4 (&acc)[4][4], bf16_t* dst, int ld, int dcol, float scale, const f32x2* rope, int rowbase, int fr, int fq) {
#pragma unroll
    for (int m = 0; m < 4; ++m)
#pragma unroll
        for (int j = 0; j < 4; ++j) {
            const int t = rowbase + m * 16 + fq * 4 + j;
#pragma unroll
            for (int nn = 0; nn < 2; ++nn) {
                const f32x2 cs = rope[(size_t)t * 32 + nn * 16 + fr];
                const float x1 = acc[m][nn][j], x2 = acc[m][nn + 2][j];
                dst[(size_t)t * ld + dcol + nn * 16 + fr] = f2bf((x1 * cs.x - x2 * cs.y) * scale);
                dst[(size_t)t * ld + dcol + (nn + 2) * 16 + fr] = f2bf((x2 * cs.x + x1 * cs.y) * scale);
            }
        }
}
__device__ __forceinline__ void store_plain(const f32x4 (&acc)[4][4], bf16_t* dst, int ld, int dcol, float scale, int act, int rowbase, int fr, int fq) {
#pragma unroll
    for (int m = 0; m < 4; ++m)
#pragma unroll
        for (int j = 0; j < 4; ++j) {
            const int t = rowbase + m * 16 + fq * 4 + j;
#pragma unroll
            for (int n = 0; n < 4; ++n) {
                float v = acc[m][n][j] * scale;
                if (act == 1) v = sigmoidf_(v);
                else if (act == 2) v = siluf_(v);
                dst[(size_t)t * ld + dcol + n * 16 + fr] = f2bf(v);
            }
        }
}
__device__ __forceinline__ void store_trans(const f32x4 (&acc)[4][4], bf16_t* dstT, int rows_per_b, int rowoff, int rowbase, int fr, int fq) {
#pragma unroll
    for (int m = 0; m < 4; ++m) {
        const int t = rowbase + m * 16 + fq * 4;
        const int b = t >> 11, s = t & 2047;
#pragma unroll
        for (int n = 0; n < 4; ++n) {
            u32x2 u; u.x = pack2(acc[m][n][0], acc[m][n][1]); u.y = pack2(acc[m][n][2], acc[m][n][3]);
            *(u32x2*)(dstT + ((size_t)b * rows_per_b + rowoff + n * 16 + fr) * 2048 + s) = u;
        }
    }
}

constexpr int LDE = 136;
template <int NW>
__device__ __forceinline__ void lds_put_tile(bf16_t* sT, const f32x4 (&acc)[4][NW], int wr, int wc, int fr, int fq) {
#pragma unroll
    for (int m = 0; m < 4; ++m)
#pragma unroll
        for (int j = 0; j < 4; ++j)
#pragma unroll
            for (int n = 0; n < NW; ++n) sT[(wr * 64 + m * 16 + fq * 4 + j) * LDE + wc * (16 * NW) + n * 16 + fr] = f2bf(acc[m][n][j]);
}
__device__ __forceinline__ void lds_put_tile_t(bf16_t* sT, const f32x4 (&acc)[4][4], int wr, int wc, int fr, int fq) {
#pragma unroll
    for (int m = 0; m < 4; ++m)
#pragma unroll
        for (int n = 0; n < 4; ++n) {
            u32x2 u; u.x = pack2(acc[m][n][0], acc[m][n][1]); u.y = pack2(acc[m][n][2], acc[m][n][3]);
            *(u32x2*)(sT + (wc * 64 + n * 16 + fr) * LDE + wr * 64 + m * 16 + fq * 4) = u;
        }
}
__device__ __forceinline__ void rope_acc(f32x4 (&acc)[4][4], float scale, const f32x2* rope, int rowbase, int fr, int fq) {
    const f32x2* rp = rope + (size_t)(rowbase + fq * 4) * 32 + fr;
#pragma unroll
    for (int m = 0; m < 4; ++m) {
#pragma unroll
        for (int j = 0; j < 4; ++j) {
#pragma unroll
            for (int nn = 0; nn < 2; ++nn) {
                const f32x2 cs = rp[(m * 16 + j) * 32 + nn * 16];
                const float cc = cs.x * scale, sn = cs.y * scale;
                const float x1 = acc[m][nn][j], x2 = acc[m][nn + 2][j];
                acc[m][nn][j] = __fmaf_rn(x1, cc, -(x2 * sn));
                acc[m][nn + 2][j] = __fmaf_rn(x2, cc, x1 * sn);
            }
            if (j & 1) __builtin_amdgcn_sched_barrier(0);
        }
    }
}
__device__ __forceinline__ void scale_act_acc(f32x4 (&acc)[4][4], float scale, int act) {
#pragma unroll
    for (int m = 0; m < 4; ++m)
#pragma unroll
        for (int n = 0; n < 4; ++n)
#pragma unroll
            for (int j = 0; j < 4; ++j) {
                float v = acc[m][n][j] * scale;
                if (act == 1) v = sigmoidf_(v);
                else if (act == 2) v = siluf_(v);
                acc[m][n][j] = v;
            }
}
struct SegDst { bf16_t* rm; int ld; int dcol; bf16_t* tr; int tr_rows; int tr_off; int kind; };
__device__ __forceinline__ SegDst seg_dst(unsigned char* r1, int c0) {
    SegDst d; d.rm = nullptr; d.ld = 0; d.dcol = 0; d.tr = nullptr; d.tr_rows = 0; d.tr_off = 0; d.kind = 0;
    if (c0 < C_CKV) { d.rm = (bf16_t*)(r1 + R1_QA); d.ld = 512; d.dcol = c0 - C_QA; d.kind = 1; }
    else if (c0 < C_IQ) { d.kind = 0; }
    else if (c0 < C_IK) { d.rm = (bf16_t*)(r1 + R1_IQ); d.ld = 256; d.dcol = c0 - C_IQ; d.kind = 1; }
    else if (c0 < C_IW) { d.rm = (bf16_t*)(r1 + R1_IK); d.ld = 64; d.dcol = 0; d.kind = 1; }
    else if (c0 < C_QB) { d.kind = 0; }
    else if (c0 < C_KB) { d.rm = (bf16_t*)(r1 + R1_QB); d.ld = 512; d.dcol = c0 - C_QB; d.kind = 1; }
    else if (c0 < C_VB) { d.rm = (bf16_t*)(r1 + R1_KB); d.ld = 512; d.dcol = c0 - C_KB; d.kind = 1; }
    else if (c0 < C_QC) { d.tr = (bf16_t*)(r1 + R1_VBT); d.tr_rows = 512; d.tr_off = c0 - C_VB; d.kind = 2; }
    else if (c0 < C_KC) { d.rm = (bf16_t*)(r1 + R1_QC); d.ld = 512; d.dcol = c0 - C_QC; d.kind = 1; }
    else if (c0 < C_VC) { d.rm = (bf16_t*)(r1 + R1_KC); d.ld = 512; d.dcol = c0 - C_KC; d.tr = (bf16_t*)(r1 + R1_KCT); d.tr_rows = 512; d.tr_off = c0 - C_KC; d.kind = 3; }
    else if (c0 < C_GC) { d.tr = (bf16_t*)(r1 + R1_VCT); d.tr_rows = 1024; d.tr_off = c0 - C_VC; d.kind = 2; }
    else if (c0 < C_GATES) { d.rm = (bf16_t*)(r1 + R1_GC); d.ld = 1024; d.dcol = c0 - C_GC; d.kind = 1; }
    else if (c0 < C_KA) { d.tr = (bf16_t*)(r1 + R1_GATES); d.tr_rows = 3072; d.tr_off = c0 - C_GATES; d.kind = 2; }
    else if (c0 < C_VA) { d.rm = (bf16_t*)(r1 + R1_KA); d.ld = 64; d.dcol = 0; d.kind = 1; }
    else { d.tr = (bf16_t*)(r1 + R1_VAT); d.tr_rows = 64; d.tr_off = 0; d.kind = 2; }
    return d;
}

__device__ __forceinline__ void ph_gemm_z(const Params& p, unsigned char* smem) {
    bf16_t* sT = (bf16_t*)smem;
    const int tid = ltid(), lane = tid & 63, wid = __builtin_amdgcn_readfirstlane(tid >> 6), wr = wid >> 1, wc = wid & 1, fr = lane & 15, fq = lane >> 4;
    const bf16_t* H = (const bf16_t*)(p.ws + OFF_H);
    const bf16_t* WinT = (const bf16_t*)(p.ws + OFF_WB) + WB_WIN;
    const int xcd = blockIdx.x & 7, jb = blockIdx.x >> 3, nper = gridDim.x >> 3;
    for (int q = jb; q < 1120; q += nper) {
        const int half = q / 560, rem = q % 560, nt = rem >> 3, mtl = rem & 7;
        const int mt = 16 * xcd + 8 * half + mtl;
        const int m0 = mt * 128, n0 = nt * 128;
        unsigned ao[4], bo[4];
#pragma unroll
        for (int i = 0; i < 4; ++i) {
            const int R = stg_row(tid, i, 4), g = stg_chunk(tid, i);
            ao[i] = (unsigned)(m0 + R) * 1024u + g * 8;
            bo[i] = (unsigned)(n0 + R) * 1024u + g * 8;
        }
        f32x4 acc[4][4];
        zero_acc<4>(acc);
        gemm_kloop2<4>(acc, H, ao, WinT, bo, 1024, smem, tid);
        int te = tid; asm volatile("" : "+v"(te));
        const int fre = te & 15, fqe = (te & 63) >> 4;
        const Params& pe = getp();
        unsigned char* r1 = pe.ws + OFF_R1;
        const f32x2* rope = (const f32x2*)(pe.ws + OFF_ROPE);
        const int c0 = n0 + wc * 64;
        const int rowbase = m0 + wr * 64;
        if (c0 < C_CKV) rope_acc(acc, 0.125f, rope, rowbase, fre, fqe);
        else if (c0 < C_IQ) {
            float* ss = (float*)(pe.ws + OFF_CKVSS);
            const int blk = (c0 - C_CKV) >> 6;
#pragma unroll
            for (int m = 0; m < 4; ++m)
#pragma unroll
                for (int j = 0; j < 4; ++j) {
                    float sq = 0.f;
#pragma unroll
                    for (int n = 0; n < 4; ++n) sq += acc[m][n][j] * acc[m][n][j];
                    sq += __shfl_xor(sq, 1); sq += __shfl_xor(sq, 2); sq += __shfl_xor(sq, 4); sq += __shfl_xor(sq, 8);
                    if (fre == 0) ss[(size_t)(rowbase + m * 16 + fqe * 4 + j) * 4 + blk] = sq;
                }
        }
        else if (c0 < C_IK) rope_acc(acc, 1.0f, rope, rowbase, fre, fqe);
        else if (c0 < C_IW) rope_acc(acc, 1.0f, rope, rowbase, fre, fqe);
        else if (c0 < C_QB) {
            float* iw = (float*)(pe.ws + OFF_IW);
            if (fre < 4) {
#pragma unroll
                for (int m = 0; m < 4; ++m)
#pragma unroll
                    for (int j = 0; j < 4; ++j) iw[(size_t)(rowbase + m * 16 + fqe * 4 + j) * 4 + fre] = acc[m][0][j] * 0.0625f;
            }
        }
        else if (c0 < C_KB) scale_act_acc(acc, 0.125f, 0);
        else if (c0 < C_QC) { }
        else if (c0 < C_KC) rope_acc(acc, 1.0f, rope, rowbase, fre, fqe);
        else if (c0 < C_VC) rope_acc(acc, 0.125f, rope, rowbase, fre, fqe);
        else if (c0 < C_GC) { }
        else if (c0 < C_GATES) scale_act_acc(acc, 1.0f, 2);
        else if (c0 < C_KA) scale_act_acc(acc, 1.0f, 1);
        else if (c0 < C_VA) rope_acc(acc, 1.0f, rope, rowbase, fre, fqe);
        const SegDst dw = seg_dst(r1, c0);
        const SegDst d0 = seg_dst(r1, n0), d1 = seg_dst(r1, n0 + 64);
        const int anyrm = (d0.kind | d1.kind) & 1, anytr = (d0.kind | d1.kind) & 2;
        __syncthreads();
        if (anyrm) {
            if (dw.kind & 1) lds_put_tile<4>(sT, acc, wr, wc, fre, fqe);
            __syncthreads();
#pragma unroll
            for (int hh = 0; hh < 2; ++hh) {
                const SegDst& d = hh ? d1 : d0;
                if (d.kind & 1) {
#pragma unroll
                    for (int i = 0; i < 4; ++i) {
                        const int c = te + 256 * i, row = c >> 3, ch = c & 7;
                        *(u32x4*)(d.rm + (size_t)(m0 + row) * d.ld + d.dcol + ch * 8) = *(const u32x4*)(sT + row * LDE + hh * 64 + ch * 8);
                    }
                }
            }
        }
        if (anytr) {
            __syncthreads();
            if (dw.kind & 2) lds_put_tile_t(sT, acc, wr, wc, fre, fqe);
            __syncthreads();
            const int b = m0 >> 11, s0 = m0 & 2047;
#pragma unroll
            for (int hh = 0; hh < 2; ++hh) {
                const SegDst& d = hh ? d1 : d0;
                if (d.kind & 2) {
#pragma unroll
                    for (int i = 0; i < 4; ++i) {
                        const int c = te + 256 * i, erow = c >> 4, ch = c & 15;
                        *(u32x4*)(d.tr + ((size_t)b * d.tr_rows + d.tr_off + erow) * 2048 + s0 + ch * 8) = *(const u32x4*)(sT + (hh * 64 + erow) * LDE + ch * 8);
                    }
                }
            }
        }
    }
}

struct __attribute__((aligned(16))) AttnLds { bf16_t K[64 * LDT]; bf16_t Vt[64 * LDT]; float rs[64]; };

__device__ __forceinline__ void tile64_load(u32x4 (&r)[2], const bf16_t* src, size_t src_ld, int tid) {
#pragma unroll
    for (int i = 0; i < 2; ++i) {
        const int c = tid + 256 * i, row = c >> 3, col8 = (c & 7) * 8;
        r[i] = *(const u32x4*)(src + (size_t)row * src_ld + col8);
    }
}
__device__ __forceinline__ void tile64_put(bf16_t* dst, const u32x4 (&r)[2], int tid) {
#pragma unroll
    for (int i = 0; i < 2; ++i) {
        const int c = tid + 256 * i, row = c >> 3, col8 = (c & 7) * 8;
        *(u32x4*)(dst + row * LDT + col8) = r[i];
    }
}
__device__ __forceinline__ void stage_tile64(bf16_t* dst, const bf16_t* src, size_t src_ld, int tid) {
#pragma unroll
    for (int i = 0; i < 2; ++i) {
        const int c = tid + 256 * i, row = c >> 3, col8 = (c & 7) * 8;
        *(u32x4*)(dst + row * LDT + col8) = *(const u32x4*)(src + (size_t)row * src_ld + col8);
    }
}

__device__ __forceinline__ void sb_tile(const AttnLds& sm, const bf16x8 (&qf)[2], f32x4 (&O)[4], float& R, bool diag, int tl, int fr, int fq) {
    f32x4 st[4];
#pragma unroll
    for (int mk = 0; mk < 4; ++mk) {
        st[mk] = (f32x4){0.f, 0.f, 0.f, 0.f};
#pragma unroll
        for (int ks = 0; ks < 2; ++ks) {
            bf16x8 kf = *(const bf16x8*)(sm.K + (mk * 16 + fr) * LDT + ks * 32 + fq * 8);
            st[mk] = __builtin_amdgcn_mfma_f32_16x16x32_bf16(kf, qf[ks], st[mk], 0, 0, 0);
        }
    }
    float Bv[4][4], Om[4][4], P[4];
#pragma unroll
    for (int mk = 0; mk < 4; ++mk) {
        P[mk] = 1.f;
#pragma unroll
        for (int r = 0; r < 4; ++r) {
            const float z = st[mk][r];
            const bool valid = !diag || (16 * mk + 4 * fq + r < tl);
            const float e = __expf(-fabsf(z));
            const float sg = __builtin_amdgcn_rcpf(1.0f + e);
            const float es = e * sg;
            const float beta = (z >= 0.f) ? sg : es, om = (z >= 0.f) ? es : sg;
            Bv[mk][r] = valid ? beta : 0.f;
            Om[mk][r] = valid ? om : 1.f;
            P[mk] *= Om[mk][r];
        }
    }
    float tot[4], above[4];
#pragma unroll
    for (int mk = 0; mk < 4; ++mk) {
        auto sw = __builtin_amdgcn_permlane16_swap(__float_as_uint(P[mk]), __float_as_uint(P[mk]), false, false);
        const float po = __uint_as_float(sw[1]);
        const float pair = __uint_as_float(sw[0]) * po;
        auto tw = __builtin_amdgcn_permlane32_swap(__float_as_uint(pair), __float_as_uint(pair), false, false);
        const float hi = __uint_as_float(tw[1]);
        tot[mk] = __uint_as_float(tw[0]) * hi;
        above[mk] = ((fq & 1) ? 1.f : po) * ((fq < 2) ? hi : 1.f);
    }
    float higher[4];
    higher[3] = 1.f; higher[2] = tot[3]; higher[1] = tot[3] * tot[2]; higher[0] = tot[3] * tot[2] * tot[1];
    float A[4][4];
#pragma unroll
    for (int mk = 0; mk < 4; ++mk) {
        float suf = above[mk] * higher[mk] * R;
#pragma unroll
        for (int r = 3; r >= 0; --r) {
            A[mk][r] = Bv[mk][r] * suf;
            suf *= Om[mk][r];
        }
    }
    R *= (tot[0] * tot[1]) * (tot[2] * tot[3]);
#pragma unroll
    for (int ks = 0; ks < 2; ++ks) {
        u32x4 uu = (u32x4){pack2(A[2 * ks][0], A[2 * ks][1]), pack2(A[2 * ks][2], A[2 * ks][3]),
                           pack2(A[2 * ks + 1][0], A[2 * ks + 1][1]), pack2(A[2 * ks + 1][2], A[2 * ks + 1][3])};
        bf16x8 pf = *(bf16x8*)&uu;
#pragma unroll
        for (int me = 0; me < 4; ++me) {
            const bf16_t* vp = sm.Vt + (me * 16 + fr) * LDT + ks * 32 + 4 * fq;
            u32x2 lo = *(const u32x2*)vp, hi = *(const u32x2*)(vp + 16);
            u32x4 vv = (u32x4){lo.x, lo.y, hi.x, hi.y};
            O[me] = __builtin_amdgcn_mfma_f32_16x16x32_bf16(*(bf16x8*)&vv, pf, O[me], 0, 0, 0);
        }
    }
}
__device__ __forceinline__ void mixb_item(const Params& p, int item, unsigned char* smem) {
    AttnLds& sm = *(AttnLds*)smem;
    const int tid = ltid(), lane = tid & 63, w = __builtin_amdgcn_readfirstlane(tid >> 6), fr = lane & 15, fq = lane >> 4;
    unsigned char* r1 = p.ws + OFF_R1;
    bf16_t* QB = (bf16_t*)(r1 + R1_QB);
    const bf16_t* KB = (const bf16_t*)(r1 + R1_KB);
    const bf16_t* VBT = (const bf16_t*)(r1 + R1_VBT);
    {
        const int qt2 = 15 - (item >> 6), bh = item & 63, b = bh >> 3, h = bh & 7;
        const int tl = 16 * w + fr;
        const int tq0 = b * 2048 + qt2 * 128 + tl, tq1 = tq0 + 64;
        bf16x8 qf0[2], qf1[2];
#pragma unroll
        for (int ks = 0; ks < 2; ++ks) {
            qf0[ks] = *(const bf16x8*)(QB + (size_t)tq0 * 512 + h * 64 + ks * 32 + fq * 8);
            qf1[ks] = *(const bf16x8*)(QB + (size_t)tq1 * 512 + h * 64 + ks * 32 + fq * 8);
        }
        f32x4 O0[4], O1[4];
#pragma unroll
        for (int me = 0; me < 4; ++me) { O0[me] = (f32x4){0.f, 0.f, 0.f, 0.f}; O1[me] = (f32x4){0.f, 0.f, 0.f, 0.f}; }
        float R0 = 1.f, R1 = 1.f;
        const int ktop = 2 * qt2 + 1;
        for (int kt = ktop; kt >= 0; --kt) {
            __syncthreads();
            stage_tile64(sm.K, KB + (size_t)(b * 2048 + kt * 64) * 512 + h * 64, 512, tid);
            stage_tile64(sm.Vt, VBT + ((size_t)(b * 8 + h) * 64) * 2048 + kt * 64, 2048, tid);
            __syncthreads();
            sb_tile(sm, qf1, O1, R1, kt == ktop, tl, fr, fq);
            if (kt < ktop) sb_tile(sm, qf0, O0, R0, kt == ktop - 1, tl, fr, fq);
        }
        const int ts = ltid();
        const int fqs = (ts & 63) >> 4;
        const int tqs0 = b * 2048 + qt2 * 128 + 16 * (ts >> 6) + (ts & 15), tqs1 = tqs0 + 64;
#pragma unroll
        for (int me = 0; me < 4; ++me) {
            u32x2 u; u.x = pack2(O0[me][0], O0[me][1]); u.y = pack2(O0[me][2], O0[me][3]);
            *(u32x2*)(QB + (size_t)tqs0 * 512 + h * 64 + me * 16 + 4 * fqs) = u;
            u32x2 v; v.x = pack2(O1[me][0], O1[me][1]); v.y = pack2(O1[me][2], O1[me][3]);
            *(u32x2*)(QB + (size_t)tqs1 * 512 + h * 64 + me * 16 + 4 * fqs) = v;
        }
    }
}

struct __attribute__((aligned(16))) RetLds { bf16_t K[64 * LDT]; bf16_t KT[64 * LDT]; bf16_t VT[128 * LDT]; bf16_t ST[128 * LDT]; };
struct __attribute__((aligned(16))) RetLds3 { bf16_t K[64 * LDT]; bf16_t VT[128 * LDT]; bf16_t ST[128 * LDT]; };

__device__ __forceinline__ void mixc1_item(const Params& p, int item, unsigned char* smem) {
    RetLds& sm = *(RetLds*)smem;
    const int tid = ltid(), lane = tid & 63, w = __builtin_amdgcn_readfirstlane(tid >> 6), fr = lane & 15, fq = lane >> 4;
    unsigned char* r1 = p.ws + OFF_R1;
    const bf16_t* KCT = (const bf16_t*)(r1 + R1_KCT);
    const bf16_t* VCT = (const bf16_t*)(r1 + R1_VCT);
    bf16_t* KVT = (bf16_t*)(p.ws + OFF_H);
    const int bh = item >> 5, n = item & 31, h = bh & 7;
    const float lg = LOGG[h];
    u32x4 rkt[2], rvt[4];
#pragma unroll
    for (int i = 0; i < 2; ++i) {
        const int c = tid + 256 * i, row = c >> 3, col8 = (c & 7) * 8;
        rkt[i] = *(const u32x4*)(KCT + ((size_t)bh * 64 + row) * 2048 + n * 64 + col8);
    }
#pragma unroll
    for (int i = 0; i < 4; ++i) {
        const int c = tid + 256 * i, row = c >> 3, col8 = (c & 7) * 8;
        rvt[i] = *(const u32x4*)(VCT + ((size_t)bh * 128 + row) * 2048 + n * 64 + col8);
    }
    __syncthreads();
#pragma unroll
    for (int i = 0; i < 2; ++i) {
        const int c = tid + 256 * i, row = c >> 3, col8 = (c & 7) * 8;
        unsigned uu[4] = {rkt[i].x, rkt[i].y, rkt[i].z, rkt[i].w};
#pragma unroll
        for (int q = 0; q < 4; ++q) {
            const float z0 = __expf(lg * (float)(63 - (col8 + 2 * q))), z1 = __expf(lg * (float)(63 - (col8 + 2 * q + 1)));
            uu[q] = pack2(__uint_as_float(uu[q] << 16) * z0, __uint_as_float(uu[q] & 0xffff0000u) * z1);
        }
        *(u32x4*)(sm.KT + row * LDT + col8) = (u32x4){uu[0], uu[1], uu[2], uu[3]};
    }
#pragma unroll
    for (int i = 0; i < 4; ++i) {
        const int c = tid + 256 * i, row = c >> 3, col8 = (c & 7) * 8;
        *(u32x4*)(sm.VT + row * LDT + col8) = rvt[i];
    }
    __syncthreads();
    f32x4 sacc[4][2];
#pragma unroll
    for (int md = 0; md < 4; ++md)
#pragma unroll
        for (int ne = 0; ne < 2; ++ne) sacc[md][ne] = (f32x4){0.f, 0.f, 0.f, 0.f};
#pragma unroll
    for (int ks = 0; ks < 2; ++ks) {
        bf16x8 vf[2];
#pragma unroll
        for (int ne = 0; ne < 2; ++ne) vf[ne] = *(const bf16x8*)(sm.VT + (32 * w + ne * 16 + fr) * LDT + ks * 32 + fq * 8);
#pragma unroll
        for (int md = 0; md < 4; ++md) {
            bf16x8 kf = *(const bf16x8*)(sm.KT + (md * 16 + fr) * LDT + ks * 32 + fq * 8);
#pragma unroll
            for (int ne = 0; ne < 2; ++ne) sacc[md][ne] = __builtin_amdgcn_mfma_f32_16x16x32_bf16(kf, vf[ne], sacc[md][ne], 0, 0, 0);
        }
    }
    bf16_t* dst = KVT + (size_t)item * 128 * 64;
#pragma unroll
    for (int md = 0; md < 4; ++md)
#pragma unroll
        for (int ne = 0; ne < 2; ++ne) {
            u32x2 u; u.x = pack2(sacc[md][ne][0], sacc[md][ne][1]); u.y = pack2(sacc[md][ne][2], sacc[md][ne][3]);
            *(u32x2*)(dst + (32 * w + ne * 16 + fr) * 64 + md * 16 + 4 * fq) = u;
        }
}
__device__ __forceinline__ void ph_mixc2(const Params& p) {
    bf16_t* KVT = (bf16_t*)(p.ws + OFF_H);
    for (int idx = blockIdx.x * 256 + ltid(); idx < 64 * 128 * 16; idx += gridDim.x * 256) {
        const int bh = idx >> 11, ed = idx & 2047;
        const float g64 = __expf(LOGG[bh & 7] * 64.0f);
        bf16_t* pp = KVT + (size_t)bh * 32 * 8192 + (size_t)ed * 4;
        float s0 = 0.f, s1 = 0.f, s2 = 0.f, s3 = 0.f;
#pragma unroll 4
        for (int n = 0; n < 32; ++n) {
            u32x2 kv = *(const u32x2*)(pp + (size_t)n * 8192);
            u32x2 o; o.x = pack2(s0, s1); o.y = pack2(s2, s3);
            *(u32x2*)(pp + (size_t)n * 8192) = o;
            s0 = s0 * g64 + __uint_as_float(kv.x << 16); s1 = s1 * g64 + __uint_as_float(kv.x & 0xffff0000u);
            s2 = s2 * g64 + __uint_as_float(kv.y << 16); s3 = s3 * g64 + __uint_as_float(kv.y & 0xffff0000u);
        }
    }
}
__device__ __forceinline__ void mixc3_item(const Params& p, int l, int item, unsigned char* smem) {
    RetLds3& sm = *(RetLds3*)smem;
    const int tid = ltid(), lane = tid & 63, w = __builtin_amdgcn_readfirstlane(tid >> 6), fr = lane & 15, fq = lane >> 4;
    unsigned char* r1 = p.ws + OFF_R1;
    const bf16_t* QC = (const bf16_t*)(r1 + R1_QC);
    const bf16_t* KC = (const bf16_t*)(r1 + R1_KC);
    const bf16_t* VCT = (const bf16_t*)(r1 + R1_VCT);
    const bf16_t* KVT = (const bf16_t*)(p.ws + OFF_H);
    bf16_t* GC = (bf16_t*)(r1 + R1_GC);
    {
        const int bh = item >> 5, n = item & 31, b = bh >> 3, h = bh & 7;
        const float lg = LOGG[h];
        const int al = 16 * w + fr;
        const float xi = __expf(lg * (float)(al + 1));
        {
            const int tok0 = b * 2048 + n * 64;
            u32x4 rk[2], rvt[4], rst[4];
            bf16x8 qf[2];
#pragma unroll
            for (int ks = 0; ks < 2; ++ks) qf[ks] = *(const bf16x8*)(QC + (size_t)(tok0 + 16 * w + fr) * 512 + h * 64 + ks * 32 + fq * 8);
            tile64_load(rk, KC + (size_t)tok0 * 512 + h * 64, 512, tid);
#pragma unroll
            for (int i = 0; i < 4; ++i) {
                const int c = tid + 256 * i, row = c >> 3, col8 = (c & 7) * 8;
                rvt[i] = *(const u32x4*)(VCT + ((size_t)bh * 128 + row) * 2048 + n * 64 + col8);
                rst[i] = *(const u32x4*)(KVT + (size_t)item * 8192 + row * 64 + col8);
            }
            __syncthreads();
            tile64_put(sm.K, rk, tid);
#pragma unroll
            for (int i = 0; i < 4; ++i) {
                const int c = tid + 256 * i, row = c >> 3, col8 = (c & 7) * 8;
                *(u32x4*)(sm.VT + row * LDT + col8) = rvt[i];
                *(u32x4*)(sm.ST + row * LDT + col8) = rst[i];
            }
            __syncthreads();
            f32x4 st[4];
#pragma unroll
            for (int mc = 0; mc < 4; ++mc) {
                st[mc] = (f32x4){0.f, 0.f, 0.f, 0.f};
#pragma unroll
                for (int ks = 0; ks < 2; ++ks) {
                    bf16x8 kf = *(const bf16x8*)(sm.K + (mc * 16 + fr) * LDT + ks * 32 + fq * 8);
                    st[mc] = __builtin_amdgcn_mfma_f32_16x16x32_bf16(kf, qf[ks], st[mc], 0, 0, 0);
                }
#pragma unroll
                for (int r = 0; r < 4; ++r) {
                    const int cc = 16 * mc + 4 * fq + r;
                    st[mc][r] *= __expf(lg * fabsf((float)(al - cc)));
                }
            }
            f32x4 o[8];
#pragma unroll
            for (int me = 0; me < 8; ++me) {
                o[me] = (f32x4){0.f, 0.f, 0.f, 0.f};
#pragma unroll
                for (int ks = 0; ks < 2; ++ks) {
                    bf16x8 sf = *(const bf16x8*)(sm.ST + (me * 16 + fr) * LDT + ks * 32 + fq * 8);
                    o[me] = __builtin_amdgcn_mfma_f32_16x16x32_bf16(sf, qf[ks], o[me], 0, 0, 0);
                }
                o[me] *= xi;
            }
#pragma unroll
            for (int ks = 0; ks < 2; ++ks) {
                bf16x8 pf;
                {
                    u32x4 uu = (u32x4){pack2(st[2 * ks][0], st[2 * ks][1]), pack2(st[2 * ks][2], st[2 * ks][3]),
                                          pack2(st[2 * ks + 1][0], st[2 * ks + 1][1]), pack2(st[2 * ks + 1][2], st[2 * ks + 1][3])};
                    pf = *(bf16x8*)&uu;
                }
#pragma unroll
                for (int me = 0; me < 8; ++me) {
                    const bf16_t* vp = sm.VT + (me * 16 + fr) * LDT + ks * 32 + 4 * fq;
                    u32x2 lo = *(const u32x2*)vp, hi = *(const u32x2*)(vp + 16);
                    u32x4 vv = (u32x4){lo.x, lo.y, hi.x, hi.y};
                    o[me] = __builtin_amdgcn_mfma_f32_16x16x32_bf16(*(bf16x8*)&vv, pf, o[me], 0, 0, 0);
                }
            }
            {
                float s1 = 0.f;
#pragma unroll
                for (int me = 0; me < 8; ++me) s1 += (o[me][0] + o[me][1]) + (o[me][2] + o[me][3]);
                s1 = xrow16_sum(s1);
                const float mu = s1 * (1.0f / 128.0f);
                float s2 = 0.f;
#pragma unroll
                for (int me = 0; me < 8; ++me)
#pragma unroll
                    for (int r = 0; r < 4; ++r) { const float d = o[me][r] - mu; s2 += d * d; }
                s2 = xrow16_sum(s2);
                const float rstd = rsqrtf(s2 * (1.0f / 128.0f) + EPS_);
                bf16_t* gp = GC + (size_t)(tok0 + al) * 1024 + h * 128;
                const float* gr = p.g_ret + (size_t)l * 1024 + h * 128;
#pragma unroll
                for (int me = 0; me < 8; ++me) {
                    const int e0 = me * 16 + 4 * fq;
                    u32x2 gu = *(const u32x2*)(gp + e0);
                    f32x4 g4 = *(const f32x4*)(gr + e0);
                    const float y0 = (o[me][0] - mu) * rstd * g4[0] * __uint_as_float(gu.x << 16);
                    const float y1 = (o[me][1] - mu) * rstd * g4[1] * __uint_as_float(gu.x & 0xffff0000u);
                    const float y2 = (o[me][2] - mu) * rstd * g4[2] * __uint_as_float(gu.y << 16);
                    const float y3 = (o[me][3] - mu) * rstd * g4[3] * __uint_as_float(gu.y & 0xffff0000u);
                    u32x2 ou; ou.x = pack2(y0, y1); ou.y = pack2(y2, y3);
                    *(u32x2*)(gp + e0) = ou;
                }
            }
        }
    }
}

__device__ __forceinline__ void mixa1_item(const Params& p, int item, unsigned char* smem) {
    float* tau_s = (float*)smem;
    int* stau_s = (int*)(smem + 64);
    const int tid = ltid(), lane = tid & 63, w = __builtin_amdgcn_readfirstlane(tid >> 6), fr = lane & 15, fq = lane >> 4;
    unsigned char* r1 = p.ws + OFF_R1;
    const bf16_t* IQ = (const bf16_t*)(r1 + R1_IQ);
    const bf16_t* IK = (const bf16_t*)(r1 + R1_IK);
    const float* IW = (const float*)(p.ws + OFF_IW);
    float* SC = (float*)(p.ws + OFF_R3);
    unsigned long long* MASKB = (unsigned long long*)(p.ws + OFF_MASKB);
    {
        const int c = 31 - (item >> 5), b = (item >> 2) & 7, qq = item & 3;
        __syncthreads();
        const int nj = c + 1, n = 64 * nj;
        const int tq = b * 2048 + c * 64 + 16 * qq + fr;
        float* scrow = SC + (size_t)b * SC_PER_BATCH + (size_t)2048 * c * (c + 1) + (size_t)(16 * qq + fr) * n;
        bf16x8 iqf[4][2];
        float iw[4];
#pragma unroll
        for (int hh = 0; hh < 4; ++hh) {
            iw[hh] = IW[(size_t)tq * 4 + hh];
#pragma unroll
            for (int ks = 0; ks < 2; ++ks) iqf[hh][ks] = *(const bf16x8*)(IQ + (size_t)tq * 256 + hh * 64 + ks * 32 + fq * 8);
        }
        for (int kt = w; kt < nj; kt += 4) {
            bf16x8 ikf[4][2];
#pragma unroll
            for (int mk = 0; mk < 4; ++mk)
#pragma unroll
                for (int ks = 0; ks < 2; ++ks) ikf[mk][ks] = *(const bf16x8*)(IK + (size_t)(b * 2048 + kt * 64 + mk * 16 + fr) * 64 + ks * 32 + fq * 8);
            f32x4 sc[4];
#pragma unroll
            for (int mk = 0; mk < 4; ++mk) sc[mk] = (f32x4){0.f, 0.f, 0.f, 0.f};
#pragma unroll
            for (int hh = 0; hh < 4; ++hh) {
#pragma unroll
                for (int mk = 0; mk < 4; ++mk) {
                    f32x4 a = (f32x4){0.f, 0.f, 0.f, 0.f};
#pragma unroll
                    for (int ks = 0; ks < 2; ++ks) a = __builtin_amdgcn_mfma_f32_16x16x32_bf16(ikf[mk][ks], iqf[hh][ks], a, 0, 0, 0);
#pragma unroll
                    for (int r = 0; r < 4; ++r) sc[mk][r] = __fmaf_rn(iw[hh], fmaxf(a[r], 0.f), sc[mk][r]);
                }
            }
#pragma unroll
            for (int mk = 0; mk < 4; ++mk) *(f32x4*)(scrow + kt * 64 + 16 * mk + 4 * fq) = sc[mk];
        }
        __syncthreads();
        for (int i = 0; i < 4; ++i) {
            const int r16 = 4 * w + i;
            float tau = -__builtin_inff();
            int stau = 1 << 30;
            if (nj > 4) {
                const float* rowp = SC + (size_t)b * SC_PER_BATCH + (size_t)2048 * c * (c + 1) + (size_t)(16 * qq + r16) * n;
                unsigned key[32];
#pragma unroll
                for (int j = 0; j < 32; ++j) key[j] = __float_as_uint(rowp[j * 64 + lane]);
#pragma unroll
                for (int j = 0; j < 32; ++j) {
                    const unsigned u = key[j];
                    const unsigned k = u ^ ((unsigned)((int)u >> 31) | 0x80000000u);
                    key[j] = (j < nj) ? k : 0u;
                }
                unsigned X = 0u;
                for (int bit = 31; bit >= 0; --bit) {
                    const unsigned cand = X | (1u << bit);
                    int cnt = 0;
                    int c0 = 0, c1 = 0;
#pragma unroll
                    for (int j = 0; j < 32; j += 4) {
                        if (j < nj) {
                            c0 = cnt_ge(c0, key[j], cand); c1 = cnt_ge(c1, key[j + 1], cand);
                            c0 = cnt_ge(c0, key[j + 2], cand); c1 = cnt_ge(c1, key[j + 3], cand);
                        }
                    }
                    cnt = wave_total6(c0 + c1);
                    if (cnt >= 256) X = cand;
                    if (cnt == 256) break;
                }
                int cgt = 0;
                {
                    const unsigned candp = X + 1u;
                    int c0 = 0, c1 = 0;
#pragma unroll
                    for (int j = 0; j < 32; j += 2) { c0 = cnt_ge(c0, key[j], candp); c1 = cnt_ge(c1, key[j + 1], candp); }
                    cgt = wave_total6(c0 + c1);
                }
                const int need = 256 - cgt;
                unsigned eqbits = 0u;
#pragma unroll
                for (int j = 0; j < 32; ++j) {
                    const unsigned ne = min(key[j] ^ X, 1u);
                    eqbits |= (1u - ne) << j;
                }
                const int teq = wave_sum_i(__popc(eqbits));
                if (teq == need) {
                    stau = 1 << 30;
                } else {
                    int lo = 0, hi = n - 1;
                    while (lo < hi) {
                        const int mid = (lo + hi) >> 1;
                        const int jmax = (mid - lane) >> 6;
                        const unsigned msk = jmax < 0 ? 0u : (jmax >= 31 ? 0xffffffffu : ((2u << jmax) - 1u));
                        const int cc = wave_sum_i(__popc(eqbits & msk));
                        if (cc >= need) hi = mid; else lo = mid + 1;
                    }
                    stau = lo;
                }
                const unsigned ux = (X & 0x80000000u) ? (X & 0x7fffffffu) : ~X;
                tau = __uint_as_float(ux);
            }
            if (lane == 0) { tau_s[r16] = tau; stau_s[r16] = stau; }
        }
        __syncthreads();
        {
            const float tau = tau_s[fr];
            const int stau = stau_s[fr];
            for (int kt = w; kt < nj; kt += 4) {
                unsigned lo = 0u, hi = 0u;
#pragma unroll
                for (int mk = 0; mk < 4; ++mk) {
                    const f32x4 v = *(const f32x4*)(scrow + kt * 64 + 16 * mk + 4 * fq);
#pragma unroll
                    for (int r = 0; r < 4; ++r) {
                        const int kl = 16 * mk + 4 * fq + r;
                        const bool sel = (v[r] > tau) || (v[r] == tau && (kt * 64 + kl) <= stau);
                        if (sel) { if (mk < 2) lo |= 1u << kl; else hi |= 1u << (kl - 32); }
                    }
                }
                lo |= __shfl_xor(lo, 16); lo |= __shfl_xor(lo, 32);
                hi |= __shfl_xor(hi, 16); hi |= __shfl_xor(hi, 32);
                if (fq == 0) MASKB[(size_t)tq * 32 + kt] = ((unsigned long long)hi << 32) | lo;
            }
        }
        __syncthreads();
    }
}

__device__ __forceinline__ void a2_tile(const unsigned char* sK, const unsigned char* sV, const float* srs, const bf16x8 (&qf)[2], f32x4 (&O)[4], float& mrun, float& lrun, unsigned long long W, int fr, int fq) {
    f32x4 st[4];
    float mx = -1e30f;
    f32x4 rsv[4];
    const int sw = (fr >> 1) & 7;
#pragma unroll
    for (int mk = 0; mk < 4; ++mk) {
        st[mk] = (f32x4){0.f, 0.f, 0.f, 0.f};
#pragma unroll
        for (int ks = 0; ks < 2; ++ks) {
            bf16x8 kf = *(const bf16x8*)(sK + (mk * 16 + fr) * 128 + (((ks * 4 + fq) ^ sw) << 4));
            st[mk] = __builtin_amdgcn_mfma_f32_16x16x32_bf16(kf, qf[ks], st[mk], 0, 0, 0);
        }
        rsv[mk] = *(const f32x4*)(srs + 16 * mk + 4 * fq);
        const unsigned nib = (unsigned)(W >> (16 * mk + 4 * fq)) & 0xfu;
#pragma unroll
        for (int r = 0; r < 4; ++r) {
            st[mk][r] *= rsv[mk][r];
            if ((nib >> r) & 1u) mx = fmaxf(mx, st[mk][r]);
        }
    }
    mx = xrow16_max(mx);
    const float mnew = fmaxf(mrun, mx);
    const float alpha = __expf(mrun - mnew);
    float ps = 0.f;
    float P[4][4];
#pragma unroll
    for (int mk = 0; mk < 4; ++mk) {
        const unsigned nib = (unsigned)(W >> (16 * mk + 4 * fq)) & 0xfu;
#pragma unroll
        for (int r = 0; r < 4; ++r) {
            const float pv = ((nib >> r) & 1u) ? __expf(st[mk][r] - mnew) : 0.f;
            ps += pv;
            P[mk][r] = pv * rsv[mk][r];
        }
    }
    ps = xrow16_sum(ps);
    lrun = lrun * alpha + ps;
    mrun = mnew;
#pragma unroll
    for (int me = 0; me < 4; ++me) O[me] *= alpha;
#pragma unroll
    for (int ks = 0; ks < 2; ++ks) {
        u32x4 uu = (u32x4){pack2(P[2 * ks][0], P[2 * ks][1]), pack2(P[2 * ks][2], P[2 * ks][3]),
                           pack2(P[2 * ks + 1][0], P[2 * ks + 1][1]), pack2(P[2 * ks + 1][2], P[2 * ks + 1][3])};
        bf16x8 pf = *(bf16x8*)&uu;
        const int ca = ((ks * 4 + (fq >> 1)) ^ sw) << 4, hb8 = (fq & 1) * 8;
#pragma unroll
        for (int me = 0; me < 4; ++me) {
            const unsigned char* vp = sV + (me * 16 + fr) * 128 + hb8;
            u32x2 lo = *(const u32x2*)(vp + ca), hi = *(const u32x2*)(vp + (ca ^ 32));
            u32x4 vv = (u32x4){lo.x, lo.y, hi.x, hi.y};
            O[me] = __builtin_amdgcn_mfma_f32_16x16x32_bf16(*(bf16x8*)&vv, pf, O[me], 0, 0, 0);
        }
    }
}
__device__ __forceinline__ void glds_tile64(unsigned char* dst, const bf16_t* src, size_t src_ld, int tid) {
    const int lane = tid & 63, wid = __builtin_amdgcn_readfirstlane(tid >> 6);
#pragma unroll
    for (int j = 0; j < 2; ++j) {
        const int i = wid * 2 + j, row = 8 * i + (lane >> 3), c = (lane & 7) ^ ((4 * i + (lane >> 4)) & 7);
        __builtin_amdgcn_global_load_lds((const unsigned*)(src + (size_t)row * src_ld + c * 8), (LAS unsigned*)(LAS unsigned char*)(dst + i * 1024), 16, 0, 0);
    }
}
constexpr int A2_STG = 8192 + 8192 + 256;
__device__ __forceinline__ int next_item(int* ctr, unsigned char* smem);
__device__ __forceinline__ void ph_mix_a2(const Params& p, int l, unsigned char* smem) {
    const int tid = ltid(), lane = tid & 63, w = __builtin_amdgcn_readfirstlane(tid >> 6), fr = lane & 15, fq = lane >> 4;
    unsigned char* r1 = p.ws + OFF_R1;
    bf16_t* QA = (bf16_t*)(r1 + R1_QA);
    const bf16_t* KA = (const bf16_t*)(r1 + R1_KA);
    const bf16_t* VAT = (const bf16_t*)(r1 + R1_VAT);
    const float* RS = (const float*)(p.ws + OFF_RS);
    const unsigned long long* MASKB = (const unsigned long long*)(p.ws + OFF_MASKB);
    int* a2ctr = (int*)(p.ws + OFF_CTL) + 272 + l * 4;
    for (;;) {
        const int item = next_item(a2ctr, smem);
        if (item >= 1024) break;
        const int c = 31 - (item >> 5), b = (item >> 2) & 7, h0 = (item & 3) * 2;
        const int tq = b * 2048 + c * 64 + 16 * w + fr;
        bf16x8 qf0[2], qf1[2];
#pragma unroll
        for (int ks = 0; ks < 2; ++ks) {
            qf0[ks] = *(const bf16x8*)(QA + (size_t)tq * 512 + h0 * 64 + ks * 32 + fq * 8);
            qf1[ks] = *(const bf16x8*)(QA + (size_t)tq * 512 + (h0 + 1) * 64 + ks * 32 + fq * 8);
        }
        f32x4 O0[4], O1[4];
#pragma unroll
        for (int me = 0; me < 4; ++me) { O0[me] = (f32x4){0.f, 0.f, 0.f, 0.f}; O1[me] = (f32x4){0.f, 0.f, 0.f, 0.f}; }
        float m0r = -1e30f, l0r = 0.f, m1r = -1e30f, l1r = 0.f;
        __syncthreads();
        glds_tile64(smem, KA + (size_t)(b * 2048) * 64, 64, tid);
        glds_tile64(smem + 8192, VAT + ((size_t)b * 64) * 2048, 2048, tid);
        float rsn = RS[b * 2048 + (tid & 63)];
        unsigned long long W = MASKB[(size_t)tq * 32];
        for (int kt = 0; kt <= c; ++kt) {
            unsigned char* cur = smem + (kt & 1) * A2_STG;
            unsigned char* nxt = smem + ((kt & 1) ^ 1) * A2_STG;
            asm volatile("s_waitcnt vmcnt(0)" ::: "memory");
            if (tid < 64) ((float*)(cur + 16384))[tid] = rsn;
            __syncthreads();
            unsigned long long Wn = 0ull;
            if (kt < c) {
                glds_tile64(nxt, KA + (size_t)(b * 2048 + (kt + 1) * 64) * 64, 64, tid);
                glds_tile64(nxt + 8192, VAT + ((size_t)b * 64) * 2048 + (kt + 1) * 64, 2048, tid);
                rsn = RS[b * 2048 + (kt + 1) * 64 + (tid & 63)];
                Wn = MASKB[(size_t)tq * 32 + kt + 1];
            }
            a2_tile(cur, cur + 8192, (const float*)(cur + 16384), qf0, O0, m0r, l0r, W, fr, fq);
            __builtin_amdgcn_sched_barrier(0);
            a2_tile(cur, cur + 8192, (const float*)(cur + 16384), qf1, O1, m1r, l1r, W, fr, fq);
            W = Wn;
        }
        const float inv0 = 1.0f / l0r, inv1 = 1.0f / l1r;
        const int ts = ltid();
        const int fqs = (ts & 63) >> 4;
        const int tqs = b * 2048 + c * 64 + 16 * (ts >> 6) + (ts & 15);
#pragma unroll
        for (int me = 0; me < 4; ++me) {
            u32x2 u; u.x = pack2(O0[me][0] * inv0, O0[me][1] * inv0); u.y = pack2(O0[me][2] * inv0, O0[me][3] * inv0);
            *(u32x2*)(QA + (size_t)tqs * 512 + h0 * 64 + me * 16 + 4 * fqs) = u;
            u32x2 v; v.x = pack2(O1[me][0] * inv1, O1[me][1] * inv1); v.y = pack2(O1[me][2] * inv1, O1[me][3] * inv1);
            *(u32x2*)(QA + (size_t)tqs * 512 + (h0 + 1) * 64 + me * 16 + 4 * fqs) = v;
        }
    }
}

__device__ __forceinline__ void ph_merge(const Params& p, unsigned char* smem) {
    bf16_t* sT = (bf16_t*)smem;
    const int tid = ltid(), lane = tid & 63, wid = __builtin_amdgcn_readfirstlane(tid >> 6), wr = wid >> 1, wc = wid & 1, fr = lane & 15, fq = lane >> 4;
    unsigned char* r1 = p.ws + OFF_R1;
    const bf16_t* WB = (const bf16_t*)(p.ws + OFF_WB);
    const bf16_t* GATES = (const bf16_t*)(r1 + R1_GATES);
    bf16_t* MG = (bf16_t*)(p.ws + OFF_H);
    const int xcd = blockIdx.x & 7, jb = blockIdx.x >> 3, nper = gridDim.x >> 3;
    for (int q = jb; q < 256; q += nper) {
        const int nt = q >> 4, mtl = q & 15;
        const int mt = 16 * xcd + mtl, m0 = mt * 128, n0 = nt * 64;
        f32x4 macc[4][2];
        zero_acc<2>(macc);
#pragma unroll 1
        for (int br = 0; br < 3; ++br) {
            const bf16_t* A = (const bf16_t*)(r1 + (br == 0 ? R1_QA : (br == 1 ? R1_QB : R1_GC)));
            const int K = (br == 2) ? 1024 : 512;
            const bf16_t* Bt = WB + (br == 0 ? WB_WOA : (br == 1 ? WB_WOB : WB_WOC));
            unsigned ao[4], bo[2];
#pragma unroll
            for (int i = 0; i < 4; ++i) ao[i] = (unsigned)(m0 + stg_row(tid, i, 4)) * (unsigned)K + stg_chunk(tid, i) * 8;
#pragma unroll
            for (int i = 0; i < 2; ++i) bo[i] = (unsigned)(n0 + stg_row(tid, i, 2)) * (unsigned)K + stg_chunk(tid, i) * 8;
            f32x4 acc[4][2];
            zero_acc<2>(acc);
            gemm_kloop2<2>(acc, A, ao, Bt, bo, K, smem, tid);
            {
                const int bb = m0 >> 11, s0 = (m0 & 2047) + wr * 64 + fq * 4;
#pragma unroll
                for (int n = 0; n < 2; ++n) {
                    const bf16_t* gp = GATES + ((size_t)bb * 3072 + br * 1024 + n0 + wc * 32 + n * 16 + fr) * 2048 + s0;
#pragma unroll
                    for (int m = 0; m < 4; ++m) {
                        const u32x2 gu = *(const u32x2*)(gp + m * 16);
                        macc[m][n][0] += __uint_as_float(gu.x << 16) * acc[m][n][0];
                        macc[m][n][1] += __uint_as_float(gu.x & 0xffff0000u) * acc[m][n][1];
                        macc[m][n][2] += __uint_as_float(gu.y << 16) * acc[m][n][2];
                        macc[m][n][3] += __uint_as_float(gu.y & 0xffff0000u) * acc[m][n][3];
                    }
                }
            }
        }
        __syncthreads();
        lds_put_tile<2>(sT, macc, wr, wc, fr, fq);
        __syncthreads();
#pragma unroll
        for (int i = 0; i < 4; ++i) {
            const int c = tid + 256 * i, row = c >> 3, ch = c & 7;
            *(u32x4*)(MG + (size_t)(m0 + row) * 1024 + n0 + ch * 8) = *(const u32x4*)(sT + row * LDE + ch * 8);
        }
    }
}

__device__ __forceinline__ void ph_outproj(const Params& p, unsigned char* smem) {
    bf16_t* sT = (bf16_t*)smem;
    const int tid = ltid(), lane = tid & 63, wid = __builtin_amdgcn_readfirstlane(tid >> 6), wr = wid >> 1, wc = wid & 1, fr = lane & 15, fq = lane >> 4;
    const bf16_t* MG = (const bf16_t*)(p.ws + OFF_H);
    const bf16_t* Bt = (const bf16_t*)(p.ws + OFF_WB) + WB_WOUT;
    bf16_t* Y = (bf16_t*)(p.ws + OFF_R1 + R1_QC);
    for (int tile = blockIdx.x; tile < 128 * 8; tile += gridDim.x) {
        const int mt = tile >> 3, nt = tile & 7, m0 = mt * 128, n0 = nt * 128;
        unsigned ao[4], bo[4];
#pragma unroll
        for (int i = 0; i < 4; ++i) {
            const int R = stg_row(tid, i, 4), g = stg_chunk(tid, i);
            ao[i] = (unsigned)(m0 + R) * 1024u + g * 8;
            bo[i] = (unsigned)(n0 + R) * 1024u + g * 8;
        }
        f32x4 acc[4][4];
        zero_acc<4>(acc);
        gemm_kloop2<4>(acc, MG, ao, Bt, bo, 1024, smem, tid);
        __syncthreads();
        lds_put_tile<4>(sT, acc, wr, wc, fr, fq);
        __syncthreads();
#pragma unroll
        for (int i = 0; i < 8; ++i) {
            const int c = tid + 256 * i, row = c >> 4, ch = c & 15;
            *(u32x4*)(Y + (size_t)(m0 + row) * 1024 + n0 + ch * 8) = *(const u32x4*)(sT + row * LDE + ch * 8);
        }
    }
}

__device__ __forceinline__ void ph_router(const Params& p, int l, unsigned char* smem) {
    const int tid = ltid(), lane = tid & 63, wid = __builtin_amdgcn_readfirstlane(tid >> 6), wr = wid >> 1, wc = wid & 1, fr = lane & 15, fq = lane >> 4;
    const bf16_t* H = (const bf16_t*)(p.ws + OFF_H);
    const bf16_t* Bt = (const bf16_t*)(p.ws + OFF_WB) + WB_WR;
    int* cnt = (int*)(p.ws + OFF_CTL) + l * 64;
    int* LIST = (int*)(p.ws + OFF_LIST);
    float* AW = (float*)(p.ws + OFF_AW);
    const float* bias = p.router_bias + l * 64;
    float* lg = (float*)smem;
    int* hist = (int*)(smem + 128 * 65 * 4);
    for (int mt = blockIdx.x; mt < 128; mt += gridDim.x) {
        const int m0 = mt * 128;
        unsigned ao[4], bo[4];
#pragma unroll
        for (int i = 0; i < 4; ++i) {
            const int R = stg_row(tid, i, 4), g = stg_chunk(tid, i);
            ao[i] = (unsigned)(m0 + R) * 1024u + g * 8;
            bo[i] = (unsigned)R * 1024u + g * 8;
        }
        f32x4 acc[4][4];
        zero_acc<4>(acc);
        gemm_kloop2<4>(acc, H, ao, Bt, bo, 1024, smem, tid);
        __syncthreads();
        if (wc == 0) {
#pragma unroll
            for (int m = 0; m < 4; ++m)
#pragma unroll
                for (int j = 0; j < 4; ++j)
#pragma unroll
                    for (int n = 0; n < 4; ++n) lg[(wr * 64 + m * 16 + fq * 4 + j) * 65 + n * 16 + fr] = acc[m][n][j];
        }
        if (tid < 64) hist[tid] = 0;
        int erank[8], ekeep[8];
#pragma unroll
        for (int k = 0; k < 8; ++k) { erank[k] = 0; ekeep[k] = 0; }
        __syncthreads();
        if (tid < 128) {
            float* row = lg + tid * 65;
            const int t = m0 + tid;
            float gs[8];
#pragma unroll
            for (int g = 0; g < 8; ++g) {
                float m1 = -__builtin_inff(), m2 = -__builtin_inff();
#pragma unroll
                for (int e = 0; e < 8; ++e) {
                    const float v = sigmoidf_(row[g * 8 + e]) + bias[g * 8 + e];
                    row[g * 8 + e] = v;
                    if (v > m1) { m2 = m1; m1 = v; } else if (v > m2) m2 = v;
                }
                gs[g] = m1 + m2;
            }
            unsigned gmask = 0u;
#pragma unroll
            for (int g = 0; g < 8; ++g) {
                int rank = 0;
#pragma unroll
                for (int g2 = 0; g2 < 8; ++g2) rank += (gs[g2] > gs[g] || (gs[g2] == gs[g] && g2 < g)) ? 1 : 0;
                if (rank < 4) gmask |= 1u << g;
            }
            unsigned long long taken = 0ull;
            int eidx[8]; float esc[8];
            float ssum = 0.f;
#pragma unroll
            for (int k = 0; k < 8; ++k) {
                float best = -__builtin_inff(); int bi = 0;
                for (int e = 0; e < 64; ++e) {
                    if (!((gmask >> (e >> 3)) & 1u) || ((taken >> e) & 1ull)) continue;
                    const float v = row[e];
                    if (v > best) { best = v; bi = e; }
                }
                taken |= 1ull << bi;
                eidx[k] = bi;
                esc[k] = best - bias[bi];
                ssum += esc[k];
            }
            const float scale = 2.5f / ssum;
#pragma unroll
            for (int k = 0; k < 8; ++k) {
                erank[k] = atomicAdd(&hist[eidx[k]], 1);
                ekeep[k] = eidx[k];
                AW[(size_t)t * 8 + k] = esc[k] * scale;
            }
        }
        __syncthreads();
        if (tid < 64) hist[64 + tid] = atomicAdd(&cnt[tid], hist[tid]);
        __syncthreads();
        if (tid < 128) {
            const int t = m0 + tid;
#pragma unroll
            for (int k = 0; k < 8; ++k) LIST[(size_t)ekeep[k] * T_ + hist[64 + ekeep[k]] + erank[k]] = t * 8 + k;
        }
        __syncthreads();
    }
}

struct __attribute__((aligned(16))) MoeLds { int tstart[66]; int xs[10]; int pad0[20]; int hbase[66]; int pad1[14]; int rowid[128]; };
__device__ __forceinline__ void moe_setup(MoeLds& sm, const int* cnt, int tid) {
    __syncthreads();
    if (tid == 0) {
        int ts = 0, hb = 0;
        for (int e = 0; e < 65; ++e) {
            const int ce = (e < 64) ? cnt[e] : T_;
            sm.tstart[e] = ts; sm.hbase[e] = hb;
            ts += (ce + 127) >> 7; hb += ce;
        }
        sm.tstart[65] = ts; sm.hbase[65] = hb;
        const int xcd = blockIdx.x & 7;
        int acc = 0;
        for (int k = 0; k < 8; ++k) { sm.xs[k] = acc; acc += sm.tstart[k * 8 + xcd + 1] - sm.tstart[k * 8 + xcd]; }
        sm.xs[8] = acc; acc += 16; sm.xs[9] = acc;
    }
    __syncthreads();
}

__device__ __forceinline__ void ph_moe1(const Params& p, int l, unsigned char* smem) {
    MoeLds& sm = *(MoeLds*)(smem + MISC + 64);
    const int tid = ltid(), lane = tid & 63, wid = __builtin_amdgcn_readfirstlane(tid >> 6), wr = wid >> 1, wc = wid & 1, fr = lane & 15, fq = lane >> 4;
    const bf16_t* H = (const bf16_t*)(p.ws + OFF_H);
    const bf16_t* W13 = (const bf16_t*)(p.ws + OFF_WB) + WB_W13;
    const int* cnt = (const int*)(p.ws + OFF_CTL) + l * 64;
    const int* LIST = (const int*)(p.ws + OFF_LIST);
    bf16_t* HID = (bf16_t*)(p.ws + OFF_R3);
    moe_setup(sm, cnt, tid);
    const int xcd = blockIdx.x & 7, jb = blockIdx.x >> 3, nper = gridDim.x >> 3;
    const int nitems = sm.xs[9] * 4;
    for (int item = jb; item < nitems; item += nper) {
        const int rtl = item >> 2, nt = item & 3;
        int k = 0;
        while (sm.xs[k + 1] <= rtl) ++k;
        const int e = (k < 8) ? (k * 8 + xcd) : 64;
        const int mtl = rtl - sm.xs[k] + ((k == 8) ? 16 * xcd : 0);
        const int ce = (e < 64) ? cnt[e] : T_;
        __syncthreads();
        if (tid < 128) {
            const int slot = mtl * 128 + tid;
            int tok = 0;
            if (slot < ce) tok = (e < 64) ? (LIST[(size_t)e * T_ + slot] >> 3) : slot;
            sm.rowid[tid] = tok;
        }
        __syncthreads();
        unsigned ao[4], bo[4];
#pragma unroll
        for (int i = 0; i < 4; ++i) {
            const int R = stg_row(tid, i, 4), g = stg_chunk(tid, i);
            ao[i] = (unsigned)sm.rowid[R] * 1024u + g * 8;
            bo[i] = (unsigned)(e * 512 + nt * 128 + R) * 1024u + g * 8;
        }
        f32x4 acc[4][4];
        zero_acc<4>(acc);
        gemm_kloop2<4>(acc, H, ao, W13, bo, 1024, smem, tid);
        const int hb = sm.hbase[e] + mtl * 128;
        f32x4 hacc[4][2];
#pragma unroll
        for (int m = 0; m < 4; ++m)
#pragma unroll
            for (int nn = 0; nn < 2; ++nn)
#pragma unroll
                for (int j = 0; j < 4; ++j) hacc[m][nn][j] = siluf_(acc[m][nn][j]) * acc[m][nn + 2][j];
        bf16_t* sT = (bf16_t*)smem;
        __syncthreads();
        lds_put_tile<2>(sT, hacc, wr, wc, fr, fq);
        __syncthreads();
        const int ts = ltid();
#pragma unroll
        for (int i = 0; i < 4; ++i) {
            const int c = ts + 256 * i, row = c >> 3, ch = c & 7;
            if (mtl * 128 + row < ce)
                *(u32x4*)(HID + (size_t)(hb + row) * 256 + nt * 64 + ch * 8) = *(const u32x4*)(sT + row * LDE + ch * 8);
        }
    }
}

__device__ __forceinline__ void ph_moe2(const Params& p, int l, unsigned char* smem) {
    MoeLds& sm = *(MoeLds*)(smem + MISC + 64);
    const int tid = ltid(), lane = tid & 63, wid = __builtin_amdgcn_readfirstlane(tid >> 6), wr = wid >> 1, wc = wid & 1, fr = lane & 15, fq = lane >> 4;
    const bf16_t* W2 = (const bf16_t*)(p.ws + OFF_WB) + WB_W2;
    const int* cnt = (const int*)(p.ws + OFF_CTL) + l * 64;
    const int* LIST = (const int*)(p.ws + OFF_LIST);
    const float* AW = (const float*)(p.ws + OFF_AW);
    const bf16_t* HID = (const bf16_t*)(p.ws + OFF_R3);
    bf16_t* SLOTS = (bf16_t*)(p.ws + OFF_R1);
    moe_setup(sm, cnt, tid);
    const int xcd = blockIdx.x & 7, jb = blockIdx.x >> 3, nper = gridDim.x >> 3;
    const int nitems = sm.xs[9] * 8;
    for (int item = jb; item < nitems; item += nper) {
        const int rtl = item >> 3, nt = item & 7;
        int k = 0;
        while (sm.xs[k + 1] <= rtl) ++k;
        const int e = (k < 8) ? (k * 8 + xcd) : 64;
        const int mtl = rtl - sm.xs[k] + ((k == 8) ? 16 * xcd : 0);
        const int ce = (e < 64) ? cnt[e] : T_;
        __syncthreads();
        if (tid < 128) {
            const int slot = mtl * 128 + tid;
            int aid = -1;
            if (slot < ce) aid = (e < 64) ? LIST[(size_t)e * T_ + slot] : (8 * T_ + slot);
            sm.rowid[tid] = aid;
        }
        __syncthreads();
        const int hb = sm.hbase[e] + mtl * 128;
        unsigned ao[4], bo[4];
#pragma unroll
        for (int i = 0; i < 4; ++i) {
            const int R = stg_row(tid, i, 4), g = stg_chunk(tid, i);
            ao[i] = (unsigned)(hb + R) * 256u + g * 8;
            bo[i] = (unsigned)(e * 1024 + nt * 128 + R) * 256u + g * 8;
        }
        f32x4 acc[4][4];
        zero_acc<4>(acc);
        gemm_kloop2<4>(acc, HID, ao, W2, bo, 256, smem, tid);
        const int ts = ltid();
        const int fqs = (ts & 63) >> 4;
#pragma unroll
        for (int m = 0; m < 4; ++m)
#pragma unroll
            for (int j = 0; j < 4; ++j) {
                const int r = wr * 64 + m * 16 + fqs * 4 + j;
                const int aid = sm.rowid[r];
                const float wt = (aid >= 0 && e < 64) ? AW[aid] : 1.0f;
#pragma unroll
                for (int n = 0; n < 4; ++n) acc[m][n][j] *= wt;
            }
        bf16_t* sT = (bf16_t*)smem;
        __syncthreads();
        lds_put_tile<4>(sT, acc, wr, wc, fr, fq);
        __syncthreads();
#pragma unroll
        for (int i = 0; i < 8; ++i) {
            const int c = ts + 256 * i, row = c >> 4, ch = c & 15;
            const int aid = sm.rowid[row];
            if (aid >= 0)
                __builtin_nontemporal_store(*(const u32x4*)(sT + row * LDE + ch * 8), (u32x4*)(SLOTS + (size_t)aid * 1024 + nt * 128 + ch * 8));
        }
    }
}

struct JobDesc { int K, NQ, src_ld, dst_ld, mode, p0, nbatch, which; unsigned src_lstride, src_bs, dst_bs, dst_off; };
constexpr int NJOBS = 12;
__constant__ JobDesc JOBS[NJOBS] = {
    {1024, 8832, NIN_, 1024, 1, 0, 1, 9, 1024u * NIN_, 0u, 0u, (unsigned)WB_WIN},
    {512, 1024, 1024, 512, 0, 0, 1, 14, 512u * 1024u, 0u, 0u, (unsigned)WB_WOA},
    {512, 1024, 1024, 512, 0, 0, 1, 15, 512u * 1024u, 0u, 0u, (unsigned)WB_WOB},
    {1024, 1024, 1024, 1024, 0, 0, 1, 16, 1024u * 1024u, 0u, 0u, (unsigned)WB_WOC},
    {1024, 1024, 1024, 1024, 0, 0, 1, 17, 1024u * 1024u, 0u, 0u, (unsigned)WB_WOUT},
    {1024, 128, 64, 1024, 3, 0, 1, 18, 1024u * 64u, 0u, 0u, (unsigned)WB_WR},
    {1024, 256, 256, 1024, 2, 0, 64, 20, 64u * 1024u * 256u, 1024u * 256u, 512u * 1024u, (unsigned)WB_W13},
    {1024, 256, 256, 1024, 2, 32, 64, 21, 64u * 1024u * 256u, 1024u * 256u, 512u * 1024u, (unsigned)WB_W13},
    {1024, 256, 256, 1024, 2, 0, 1, 23, 1024u * 256u, 0u, 0u, (unsigned)(WB_W13 + (size_t)64 * 512 * 1024)},
    {1024, 256, 256, 1024, 2, 32, 1, 24, 1024u * 256u, 0u, 0u, (unsigned)(WB_W13 + (size_t)64 * 512 * 1024)},
    {256, 1024, 1024, 256, 0, 0, 64, 22, 64u * 256u * 1024u, 256u * 1024u, 1024u * 256u, (unsigned)WB_W2},
    {256, 1024, 1024, 256, 0, 0, 1, 25, 256u * 1024u, 0u, 0u, (unsigned)(WB_W2 + (size_t)64 * 1024 * 256)},
};
__constant__ int JOBPRE[NJOBS + 1] = {0, 2208, 2336, 2464, 2720, 2976, 3008, 7104, 11200, 11264, 11328, 15424, 15488};
__device__ __forceinline__ TJob make_job(const Params& p, int l, int it, int& base) {
    int j = 0;
    while (JOBPRE[j + 1] <= it) ++j;
    const JobDesc d = JOBS[j];
    TJob tj;
    tj.src = ((const float* const*)&p)[d.which] + (size_t)l * d.src_lstride;
    tj.dst = (bf16_t*)(p.ws + OFF_WB) + d.dst_off;
    tj.K = d.K; tj.NQ = d.NQ; tj.src_ld = d.src_ld; tj.dst_ld = d.dst_ld; tj.mode = d.mode; tj.p0 = d.p0; tj.nbatch = d.nbatch; tj.pad = 0;
    tj.src_bs = d.src_bs; tj.dst_bs = d.dst_bs;
    base = JOBPRE[j];
    return tj;
}
__device__ __forceinline__ void tconv_range(const Params& p, int l, unsigned char* smem, int first, int stride, int it0, int it1) {
    float* tile = (float*)smem;
    const int tid = ltid();
    const int total = it1;
    __syncthreads();
    int it = it0 + first;
    f32x4 r[4];
    if (it < total) { int base; const TJob tj = make_job(p, l, it, base); tconv_load(tj, it - base, tid, r); }
    while (it < total) {
        const int nxt = it + stride;
        tconv_put(tid, r, tile);
        __syncthreads();
        if (nxt < total) { int base; const TJob tj = make_job(p, l, nxt, base); tconv_load(tj, nxt - base, tid, r); }
        { int base; const TJob tj = make_job(p, l, it, base); tconv_emit(tj, it - base, tid, tile); }
        __syncthreads();
        it = nxt;
    }
}

constexpr int TC_MIX_END = 3008;
__device__ __forceinline__ void ph_tconv_mix(const Params& p, int l, unsigned char* smem) { tconv_range(p, l, smem, blockIdx.x, gridDim.x, 0, TC_MIX_END); }
constexpr int SMEM_BYTES = DYN_LDS;
__device__ __forceinline__ int next_item(int* ctr, unsigned char* smem) {
    int* s_item = (int*)(smem + MISC);
    __syncthreads();
    if (ltid() == 0) *s_item = atomicAdd(ctr, 1);
    __syncthreads();
    return *s_item;
}
constexpr int TC_CH = 8;
constexpr int TC_NCH = (15488 - TC_MIX_END + TC_CH - 1) / TC_CH;
__device__ __forceinline__ void ph_tconv_moe(const Params& p, int l, unsigned char* smem) {
    int* ctr = (int*)(p.ws + OFF_CTL) + 256 + l * 4;
    for (;;) { const int it = next_item(ctr + 3, smem); if (it >= TC_NCH) break;
        const int a0 = TC_MIX_END + it * TC_CH; tconv_range(p, l, smem, 0, 1, a0, (a0 + TC_CH < JOBPRE[NJOBS]) ? a0 + TC_CH : JOBPRE[NJOBS]); }
}
__device__ __forceinline__ void ph_mix1(const Params& p, int l, unsigned char* smem) {
    int* ctr = (int*)(p.ws + OFF_CTL) + 256 + l * 4;
    {
        const float* CKVSS = (const float*)(p.ws + OFF_CKVSS);
        float* RS = (float*)(p.ws + OFF_RS);
        for (int t = blockIdx.x * 256 + ltid(); t < T_; t += gridDim.x * 256) {
            const f32x4 s4 = *(const f32x4*)(CKVSS + (size_t)t * 4);
            RS[t] = rsqrtf(((s4[0] + s4[1]) + (s4[2] + s4[3])) * (1.0f / 256.0f) + EPS_);
        }
    }
    for (;;) { const int it = next_item(ctr + 0, smem); if (it >= 2048) break; mixc1_item(p, it, smem); }
    for (;;) { const int it = next_item(ctr + 1, smem); if (it >= 1024) break; mixb_item(p, it, smem); }
    for (;;) { const int it = next_item(ctr + 2, smem); if (it >= 1024) break; mixa1_item(p, it, smem); }
}


constexpr size_t OFF_BAR = 16 * KiB;
#define XB_TMO      128
#define XB_XCNT(j)  (256  + 64 * (j))
#define XB_XSUB(j)  (1280 + 64 * (j))
#define XB_XGEN(j)  (2304 + 64 * (j))
#define XB_TOP      3328
#define XB_TOPGEN   3392
#define XCD_BAR_WORDS 3456
#define XB_SPIN_CAP (1u << 18)
__device__ __forceinline__ unsigned xb_ld(unsigned* p)              { return __hip_atomic_load(p, __ATOMIC_RELAXED, __HIP_MEMORY_SCOPE_AGENT); }
__device__ __forceinline__ unsigned xb_add(unsigned* p, unsigned v) { return __hip_atomic_fetch_add(p, v, __ATOMIC_RELAXED, __HIP_MEMORY_SCOPE_AGENT); }
__device__ __forceinline__ unsigned xb_xcc_id() { return (unsigned)__builtin_amdgcn_s_getreg((3 << 11) | 20) & 0xFu; }
#define XB_SPIN(cond, bar) do { unsigned _sp = 0; while (cond) { __builtin_amdgcn_s_sleep(1); \
    if ((++_sp & 255u) == 0u) { if (xb_ld(&(bar)[XB_TMO])) break; if (_sp > XB_SPIN_CAP) { atomicAdd(&(bar)[XB_TMO], 1u); break; } } } } while (0)
__device__ __forceinline__ void xcd_barrier_post(unsigned* bar) {
    if (threadIdx.x == 0) (void)xb_add(&bar[XB_XCNT(xb_xcc_id())], 1u);
}
__device__ __forceinline__ void xcd_barrier_complete(unsigned* bar, unsigned x, unsigned& nloc, unsigned& nx) {
    const unsigned G = gridDim.x * gridDim.y * gridDim.z;
    unsigned sum, cnt, mine, sp = 0u;
    for (;;) {
        sum = 0u; cnt = 0u; mine = 0u;
#pragma unroll
        for (unsigned j = 0; j < 16; ++j) { const unsigned c = xb_ld(&bar[XB_XCNT(j)]); sum += c; cnt += (c > 0u) ? 1u : 0u; mine = (j == x) ? c : mine; }
        if (sum == G) break;
        __builtin_amdgcn_s_sleep(1);
        if ((++sp & 255u) == 0u) { if (xb_ld(&bar[XB_TMO])) break; if (sp > XB_SPIN_CAP) { atomicAdd(&bar[XB_TMO], 1u); break; } }
    }
    nloc = mine > 0u ? mine : 1u; nx = cnt > 0u ? cnt : 1u;
}
__device__ __forceinline__ void xcd_barrier(unsigned* bar, volatile LAS unsigned* st) {
    asm volatile("s_waitcnt vmcnt(0)" ::: "memory");
    __syncthreads();
    if (threadIdx.x == 0) {
        const unsigned x = xb_xcc_id();
        __builtin_amdgcn_s_waitcnt(0);
        unsigned nloc = st[0], nx = st[1];
        if (nloc == 0u) { xcd_barrier_complete(bar, x, nloc, nx); st[0] = nloc; st[1] = nx; }
        const unsigned old = xb_add(&bar[XB_XSUB(x)], 1u);
        const unsigned gen = old / nloc;
        if (old + 1u == (gen + 1u) * nloc) {
            __builtin_amdgcn_fence(__ATOMIC_RELEASE, "agent");
            asm volatile("s_waitcnt vmcnt(0)" ::: "memory");
            const unsigned og = xb_add(&bar[XB_TOP], 1u);
            const unsigned tg = og / nx;
            if (og + 1u == (tg + 1u) * nx) xb_add(&bar[XB_TOPGEN], 1u);
            else XB_SPIN(xb_ld(&bar[XB_TOPGEN]) == tg, bar);
            __builtin_amdgcn_fence(__ATOMIC_ACQUIRE, "agent");
            xb_add(&bar[XB_XGEN(x)], 1u);
            asm volatile("s_waitcnt vmcnt(0)" ::: "memory");
        } else {
            XB_SPIN(xb_ld(&bar[XB_XGEN(x)]) == gen, bar);
            __builtin_amdgcn_fence(__ATOMIC_ACQUIRE, "agent");
            asm volatile("s_waitcnt vmcnt(0)" ::: "memory");
        }
    }
    __syncthreads();
}

#define LAUNDER()
__global__ void __launch_bounds__(256, 3) mega(Params p_unused) {
    extern __shared__ __attribute__((aligned(16))) unsigned char smem[];
    if (threadIdx.x == 0) *(u32x4*)(smem + MISC + 16) = (u32x4){0u, 0u, 0u, 0u};
    __syncthreads();
    xcd_barrier_post((unsigned*)(getp().ws + OFF_BAR));
#define GSYNC() xcd_barrier((unsigned*)(getp().ws + OFF_BAR), (volatile LAS unsigned*)(smem + MISC + 16))

    ph_rope(getp());
    ph_mod(getp(), smem);
    ph_tconv_mix(getp(), 0, smem);
    ph_wcomp(getp(), 0, smem);
    GSYNC();
    {
        const Params& p = getp();
        const float* mod = (const float*)(p.ws + OFF_MOD);
        NormArgs a;
        a.xin = p.x; a.Y = nullptr; a.slots = nullptr; a.gpost = nullptr; a.gt = nullptr;
        a.mode = 0; a.gpre = p.g_pre_mix; a.sc = mod + 1024; a.sh = mod + 0;
        ph_norm(p, a);
    }
    GSYNC();
#pragma unroll 1
    for (int l = 0; l < DEPTH_; ++l) {
        ph_gemm_z(getp(), smem);
        GSYNC();
        ph_mix1(getp(), l, smem);
        GSYNC();
        ph_mixc2(getp());
        ph_mix_a2(getp(), l, smem);
        GSYNC();
        { const Params& p = getp(); for (int it = blockIdx.x; it < 2048; it += gridDim.x) mixc3_item(p, l, it, smem); }
        GSYNC();
        ph_merge(getp(), smem);
        GSYNC();
        ph_outproj(getp(), smem);
        GSYNC();
        {
            const Params& p = getp();
        const float* mod = (const float*)(p.ws + OFF_MOD);
        NormArgs a;
            a.xin = nullptr; a.slots = nullptr;
            a.mode = 1; a.Y = (const bf16_t*)(p.ws + OFF_R1 + R1_QC);
            a.gpost = p.g_post_mix + l * 1024; a.gt = mod + (size_t)l * 8 * 6144 + 2048;
            a.gpre = p.g_pre_ffn + l * 1024; a.sc = mod + (size_t)l * 8 * 6144 + 4096; a.sh = mod + (size_t)l * 8 * 6144 + 3072;
            ph_norm(p, a);
        }
        GSYNC();
        ph_router(getp(), l, smem);
        ph_tconv_moe(getp(), l, smem);
        GSYNC();
        ph_moe1(getp(), l, smem);
        GSYNC();
        ph_moe2(getp(), l, smem);
        GSYNC();
        {
            const Params& p = getp();
        const float* mod = (const float*)(p.ws + OFF_MOD);
        NormArgs a;
            a.xin = nullptr; a.Y = nullptr;
            a.mode = 2; a.slots = (const bf16_t*)(p.ws + OFF_R1);
            a.gpost = p.g_post_ffn + l * 1024; a.gt = mod + (size_t)l * 8 * 6144 + 5120;
            a.gpre = nullptr; a.sc = nullptr; a.sh = nullptr;
            if (l + 1 < DEPTH_) { a.gpre = p.g_pre_mix + (l + 1) * 1024; a.sc = mod + (size_t)(l + 1) * 8 * 6144 + 1024; a.sh = mod + (size_t)(l + 1) * 8 * 6144 + 0; }
            ph_norm(p, a);
        }
        if (l + 1 < DEPTH_) {
            ph_tconv_mix(getp(), l + 1, smem);
            ph_wcomp(getp(), l + 1, smem);
            GSYNC();
        }
    }
}

extern "C" void kernel_launch(void* const* d_in, const int* in_sizes, int n_in, void* d_out, int out_size, void* d_ws, size_t ws_size, hipStream_t stream) {
    if (n_in < 26 || ws_size < WS_TOTAL) { fprintf(stderr, "kernel_launch: bad inputs / workspace too small (%zu < %zu)\n", ws_size, (size_t)WS_TOTAL); return; }
    Params p;
    memset(&p, 0, sizeof(p));
    p.x = (const float*)d_in[0]; p.c = (const float*)d_in[1]; p.positions = (const int*)d_in[2]; p.ada_w = (const float*)d_in[3]; p.ada_b = (const float*)d_in[4];
    p.g_pre_mix = (const float*)d_in[5]; p.g_post_mix = (const float*)d_in[6]; p.g_pre_ffn = (const float*)d_in[7]; p.g_post_ffn = (const float*)d_in[8];
    p.w_in = (const float*)d_in[9]; p.g_kv = (const float*)d_in[10]; p.w_uk = (const float*)d_in[11]; p.w_uv = (const float*)d_in[12]; p.g_ret = (const float*)d_in[13];
    p.w_o_a = (const float*)d_in[14]; p.w_o_b = (const float*)d_in[15]; p.w_o_c = (const float*)d_in[16]; p.w_out = (const float*)d_in[17];
    p.w_router = (const float*)d_in[18]; p.router_bias = (const float*)d_in[19]; p.w1 = (const float*)d_in[20]; p.w3 = (const float*)d_in[21]; p.w2 = (const float*)d_in[22];
    p.ws1 = (const float*)d_in[23]; p.ws3 = (const float*)d_in[24]; p.ws2 = (const float*)d_in[25];
    p.out = (float*)d_out; p.ws = (unsigned char*)d_ws;
    static int grid_blocks = 0;
    if (!grid_blocks) {
        int dev = 0, cus = 0, per_cu = 0;
        (void)hipGetDevice(&dev);
        (void)hipDeviceGetAttribute(&cus, hipDeviceAttributeMultiprocessorCount, dev);
        (void)hipFuncSetAttribute((const void*)mega, hipFuncAttributeMaxDynamicSharedMemorySize, DYN_LDS);
        (void)hipOccupancyMaxActiveBlocksPerMultiprocessor(&per_cu, mega, 256, DYN_LDS);
        if (per_cu < 1) per_cu = 1;
        if (per_cu > 3) per_cu = 3;
        grid_blocks = cus * per_cu;
    }
    (void)hipMemsetAsync((unsigned char*)d_ws + OFF_CTL, 0, 32 * 1024, stream);
    void* args[] = {&p};
    hipError_t e = hipLaunchCooperativeKernel((void*)mega, dim3(grid_blocks), dim3(256), args, DYN_LDS, stream);
    if (e != hipSuccess) fprintf(stderr, "cooperative launch failed: %s (grid %d)\n", hipGetErrorString(e), grid_blocks);
}
```

```cpp
#include <hip/hip_runtime.h>
#include <hip/hip_cooperative_groups.h>
namespace cg = cooperative_groups;
#include <stdint.h>
#include <stdio.h>
#include <string.h>

typedef unsigned short bf16_t;
typedef short bf16x8 __attribute__((ext_vector_type(8)));
typedef short bf16x4 __attribute__((ext_vector_type(4)));
typedef float f32x4 __attribute__((ext_vector_type(4)));
typedef float f32x2 __attribute__((ext_vector_type(2)));
typedef unsigned u32x4 __attribute__((ext_vector_type(4)));
typedef unsigned u32x2 __attribute__((ext_vector_type(2)));

constexpr int T_ = 16384, S_ = 2048, NB_ = 8, D_ = 1024, DEPTH_ = 2;
constexpr int NIN_ = 8772;
constexpr int NZ_ = 8960;
constexpr float EPS_ = 1e-6f;

constexpr int C_QA = 0, C_CKV = 512, C_IQ = 768, C_IK = 1024, C_IW = 1088, C_QB = 1152, C_KB = 1664, C_VB = 2176,
              C_QC = 2688, C_KC = 3200, C_VC = 3712, C_GC = 4736, C_GATES = 5760, C_KA = 8832, C_VA = 8896;

constexpr size_t KiB = 1024, MiB = 1024 * 1024;
constexpr size_t OFF_CTL = 0;
constexpr size_t OFF_MOD = 64 * KiB;
constexpr size_t OFF_IW = 512 * KiB;
constexpr size_t OFF_CKVSS = 768 * KiB;
constexpr size_t OFF_AW = 1 * MiB;
constexpr size_t OFF_RS = 1 * MiB + 512 * KiB;
constexpr size_t OFF_ROPE = 2 * MiB;
constexpr size_t OFF_LIST = 6 * MiB;
constexpr size_t OFF_MASKB = 10 * MiB;
constexpr size_t OFF_WB = 14 * MiB;
constexpr size_t WB_WIN = 0;
constexpr size_t WB_WOA = WB_WIN + (size_t)NZ_ * 1024;
constexpr size_t WB_WOB = WB_WOA + 1024 * 512;
constexpr size_t WB_WOC = WB_WOB + 1024 * 512;
constexpr size_t WB_WOUT = WB_WOC + 1024 * 1024;
constexpr size_t WB_WR = WB_WOUT + 1024 * 1024;
constexpr size_t WB_W13 = WB_WR + 128 * 1024;
constexpr size_t WB_W2 = WB_W13 + (size_t)65 * 512 * 1024;
constexpr size_t WB_END = WB_W2 + (size_t)65 * 1024 * 256;
constexpr size_t OFF_H = OFF_WB + ((WB_END * 2 + MiB - 1) / MiB) * MiB;
constexpr size_t OFF_R1 = OFF_H + 32 * MiB;
constexpr size_t R1_QA = 0;
constexpr size_t R1_IQ = R1_QA + 16 * MiB;
constexpr size_t R1_IK = R1_IQ + 8 * MiB;
constexpr size_t R1_KA = R1_IK + 2 * MiB;
constexpr size_t R1_VAT = R1_KA + 2 * MiB;
constexpr size_t R1_QB = R1_VAT + 2 * MiB;
constexpr size_t R1_KB = R1_QB + 16 * MiB;
constexpr size_t R1_VBT = R1_KB + 16 * MiB;
constexpr size_t R1_QC = R1_VBT + 16 * MiB;
constexpr size_t R1_KC = R1_QC + 16 * MiB;
constexpr size_t R1_KCT = R1_KC + 16 * MiB;
constexpr size_t R1_VCT = R1_KCT + 16 * MiB;
constexpr size_t R1_GC = R1_VCT + 32 * MiB;
constexpr size_t R1_GATES = R1_GC + 32 * MiB;
constexpr size_t R1_ZEND = R1_GATES + 96 * MiB;
constexpr size_t R1_SIZE = 288 * MiB;
constexpr size_t OFF_R3 = OFF_R1 + R1_SIZE;
constexpr size_t R3_SIZE = 78 * MiB;
constexpr size_t OFF_XR = OFF_R3 + R3_SIZE;
constexpr size_t WS_TOTAL = OFF_XR + 32 * MiB;
static_assert(R1_ZEND <= R1_SIZE, "r1");
constexpr size_t SC_PER_BATCH = 2162688;

__constant__ float INVF[32] = {
    1.000000000e+00f, 7.498942614e-01f, 5.623413324e-01f, 4.216965139e-01f, 3.162277639e-01f, 2.371373773e-01f, 1.778279394e-01f, 1.333521307e-01f,
    1.000000015e-01f, 7.498941571e-02f, 5.623413250e-02f, 4.216965288e-02f, 3.162277490e-02f, 2.371373773e-02f, 1.778279431e-02f, 1.333521493e-02f,
    9.999999776e-03f, 7.498941850e-03f, 5.623413250e-03f, 4.216964822e-03f, 3.162277630e-03f, 2.371373586e-03f, 1.778279431e-03f, 1.333521446e-03f,
    1.000000047e-03f, 7.498942432e-04f, 5.623413017e-04f, 4.216965172e-04f, 3.162277571e-04f, 2.371373703e-04f, 1.778279402e-04f, 1.333521504e-04f};

__constant__ float LOGG[8] = {-0.0317486983145803f, -0.015748356968139168f, -0.007843177461025893f, -0.003913899321136329f,
                               -0.0019550348358033506f, -0.0009770396478266127f, -0.0004884004981088745f, -0.0002441704321739145f};

__device__ __forceinline__ float bf2f(bf16_t u) { return __uint_as_float(((unsigned)u) << 16); }
__device__ __forceinline__ bf16_t f2bf(float f) {
    unsigned u = __float_as_uint(f);
    u += 0x7fffu + ((u >> 16) & 1u);
    return (bf16_t)(u >> 16);
}
__device__ __forceinline__ unsigned pack2(float a, float b) { return (unsigned)f2bf(a) | ((unsigned)f2bf(b) << 16); }
__device__ __forceinline__ float sigmoidf_(float x) { return __builtin_amdgcn_rcpf(1.0f + __expf(-x)); }
__device__ __forceinline__ float siluf_(float x) { return x * __builtin_amdgcn_rcpf(1.0f + __expf(-x)); }
__device__ __forceinline__ float wave_sum(float v) {
#pragma unroll
    for (int o = 32; o >= 1; o >>= 1) v += __shfl_xor(v, o);
    return v;
}
__device__ __forceinline__ int wave_sum_i(int v) {
#pragma unroll
    for (int o = 32; o >= 1; o >>= 1) v += __shfl_xor(v, o);
    return v;
}

struct Params {
    const float* x; const float* c; const int* positions; const float* ada_w; const float* ada_b;
    const float* g_pre_mix; const float* g_post_mix; const float* g_pre_ffn; const float* g_post_ffn;
    const float* w_in; const float* g_kv; const float* w_uk; const float* w_uv; const float* g_ret;
    const float* w_o_a; const float* w_o_b; const float* w_o_c; const float* w_out;
    const float* w_router; const float* router_bias; const float* w1; const float* w3; const float* w2;
    const float* ws1; const float* ws3; const float* ws2;
    float* out;
    unsigned char* ws;
};

__device__ __forceinline__ int cnt_ge(int cnt, unsigned key, unsigned cand) {
    asm volatile("v_cmp_ge_u32 vcc, %1, %2\n\tv_addc_co_u32 %0, vcc, 0, %0, vcc" : "+v"(cnt) : "v"(key), "v"(cand) : "vcc");
    return cnt;
}
__device__ __forceinline__ int cnt_ge_s(int cnt, unsigned key, unsigned cand) {
    asm volatile("v_cmp_ge_u32 vcc, %1, %2\n\ts_bcnt1_i32_b64 vcc_lo, vcc\n\ts_add_i32 %0, %0, vcc_lo" : "+s"(cnt) : "v"(key), "v"(cand) : "vcc", "scc");
    return cnt;
}
__device__ __forceinline__ int wave_total6(int c) {
    int t = 0;
#pragma unroll
    for (int b = 0; b < 6; ++b) t += __builtin_popcountll(__ballot((c >> b) & 1)) << b;
    return t;
}
__device__ __forceinline__ float xrow16_max(float x) {
    auto s = __builtin_amdgcn_permlane16_swap(__float_as_uint(x), __float_as_uint(x), false, false);
    x = fmaxf(__uint_as_float(s[0]), __uint_as_float(s[1]));
    auto t = __builtin_amdgcn_permlane32_swap(__float_as_uint(x), __float_as_uint(x), false, false);
    return fmaxf(__uint_as_float(t[0]), __uint_as_float(t[1]));
}
__device__ __forceinline__ float xrow16_sum(float x) {
    auto s = __builtin_amdgcn_permlane16_swap(__float_as_uint(x), __float_as_uint(x), false, false);
    x = __uint_as_float(s[0]) + __uint_as_float(s[1]);
    auto t = __builtin_amdgcn_permlane32_swap(__float_as_uint(x), __float_as_uint(x), false, false);
    return __uint_as_float(t[0]) + __uint_as_float(t[1]);
}
__device__ __forceinline__ int ltid() { int t = threadIdx.x; asm volatile("" : "+v"(t)); return t; }
typedef const Params __attribute__((address_space(4))) * KParamsPtr;
__device__ __forceinline__ const Params& getp() {
    KParamsPtr kp = (KParamsPtr)__builtin_amdgcn_kernarg_segment_ptr();
    asm volatile("" : "+s"(kp));
    return *(const Params*)kp;
}
__device__ __forceinline__ void ph_rope(const Params& p) {
    for (int idx = blockIdx.x * 256 + ltid(); idx < T_ * 32; idx += gridDim.x * 256) {
        int t = idx >> 5, i = idx & 31;
        float ang = (float)p.positions[t] * INVF[i];
        double rev = (double)ang * 0.15915494309189535;
        double fr = rev - rint(rev);
        float r = (float)(fr * 6.283185307179586);
        f32x2 cs; cs.x = __cosf(r); cs.y = __sinf(r);
        ((f32x2*)(p.ws + OFF_ROPE))[idx] = cs;
    }
}

__device__ __forceinline__ void ph_mod(const Params& p, unsigned char* smem) {
    float* sc = (float*)smem;
    float* part = sc + 8 * 1024;
    const int tid = ltid();
    if ((int)blockIdx.x >= 192) return;
    __syncthreads();
    for (int i = tid; i < 8192; i += 256) sc[i] = siluf_(p.c[i]);
    __syncthreads();
    for (int it = blockIdx.x; it < 192; it += gridDim.x) {
        const int l = it / 96, jb = (it % 96) * 64;
        const int c4 = (tid & 15) * 4, kg = tid >> 4;
        f32x4 acc[8];
#pragma unroll
        for (int b = 0; b < 8; ++b) acc[b] = (f32x4){0.f, 0.f, 0.f, 0.f};
        const float* w = p.ada_w + (size_t)l * 1024 * 6144 + jb + c4;
#pragma unroll 4
        for (int k = kg * 64; k < kg * 64 + 64; ++k) {
            const f32x4 wv = *(const f32x4*)(w + (size_t)k * 6144);
#pragma unroll
            for (int b = 0; b < 8; ++b) acc[b] += wv * sc[b * 1024 + k];
        }
        if (kg >= 8) {
#pragma unroll
            for (int b = 0; b < 8; ++b) *(f32x4*)(part + ((kg - 8) * 8 + b) * 64 + c4) = acc[b];
        }
        __syncthreads();
        if (kg < 8) {
#pragma unroll
            for (int b = 0; b < 8; ++b) { f32x4* q = (f32x4*)(part + (kg * 8 + b) * 64 + c4); *q = *q + acc[b]; }
        }
        __syncthreads();
        {
            float* mod = (float*)(p.ws + OFF_MOD);
#pragma unroll
            for (int o = 0; o < 2; ++o) {
                const int idx = tid + 256 * o, b = idx >> 6, jj = idx & 63;
                float r = 0.f;
#pragma unroll
                for (int g = 0; g < 8; ++g) r += part[(g * 8 + b) * 64 + jj];
                mod[(size_t)(l * 8 + b) * 6144 + jb + jj] = r + p.ada_b[l * 6144 + jb + jj];
            }
        }
        __syncthreads();
    }
}

struct TJob {
    const float* src; bf16_t* dst;
    int K, NQ, src_ld, dst_ld, mode, p0, nbatch, pad;
    size_t src_bs, dst_bs;
};
__device__ __forceinline__ int tj_src_col(int mode, int p0, int q) {
    if (mode == 0) return q + p0;
    if (mode == 1) return q < 1092 ? q : (q < 1152 ? -1 : q - 60);
    if (mode == 2) return q;
    return q < 64 ? q : -1;
}
__device__ __forceinline__ int tj_dst_row(int mode, int p0, int q) {
    if (mode == 2) return (q >> 5) * 64 + p0 + (q & 31);
    return q;
}
__device__ __forceinline__ void tconv_load(const TJob& j, int it, int tid, f32x4 (&r)[4]) {
    const int nk = j.K / 64;
    const int per = (j.NQ / 64) * nk;
    const int b = it / per, rr = it % per, qt = rr / nk, kt = rr % nk;
    const float* src = j.src + (size_t)b * j.src_bs;
    const int tx4 = (tid & 15) * 4, ty = tid >> 4;
    const int sc = tj_src_col(j.mode, j.p0, qt * 64 + tx4);
#pragma unroll
    for (int i = 0; i < 4; ++i) {
        if (sc >= 0) r[i] = *(const f32x4*)(src + (size_t)(kt * 64 + ty + 16 * i) * j.src_ld + sc);
        else r[i] = (f32x4){0.f, 0.f, 0.f, 0.f};
    }
}
constexpr int TCS = 68;
__device__ __forceinline__ void tconv_put(int tid, const f32x4 (&r)[4], float* tile) {
    const int tx4 = (tid & 15) * 4, ty = tid >> 4;
#pragma unroll
    for (int i = 0; i < 4; ++i) {
        const int k = ty + 16 * i;
        *(f32x4*)(tile + k * TCS + (tx4 ^ (((k >> 4) & 1) * 16))) = r[i];
    }
}
__device__ __forceinline__ void tconv_emit(const TJob& j, int it, int tid, const float* tile) {
    const int nk = j.K / 64;
    const int per = (j.NQ / 64) * nk;
    const int b = it / per, rr = it % per, qt = rr / nk, kt = rr % nk;
    bf16_t* dst = j.dst + (size_t)b * j.dst_bs;
    const int nn = tid >> 2, kc = (tid & 3) * 16;
    const int dr = tj_dst_row(j.mode, j.p0, qt * 64 + nn);
    const int col = nn ^ (((kc >> 4) & 1) * 16);
    unsigned w[8];
#pragma unroll
    for (int i = 0; i < 8; ++i) w[i] = pack2(tile[(kc + 2 * i) * TCS + col], tile[(kc + 2 * i + 1) * TCS + col]);
    u32x4* d = (u32x4*)(dst + (size_t)dr * j.dst_ld + kt * 64 + kc);
    d[0] = (u32x4){w[0], w[1], w[2], w[3]};
    d[1] = (u32x4){w[4], w[5], w[6], w[7]};
}

__device__ __forceinline__ void ph_wcomp(const Params& p, int l, unsigned char* smem) {
    float (*row)[256] = (float (*)[256])smem;
    const int tid = ltid();
    for (int it = blockIdx.x; it < 512; it += gridDim.x) {
    const int k0 = it * 2;
    __syncthreads();
    {
        const int kk = tid >> 7, jj = tid & 127;
        const float* wi = p.w_in + ((size_t)l * 1024 + k0 + kk) * NIN_ + 512;
        row[kk][jj] = wi[jj] * p.g_kv[l * 256 + jj];
        row[kk][jj + 128] = wi[jj + 128] * p.g_kv[l * 256 + jj + 128];
    }
    __syncthreads();
    const int kk = tid >> 7, n = tid & 127;
    const float* wu = (n < 64) ? (p.w_uk + (size_t)l * 256 * 64 + n) : (p.w_uv + (size_t)l * 256 * 64 + (n - 64));
    float acc = 0.f;
#pragma unroll 1
    for (int j0 = 0; j0 < 256; j0 += 16) {
        float wv[16];
#pragma unroll
        for (int jx = 0; jx < 16; ++jx) wv[jx] = wu[(j0 + jx) * 64];
#pragma unroll
        for (int jx = 0; jx < 16; ++jx) acc += row[kk][j0 + jx] * wv[jx];
    }
    bf16_t* WinT = (bf16_t*)(p.ws + OFF_WB) + WB_WIN;
    WinT[(size_t)(C_KA + n) * 1024 + k0 + kk] = f2bf(acc);
    }
}

struct NormArgs {
    const float* xin; const bf16_t* Y; const bf16_t* slots;
    const float* gpost; const float* gt;
    const float* gpre; const float* sc; const float* sh;
    int mode;
    const float* xres;
    int out_f32;
};
__device__ __forceinline__ void ph_norm(const Params& p, const NormArgs& a) {
    const int lane = ltid() & 63;
    for (int row = blockIdx.x * 4 + (ltid() >> 6); row < T_; row += gridDim.x * 4) {
    const int b = row >> 11;
    float* xo = p.out + (size_t)row * 1024;
    bf16_t* xr = (bf16_t*)(p.ws + OFF_XR) + (size_t)row * 1024;
    f32x4 xv[4];
    if (a.mode == 0) {
#pragma unroll
        for (int i = 0; i < 4; ++i) xv[i] = *(const f32x4*)(a.xin + (size_t)row * 1024 + i * 256 + lane * 4);
    } else {
        f32x4 yv[4];
        if (a.mode == 1) {
#pragma unroll
            for (int i = 0; i < 4; ++i) {
                u32x2 u = *(const u32x2*)(a.Y + (size_t)row * 1024 + i * 256 + lane * 4);
                yv[i][0] = __uint_as_float(u.x << 16); yv[i][1] = __uint_as_float(u.x & 0xffff0000u);
                yv[i][2] = __uint_as_float(u.y << 16); yv[i][3] = __uint_as_float(u.y & 0xffff0000u);
            }
        } else {
#pragma unroll
            for (int i = 0; i < 4; ++i) yv[i] = (f32x4){0.f, 0.f, 0.f, 0.f};
#pragma unroll
            for (int k = 0; k < 9; ++k) {
                const bf16_t* sp = a.slots + (k < 8 ? ((size_t)row * 8 + k) : ((size_t)8 * T_ + row)) * 1024;
#pragma unroll
                for (int i = 0; i < 4; ++i) {
                    u32x2 u = *(const u32x2*)(sp + i * 256 + lane * 4);
                    yv[i][0] += __uint_as_float(u.x << 16); yv[i][1] += __uint_as_float(u.x & 0xffff0000u);
                    yv[i][2] += __uint_as_float(u.y << 16); yv[i][3] += __uint_as_float(u.y & 0xffff0000u);
                }
            }
        }
        float ss = 0.f;
#pragma unroll
        for (int i = 0; i < 4; ++i) ss += yv[i][0] * yv[i][0] + yv[i][1] * yv[i][1] + yv[i][2] * yv[i][2] + yv[i][3] * yv[i][3];
        ss = wave_sum(ss);
        const float rs = rsqrtf(ss * (1.0f / 1024.0f) + EPS_);
#pragma unroll
        for (int i = 0; i < 4; ++i) {
            const int col = i * 256 + lane * 4;
            f32x4 xo4;
            if (a.xres) xo4 = *(const f32x4*)(a.xres + (size_t)row * 1024 + col);
            else {
                const u32x2 u = *(const u32x2*)(xr + col);
                xo4[0] = __uint_as_float(u.x << 16); xo4[1] = __uint_as_float(u.x & 0xffff0000u);
                xo4[2] = __uint_as_float(u.y << 16); xo4[3] = __uint_as_float(u.y & 0xffff0000u);
            }
            f32x4 g4 = *(const f32x4*)(a.gpost + col);
            f32x4 gt4 = *(const f32x4*)(a.gt + (size_t)b * 6144 + col);
            xv[i] = xo4 + gt4 * (yv[i] * rs * g4);
        }
    }
    if (a.out_f32) {
#pragma unroll
        for (int i = 0; i < 4; ++i) *(f32x4*)(xo + i * 256 + lane * 4) = xv[i];
    } else if (a.mode != 0) {
#pragma unroll
        for (int i = 0; i < 4; ++i) {
            u32x2 u; u.x = pack2(xv[i][0], xv[i][1]); u.y = pack2(xv[i][2], xv[i][3]);
            *(u32x2*)(xr + i * 256 + lane * 4) = u;
        }
    }
    if (a.gpre) {
        float ss = 0.f;
#pragma unroll
        for (int i = 0; i < 4; ++i) ss += xv[i][0] * xv[i][0] + xv[i][1] * xv[i][1] + xv[i][2] * xv[i][2] + xv[i][3] * xv[i][3];
        ss = wave_sum(ss);
        const float rs = rsqrtf(ss * (1.0f / 1024.0f) + EPS_);
        bf16_t* H = (bf16_t*)(p.ws + OFF_H) + (size_t)row * 1024;
#pragma unroll
        for (int i = 0; i < 4; ++i) {
            const int col = i * 256 + lane * 4;
            f32x4 g4 = *(const f32x4*)(a.gpre + col);
            f32x4 sc4 = *(const f32x4*)(a.sc + (size_t)b * 6144 + col);
            f32x4 sh4 = *(const f32x4*)(a.sh + (size_t)b * 6144 + col);
            f32x4 h = (xv[i] * rs * g4) * (sc4 + 1.0f) + sh4;
            u32x2 u; u.x = pack2(h[0], h[1]); u.y = pack2(h[2], h[3]);
            *(u32x2*)(H + col) = u;
        }
    }
    }
}

#define LAS __attribute__((address_space(3)))
constexpr int STG = 32768;
constexpr int MISC = 49152;
constexpr int DYN_LDS = 49152 + 1280;
__device__ __forceinline__ int stg_row(int tid, int i, int pieces) { return ((tid >> 6) * pieces + i) * 8 + ((tid & 63) >> 3); }
__device__ __forceinline__ int stg_chunk(int tid, int i) { return (tid & 7) ^ ((4 * i + ((tid & 63) >> 4)) & 7); }
template <int NW>
__device__ __forceinline__ void gemm_kloop2(f32x4 (&acc)[4][NW], const bf16_t* abase, const unsigned (&aoff)[4], const bf16_t* bbase, const unsigned (&boff)[NW], int K, unsigned char* smem, int tid) {
    const int lane = tid & 63, wid = __builtin_amdgcn_readfirstlane(tid >> 6), wr = wid >> 1, wc = wid & 1, fr = lane & 15, fq = lane >> 4;
    LAS unsigned char* lds = (LAS unsigned char*)smem;
    const int nt = K >> 6;
    const int offA = (wr * 64 + fr) * 128, offB = 16384 + (wc * (16 * NW) + fr) * 128;
    const int sw = fr >> 1;
    for (int t = 0; t < nt; ++t) {
        __syncthreads();
#pragma unroll
        for (int i = 0; i < 4; ++i) __builtin_amdgcn_global_load_lds((const unsigned*)(abase + aoff[i] + t * 64), (LAS unsigned*)(lds + (wid * 4 + i) * 1024), 16, 0, 0);
#pragma unroll
        for (int i = 0; i < NW; ++i) __builtin_amdgcn_global_load_lds((const unsigned*)(bbase + boff[i] + t * 64), (LAS unsigned*)(lds + 16384 + (wid * NW + i) * 1024), 16, 0, 0);
        asm volatile("s_waitcnt vmcnt(0)" ::: "memory");
        __syncthreads();
#pragma unroll
        for (int ks = 0; ks < 2; ++ks) {
            const int ch = ((ks * 4 + fq) ^ sw) << 4;
            bf16x8 af[4], bfv[NW];
#pragma unroll
            for (int m = 0; m < 4; ++m) af[m] = *(const LAS bf16x8*)(lds + offA + m * 2048 + ch);
#pragma unroll
            for (int n = 0; n < NW; ++n) bfv[n] = *(const LAS bf16x8*)(lds + offB + n * 2048 + ch);
            __builtin_amdgcn_s_setprio(1);
#pragma unroll
            for (int m = 0; m < 4; ++m)
#pragma unroll
                for (int n = 0; n < NW; ++n) acc[m][n] = __builtin_amdgcn_mfma_f32_16x16x32_bf16(af[m], bfv[n], acc[m][n], 0, 0, 0);
            __builtin_amdgcn_s_setprio(0);
        }
    }
}

constexpr int LDT = 72;
struct __attribute__((aligned(16))) GemmLds { bf16_t A[128 * LDT]; bf16_t B[128 * LDT]; };

template <int NW>
__device__ __forceinline__ void gemm_kloop(f32x4 (&acc)[4][NW], const bf16_t* const (&ap)[4], const bf16_t* const (&bp)[NW], int K,
                                           bf16_t* sA, bf16_t* sB, int tid) {
    const int lane = tid & 63, wid = __builtin_amdgcn_readfirstlane(tid >> 6), wr = wid >> 1, wc = wid & 1, fr = lane & 15, fq = lane >> 4;
    u32x4 ra[4], rb[NW];
#pragma unroll
    for (int i = 0; i < 4; ++i) ra[i] = *(const u32x4*)(ap[i]);
#pragma unroll
    for (int i = 0; i < NW; ++i) rb[i] = *(const u32x4*)(bp[i]);
    const int srow = tid >> 3, scol = (tid & 7) * 8;
    for (int k0 = 0; k0 < K; k0 += 64) {
        __syncthreads();
#pragma unroll
        for (int i = 0; i < 4; ++i) *(u32x4*)(sA + (srow + 32 * i) * LDT + scol) = ra[i];
#pragma unroll
        for (int i = 0; i < NW; ++i) *(u32x4*)(sB + (srow + 32 * i) * LDT + scol) = rb[i];
        __syncthreads();
        if (k0 + 64 < K) {
#pragma unroll
            for (int i = 0; i < 4; ++i) ra[i] = *(const u32x4*)(ap[i] + k0 + 64);
#pragma unroll
            for (int i = 0; i < NW; ++i) rb[i] = *(const u32x4*)(bp[i] + k0 + 64);
        }
#pragma unroll
        for (int ks = 0; ks < 2; ++ks) {
            bf16x8 af[4], bfv[NW];
#pragma unroll
            for (int m = 0; m < 4; ++m) af[m] = *(const bf16x8*)(sA + (wr * 64 + m * 16 + fr) * LDT + ks * 32 + fq * 8);
#pragma unroll
            for (int n = 0; n < NW; ++n) bfv[n] = *(const bf16x8*)(sB + (wc * (16 * NW) + n * 16 + fr) * LDT + ks * 32 + fq * 8);
#pragma unroll
            for (int m = 0; m < 4; ++m)
#pragma unroll
                for (int n = 0; n < NW; ++n) acc[m][n] = __builtin_amdgcn_mfma_f32_16x16x32_bf16(af[m], bfv[n], acc[m][n], 0, 0, 0);
        }
    }
}
template <int NW>
__device__ __forceinline__ void zero_acc(f32x4 (&acc)[4][NW]) {
#pragma unroll
    for (int m = 0; m < 4; ++m)
#pragma unroll
        for (int n = 0; n < NW; ++n) acc[m][n] = (f32x4){0.f, 0.f, 0.f, 0.f};
}

__device__ __forceinline__ void store_rope(const f32x4 (&acc)[4][4], bf16_t* dst, int ld, int dcol, float scale, const f32x2* rope, int rowbase, int fr, int fq) {
#pragma unroll
    for (int m = 0; m < 4; ++m)
#pragma unroll
        for (int j = 0; j < 4; ++j) {
            const int t = rowbase + m * 16 + fq * 4 + j;
#pragma unroll
            for (int nn = 0; nn < 2; ++nn) {
                const f32x2 cs = rope[(size_t)t * 32 + nn * 16 + fr];
                const float x1 = acc[m][nn][j], x2 = acc[m][nn + 2][j];
                dst[(size_t)t * ld + dcol + nn * 16 + fr] = f2bf((x1 * cs.x - x2 * cs.y) * scale);
                dst[(size_t)t * ld + dcol + (nn + 2) * 16 + fr] = f2bf((x2 * cs.x + x1 * cs.y) * scale);
            }
        }
}
__device__ __forceinline__ void store_plain(const f32x4 (&acc)[4][4], bf16_t* dst, int ld, int dcol, float scale, int act, int rowbase, int fr, int fq) {
#pragma unroll
    for (int m = 0; m < 4; ++m)
#pragma unroll
        for (int j = 0; j < 4; ++j) {
            const int t = rowbase + m * 16 + fq * 4 + j;
#pragma unroll
            for (int n = 0; n < 4; ++n) {
                float v = acc[m][n][j] * scale;
                if (act == 1) v = sigmoidf_(v);
                else if (act == 2) v = siluf_(v);
                dst[(size_t)t * ld + dcol + n * 16 + fr] = f2bf(v);
            }
        }
}
__device__ __forceinline__ void store_trans(const f32x4 (&acc)[4][4], bf16_t* dstT, int rows_per_b, int rowoff, int rowbase, int fr, int fq) {
#pragma unroll
    for (int m = 0; m < 4; ++m) {
        const int t = rowbase + m * 16 + fq * 4;
        const int b = t >> 11, s = t & 2047;
#pragma unroll
        for (int n = 0; n < 4; ++n) {
            u32x2 u; u.x = pack2(acc[m][n][0], acc[m][n][1]); u.y = pack2(acc[m][n][2], acc[m][n][3]);
            *(u32x2*)(dstT + ((size_t)b * rows_per_b + rowoff + n * 16 + fr) * 2048 + s) = u;
        }
    }
}

constexpr int LDE = 136;
template <int NW>
__device__ __forceinline__ void lds_put_tile(bf16_t* sT, const f32x4 (&acc)[4][NW], int wr, int wc, int fr, int fq) {
#pragma unroll
    for (int m = 0; m < 4; ++m)
#pragma unroll
        for (int j = 0; j < 4; ++j)
#pragma unroll
            for (int n = 0; n < NW; ++n) sT[(wr * 64 + m * 16 + fq * 4 + j) * LDE + wc * (16 * NW) + n * 16 + fr] = f2bf(acc[m][n][j]);
}
__device__ __forceinline__ void lds_put_tile_t(bf16_t* sT, const f32x4 (&acc)[4][4], int wr, int wc, int fr, int fq) {
#pragma unroll
    for (int m = 0; m < 4; ++m)
#pragma unroll
        for (int n = 0; n < 4; ++n) {
            u32x2 u; u.x = pack2(acc[m][n][0], acc[m][n][1]); u.y = pack2(acc[m][n][2], acc[m][n][3]);
            *(u32x2*)(sT + (wc * 64 + n * 16 + fr) * LDE + wr * 64 + m * 16 + fq * 4) = u;
        }
}
__device__ __forceinline__ void rope_acc(f32x4 (&acc)[4][4], float scale, const f32x2* rope, int rowbase, int fr, int fq) {
    const f32x2* rp = rope + (size_t)(rowbase + fq * 4) * 32 + fr;
#pragma unroll
    for (int m = 0; m < 4; ++m) {
#pragma unroll
        for (int j = 0; j < 4; ++j) {
#pragma unroll
            for (int nn = 0; nn < 2; ++nn) {
                const f32x2 cs = rp[(m * 16 + j) * 32 + nn * 16];
                const float cc = cs.x * scale, sn = cs.y * scale;
                const float x1 = acc[m][nn][j], x2 = acc[m][nn + 2][j];
                acc[m][nn][j] = __fmaf_rn(x1, cc, -(x2 * sn));
                acc[m][nn + 2][j] = __fmaf_rn(x2, cc, x1 * sn);
            }
            if (j & 1) __builtin_amdgcn_sched_barrier(0);
        }
    }
}
__device__ __forceinline__ void scale_act_acc(f32x4 (&acc)[4][4], float scale, int act) {
#pragma unroll
    for (int m = 0; m < 4; ++m)
#pragma unroll
        for (int n = 0; n < 4; ++n)
#pragma unroll
            for (int j = 0; j < 4; ++j) {
                float v = acc[m][n][j] * scale;
                if (act == 1) v = sigmoidf_(v);
                else if (act == 2) v = siluf_(v);
                acc[m][n][j] = v;
            }
}
struct SegDst { bf16_t* rm; int ld; int dcol; bf16_t* tr; int tr_rows; int tr_off; int kind; };
__device__ __forceinline__ SegDst seg_dst(unsigned char* r1, int c0) {
    SegDst d; d.rm = nullptr; d.ld = 0; d.dcol = 0; d.tr = nullptr; d.tr_rows = 0; d.tr_off = 0; d.kind = 0;
    if (c0 < C_CKV) { d.rm = (bf16_t*)(r1 + R1_QA); d.ld = 512; d.dcol = c0 - C_QA; d.kind = 1; }
    else if (c0 < C_IQ) { d.kind = 0; }
    else if (c0 < C_IK) { d.rm = (bf16_t*)(r1 + R1_IQ); d.ld = 256; d.dcol = c0 - C_IQ; d.kind = 1; }
    else if (c0 < C_IW) { d.rm = (bf16_t*)(r1 + R1_IK); d.ld = 64; d.dcol = 0; d.kind = 1; }
    else if (c0 < C_QB) { d.kind = 0; }
    else if (c0 < C_KB) { d.rm = (bf16_t*)(r1 + R1_QB); d.ld = 512; d.dcol = c0 - C_QB; d.kind = 1; }
    else if (c0 < C_VB) { d.rm = (bf16_t*)(r1 + R1_KB); d.ld = 512; d.dcol = c0 - C_KB; d.kind = 1; }
    else if (c0 < C_QC) { d.tr = (bf16_t*)(r1 + R1_VBT); d.tr_rows = 512; d.tr_off = c0 - C_VB; d.kind = 2; }
    else if (c0 < C_KC) { d.rm = (bf16_t*)(r1 + R1_QC); d.ld = 512; d.dcol = c0 - C_QC; d.kind = 1; }
    else if (c0 < C_VC) { d.rm = (bf16_t*)(r1 + R1_KC); d.ld = 512; d.dcol = c0 - C_KC; d.tr = (bf16_t*)(r1 + R1_KCT); d.tr_rows = 512; d.tr_off = c0 - C_KC; d.kind = 3; }
    else if (c0 < C_GC) { d.tr = (bf16_t*)(r1 + R1_VCT); d.tr_rows = 1024; d.tr_off = c0 - C_VC; d.kind = 2; }
    else if (c0 < C_GATES) { d.rm = (bf16_t*)(r1 + R1_GC); d.ld = 1024; d.dcol = c0 - C_GC; d.kind = 1; }
    else if (c0 < C_KA) { d.tr = (bf16_t*)(r1 + R1_GATES); d.tr_rows = 3072; d.tr_off = c0 - C_GATES; d.kind = 2; }
    else if (c0 < C_VA) { d.rm = (bf16_t*)(r1 + R1_KA); d.ld = 64; d.dcol = 0; d.kind = 1; }
    else { d.tr = (bf16_t*)(r1 + R1_VAT); d.tr_rows = 64; d.tr_off = 0; d.kind = 2; }
    return d;
}

__device__ __forceinline__ void ph_gemm_z(const Params& p, unsigned char* smem) {
    bf16_t* sT = (bf16_t*)smem;
    const int tid = ltid(), lane = tid & 63, wid = __builtin_amdgcn_readfirstlane(tid >> 6), wr = wid >> 1, wc = wid & 1, fr = lane & 15, fq = lane >> 4;
    const bf16_t* H = (const bf16_t*)(p.ws + OFF_H);
    const bf16_t* WinT = (const bf16_t*)(p.ws + OFF_WB) + WB_WIN;
    const int xcd = blockIdx.x & 7, jb = blockIdx.x >> 3, nper = gridDim.x >> 3;
    for (int q = jb; q < 1120; q += nper) {
        const int half = q / 560, rem = q % 560, nt = rem >> 3, mtl = rem & 7;
        const int mt = 16 * xcd + 8 * half + mtl;
        const int m0 = mt * 128, n0 = nt * 128;
        unsigned ao[4], bo[4];
#pragma unroll
        for (int i = 0; i < 4; ++i) {
            const int R = stg_row(tid, i, 4), g = stg_chunk(tid, i);
            ao[i] = (unsigned)(m0 + R) * 1024u + g * 8;
            bo[i] = (unsigned)(n0 + R) * 1024u + g * 8;
        }
        f32x4 acc[4][4];
        zero_acc<4>(acc);
        gemm_kloop2<4>(acc, H, ao, WinT, bo, 1024, smem, tid);
        int te = tid; asm volatile("" : "+v"(te));
        const int fre = te & 15, fqe = (te & 63) >> 4;
        const Params& pe = getp();
        unsigned char* r1 = pe.ws + OFF_R1;
        const f32x2* rope = (const f32x2*)(pe.ws + OFF_ROPE);
        const int c0 = n0 + wc * 64;
        const int rowbase = m0 + wr * 64;
        if (c0 < C_CKV) rope_acc(acc, 0.125f, rope, rowbase, fre, fqe);
        else if (c0 < C_IQ) {
            float* ss = (float*)(pe.ws + OFF_CKVSS);
            const int blk = (c0 - C_CKV) >> 6;
#pragma unroll
            for (int m = 0; m < 4; ++m)
#pragma unroll
                for (int j = 0; j < 4; ++j) {
                    float sq = 0.f;
#pragma unroll
                    for (int n = 0; n < 4; ++n) sq += acc[m][n][j] * acc[m][n][j];
                    sq += __shfl_xor(sq, 1); sq += __shfl_xor(sq, 2); sq += __shfl_xor(sq, 4); sq += __shfl_xor(sq, 8);
                    if (fre == 0) ss[(size_t)(rowbase + m * 16 + fqe * 4 + j) * 4 + blk] = sq;
                }
        }
        else if (c0 < C_IK) rope_acc(acc, 1.0f, rope, rowbase, fre, fqe);
        else if (c0 < C_IW) rope_acc(acc, 1.0f, rope, rowbase, fre, fqe);
        else if (c0 < C_QB) {
            float* iw = (float*)(pe.ws + OFF_IW);
            if (fre < 4) {
#pragma unroll
                for (int m = 0; m < 4; ++m)
#pragma unroll
                    for (int j = 0; j < 4; ++j) iw[(size_t)(rowbase + m * 16 + fqe * 4 + j) * 4 + fre] = acc[m][0][j] * 0.0625f;
            }
        }
        else if (c0 < C_KB) scale_act_acc(acc, 0.125f, 0);
        else if (c0 < C_QC) { }
        else if (c0 < C_KC) rope_acc(acc, 1.0f, rope, rowbase, fre, fqe);
        else if (c0 < C_VC) rope_acc(acc, 0.125f, rope, rowbase, fre, fqe);
        else if (c0 < C_GC) { }
        else if (c0 < C_GATES) scale_act_acc(acc, 1.0f, 2);
        else if (c0 < C_KA) scale_act_acc(acc, 1.0f, 1);
        else if (c0 < C_VA) rope_acc(acc, 1.0f, rope, rowbase, fre, fqe);
        const SegDst dw = seg_dst(r1, c0);
        const SegDst d0 = seg_dst(r1, n0), d1 = seg_dst(r1, n0 + 64);
        const int anyrm = (d0.kind | d1.kind) & 1, anytr = (d0.kind | d1.kind) & 2;
        __syncthreads();
        if (anyrm) {
            if (dw.kind & 1) lds_put_tile<4>(sT, acc, wr, wc, fre, fqe);
            __syncthreads();
#pragma unroll
            for (int hh = 0; hh < 2; ++hh) {
                const SegDst& d = hh ? d1 : d0;
                if (d.kind & 1) {
#pragma unroll
                    for (int i = 0; i < 4; ++i) {
                        const int c = te + 256 * i, row = c >> 3, ch = c & 7;
                        *(u32x4*)(d.rm + (size_t)(m0 + row) * d.ld + d.dcol + ch * 8) = *(const u32x4*)(sT + row * LDE + hh * 64 + ch * 8);
                    }
                }
            }
        }
        if (anytr) {
            __syncthreads();
            if (dw.kind & 2) lds_put_tile_t(sT, acc, wr, wc, fre, fqe);
            __syncthreads();
            const int b = m0 >> 11, s0 = m0 & 2047;
#pragma unroll
            for (int hh = 0; hh < 2; ++hh) {
                const SegDst& d = hh ? d1 : d0;
                if (d.kind & 2) {
#pragma unroll
                    for (int i = 0; i < 4; ++i) {
                        const int c = te + 256 * i, erow = c >> 4, ch = c & 15;
                        *(u32x4*)(d.tr + ((size_t)b * d.tr_rows + d.tr_off + erow) * 2048 + s0 + ch * 8) = *(const u32x4*)(sT + (hh * 64 + erow) * LDE + ch * 8);
                    }
                }
            }
        }
    }
}

struct __attribute__((aligned(16))) AttnLds { bf16_t K[64 * LDT]; bf16_t Vt[64 * LDT]; float rs[64]; };

__device__ __forceinline__ void tile64_load(u32x4 (&r)[2], const bf16_t* src, size_t src_ld, int tid) {
#pragma unroll
    for (int i = 0; i < 2; ++i) {
        const int c = tid + 256 * i, row = c >> 3, col8 = (c & 7) * 8;
        r[i] = *(const u32x4*)(src + (size_t)row * src_ld + col8);
    }
}
__device__ __forceinline__ void tile64_put(bf16_t* dst, const u32x4 (&r)[2], int tid) {
#pragma unroll
    for (int i = 0; i < 2; ++i) {
        const int c = tid + 256 * i, row = c >> 3, col8 = (c & 7) * 8;
        *(u32x4*)(dst + row * LDT + col8) = r[i];
    }
}
__device__ __forceinline__ void stage_tile64(bf16_t* dst, const bf16_t* src, size_t src_ld, int tid) {
#pragma unroll
    for (int i = 0; i < 2; ++i) {
        const int c = tid + 256 * i, row = c >> 3, col8 = (c & 7) * 8;
        *(u32x4*)(dst + row * LDT + col8) = *(const u32x4*)(src + (size_t)row * src_ld + col8);
    }
}

__device__ __forceinline__ void sb_tile(const AttnLds& sm, const bf16x8 (&qf)[2], f32x4 (&O)[4], float& R, bool diag, int tl, int fr, int fq) {
    f32x4 st[4];
#pragma unroll
    for (int mk = 0; mk < 4; ++mk) {
        st[mk] = (f32x4){0.f, 0.f, 0.f, 0.f};
#pragma unroll
        for (int ks = 0; ks < 2; ++ks) {
            bf16x8 kf = *(const bf16x8*)(sm.K + (mk * 16 + fr) * LDT + ks * 32 + fq * 8);
            st[mk] = __builtin_amdgcn_mfma_f32_16x16x32_bf16(kf, qf[ks], st[mk], 0, 0, 0);
        }
    }
    float Bv[4][4], Om[4][4], P[4];
#pragma unroll
    for (int mk = 0; mk < 4; ++mk) {
        P[mk] = 1.f;
#pragma unroll
        for (int r = 0; r < 4; ++r) {
            const float z = st[mk][r];
            const bool valid = !diag || (16 * mk + 4 * fq + r < tl);
            const float e = __expf(-fabsf(z));
            const float sg = __builtin_amdgcn_rcpf(1.0f + e);
            const float es = e * sg;
            const float beta = (z >= 0.f) ? sg : es, om = (z >= 0.f) ? es : sg;
            Bv[mk][r] = valid ? beta : 0.f;
            Om[mk][r] = valid ? om : 1.f;
            P[mk] *= Om[mk][r];
        }
    }
    float tot[4], above[4];
#pragma unroll
    for (int mk = 0; mk < 4; ++mk) {
        auto sw = __builtin_amdgcn_permlane16_swap(__float_as_uint(P[mk]), __float_as_uint(P[mk]), false, false);
        const float po = __uint_as_float(sw[1]);
        const float pair = __uint_as_float(sw[0]) * po;
        auto tw = __builtin_amdgcn_permlane32_swap(__float_as_uint(pair), __float_as_uint(pair), false, false);
        const float hi = __uint_as_float(tw[1]);
        tot[mk] = __uint_as_float(tw[0]) * hi;
        above[mk] = ((fq & 1) ? 1.f : po) * ((fq < 2) ? hi : 1.f);
    }
    float higher[4];
    higher[3] = 1.f; higher[2] = tot[3]; higher[1] = tot[3] * tot[2]; higher[0] = tot[3] * tot[2] * tot[1];
    float A[4][4];
#pragma unroll
    for (int mk = 0; mk < 4; ++mk) {
        float suf = above[mk] * higher[mk] * R;
#pragma unroll
        for (int r = 3; r >= 0; --r) {
            A[mk][r] = Bv[mk][r] * suf;
            suf *= Om[mk][r];
        }
    }
    R *= (tot[0] * tot[1]) * (tot[2] * tot[3]);
#pragma unroll
    for (int ks = 0; ks < 2; ++ks) {
        u32x4 uu = (u32x4){pack2(A[2 * ks][0], A[2 * ks][1]), pack2(A[2 * ks][2], A[2 * ks][3]),
                           pack2(A[2 * ks + 1][0], A[2 * ks + 1][1]), pack2(A[2 * ks + 1][2], A[2 * ks + 1][3])};
        bf16x8 pf = *(bf16x8*)&uu;
#pragma unroll
        for (int me = 0; me < 4; ++me) {
            const bf16_t* vp = sm.Vt + (me * 16 + fr) * LDT + ks * 32 + 4 * fq;
            u32x2 lo = *(const u32x2*)vp, hi = *(const u32x2*)(vp + 16);
            u32x4 vv = (u32x4){lo.x, lo.y, hi.x, hi.y};
            O[me] = __builtin_amdgcn_mfma_f32_16x16x32_bf16(*(bf16x8*)&vv, pf, O[me], 0, 0, 0);
        }
    }
}
__device__ __forceinline__ void mixb_item(const Params& p, int item, unsigned char* smem) {
    AttnLds& sm = *(AttnLds*)smem;
    const int tid = ltid(), lane = tid & 63, w = __builtin_amdgcn_readfirstlane(tid >> 6), fr = lane & 15, fq = lane >> 4;
    unsigned char* r1 = p.ws + OFF_R1;
    bf16_t* QB = (bf16_t*)(r1 + R1_QB);
    const bf16_t* KB = (const bf16_t*)(r1 + R1_KB);
    const bf16_t* VBT = (const bf16_t*)(r1 + R1_VBT);
    {
        const int qt2 = 15 - (item >> 6), bh = item & 63, b = bh >> 3, h = bh & 7;
        const int tl = 16 * w + fr;
        const int tq0 = b * 2048 + qt2 * 128 + tl, tq1 = tq0 + 64;
        bf16x8 qf0[2], qf1[2];
#pragma unroll
        for (int ks = 0; ks < 2; ++ks) {
            qf0[ks] = *(const bf16x8*)(QB + (size_t)tq0 * 512 + h * 64 + ks * 32 + fq * 8);
            qf1[ks] = *(const bf16x8*)(QB + (size_t)tq1 * 512 + h * 64 + ks * 32 + fq * 8);
        }
        f32x4 O0[4], O1[4];
#pragma unroll
        for (int me = 0; me < 4; ++me) { O0[me] = (f32x4){0.f, 0.f, 0.f, 0.f}; O1[me] = (f32x4){0.f, 0.f, 0.f, 0.f}; }
        float R0 = 1.f, R1 = 1.f;
        const int ktop = 2 * qt2 + 1;
        for (int kt = ktop; kt >= 0; --kt) {
            __syncthreads();
            stage_tile64(sm.K, KB + (size_t)(b * 2048 + kt * 64) * 512 + h * 64, 512, tid);
            stage_tile64(sm.Vt, VBT + ((size_t)(b * 8 + h) * 64) * 2048 + kt * 64, 2048, tid);
            __syncthreads();
            sb_tile(sm, qf1, O1, R1, kt == ktop, tl, fr, fq);
            if (kt < ktop) sb_tile(sm, qf0, O0, R0, kt == ktop - 1, tl, fr, fq);
        }
        const int ts = ltid();
        const int fqs = (ts & 63) >> 4;
        const int tqs0 = b * 2048 + qt2 * 128 + 16 * (ts >> 6) + (ts & 15), tqs1 = tqs0 + 64;
#pragma unroll
        for (int me = 0; me < 4; ++me) {
            u32x2 u; u.x = pack2(O0[me][0], O0[me][1]); u.y = pack2(O0[me][2], O0[me][3]);
            *(u32x2*)(QB + (size_t)tqs0 * 512 + h * 64 + me * 16 + 4 * fqs) = u;
            u32x2 v; v.x = pack2(O1[me][0], O1[me][1]); v.y = pack2(O1[me][2], O1[me][3]);
            *(u32x2*)(QB + (size_t)tqs1 * 512 + h * 64 + me * 16 + 4 * fqs) = v;
        }
    }
}

struct __attribute__((aligned(16))) RetLds { bf16_t K[64 * LDT]; bf16_t KT[64 * LDT]; bf16_t VT[128 * LDT]; bf16_t ST[128 * LDT]; };
struct __attribute__((aligned(16))) RetLds3 { bf16_t K[64 * LDT]; bf16_t VT[128 * LDT]; bf16_t ST[128 * LDT]; };

__device__ __forceinline__ void mixc1_item(const Params& p, int item, unsigned char* smem) {
    RetLds& sm = *(RetLds*)smem;
    const int tid = ltid(), lane = tid & 63, w = __builtin_amdgcn_readfirstlane(tid >> 6), fr = lane & 15, fq = lane >> 4;
    unsigned char* r1 = p.ws + OFF_R1;
    const bf16_t* KCT = (const bf16_t*)(r1 + R1_KCT);
    const bf16_t* VCT = (const bf16_t*)(r1 + R1_VCT);
    bf16_t* KVT = (bf16_t*)(p.ws + OFF_H);
    const int bh = item >> 5, n = item & 31, h = bh & 7;
    const float lg = LOGG[h];
    u32x4 rkt[2], rvt[4];
#pragma unroll
    for (int i = 0; i < 2; ++i) {
        const int c = tid + 256 * i, row = c >> 3, col8 = (c & 7) * 8;
        rkt[i] = *(const u32x4*)(KCT + ((size_t)bh * 64 + row) * 2048 + n * 64 + col8);
    }
#pragma unroll
    for (int i = 0; i < 4; ++i) {
        const int c = tid + 256 * i, row = c >> 3, col8 = (c & 7) * 8;
        rvt[i] = *(const u32x4*)(VCT + ((size_t)bh * 128 + row) * 2048 + n * 64 + col8);
    }
    __syncthreads();
#pragma unroll
    for (int i = 0; i < 2; ++i) {
        const int c = tid + 256 * i, row = c >> 3, col8 = (c & 7) * 8;
        unsigned uu[4] = {rkt[i].x, rkt[i].y, rkt[i].z, rkt[i].w};
#pragma unroll
        for (int q = 0; q < 4; ++q) {
            const float z0 = __expf(lg * (float)(63 - (col8 + 2 * q))), z1 = __expf(lg * (float)(63 - (col8 + 2 * q + 1)));
            uu[q] = pack2(__uint_as_float(uu[q] << 16) * z0, __uint_as_float(uu[q] & 0xffff0000u) * z1);
        }
        *(u32x4*)(sm.KT + row * LDT + col8) = (u32x4){uu[0], uu[1], uu[2], uu[3]};
    }
#pragma unroll
    for (int i = 0; i < 4; ++i) {
        const int c = tid + 256 * i, row = c >> 3, col8 = (c & 7) * 8;
        *(u32x4*)(sm.VT + row * LDT + col8) = rvt[i];
    }
    __syncthreads();
    f32x4 sacc[4][2];
#pragma unroll
    for (int md = 0; md < 4; ++md)
#pragma unroll
        for (int ne = 0; ne < 2; ++ne) sacc[md][ne] = (f32x4){0.f, 0.f, 0.f, 0.f};
#pragma unroll
    for (int ks = 0; ks < 2; ++ks) {
        bf16x8 vf[2];
#pragma unroll
        for (int ne = 0; ne < 2; ++ne) vf[ne] = *(const bf16x8*)(sm.VT + (32 * w + ne * 16 + fr) * LDT + ks * 32 + fq * 8);
#pragma unroll
        for (int md = 0; md < 4; ++md) {
            bf16x8 kf = *(const bf16x8*)(sm.KT + (md * 16 + fr) * LDT + ks * 32 + fq * 8);
#pragma unroll
            for (int ne = 0; ne < 2; ++ne) sacc[md][ne] = __builtin_amdgcn_mfma_f32_16x16x32_bf16(kf, vf[ne], sacc[md][ne], 0, 0, 0);
        }
    }
    bf16_t* dst = KVT + (size_t)item * 128 * 64;
#pragma unroll
    for (int md = 0; md < 4; ++md)
#pragma unroll
        for (int ne = 0; ne < 2; ++ne) {
            u32x2 u; u.x = pack2(sacc[md][ne][0], sacc[md][ne][1]); u.y = pack2(sacc[md][ne][2], sacc[md][ne][3]);
            *(u32x2*)(dst + (32 * w + ne * 16 + fr) * 64 + md * 16 + 4 * fq) = u;
        }
}
__device__ __forceinline__ void ph_mixc2(const Params& p) {
    bf16_t* KVT = (bf16_t*)(p.ws + OFF_H);
    for (int idx = blockIdx.x * 256 + ltid(); idx < 64 * 128 * 16; idx += gridDim.x * 256) {
        const int bh = idx >> 11, ed = idx & 2047;
        const float g64 = __expf(LOGG[bh & 7] * 64.0f);
        bf16_t* pp = KVT + (size_t)bh * 32 * 8192 + (size_t)ed * 4;
        float s0 = 0.f, s1 = 0.f, s2 = 0.f, s3 = 0.f;
#pragma unroll 4
        for (int n = 0; n < 32; ++n) {
            u32x2 kv = *(const u32x2*)(pp + (size_t)n * 8192);
            u32x2 o; o.x = pack2(s0, s1); o.y = pack2(s2, s3);
            *(u32x2*)(pp + (size_t)n * 8192) = o;
            s0 = s0 * g64 + __uint_as_float(kv.x << 16); s1 = s1 * g64 + __uint_as_float(kv.x & 0xffff0000u);
            s2 = s2 * g64 + __uint_as_float(kv.y << 16); s3 = s3 * g64 + __uint_as_float(kv.y & 0xffff0000u);
        }
    }
}
__device__ __forceinline__ void mixc3_item(const Params& p, int l, int item, unsigned char* smem) {
    RetLds3& sm = *(RetLds3*)smem;
    const int tid = ltid(), lane = tid & 63, w = __builtin_amdgcn_readfirstlane(tid >> 6), fr = lane & 15, fq = lane >> 4;
    unsigned char* r1 = p.ws + OFF_R1;
    const bf16_t* QC = (const bf16_t*)(r1 + R1_QC);
    const bf16_t* KC = (const bf16_t*)(r1 + R1_KC);
    const bf16_t* VCT = (const bf16_t*)(r1 + R1_VCT);
    const bf16_t* KVT = (const bf16_t*)(p.ws + OFF_H);
    bf16_t* GC = (bf16_t*)(r1 + R1_GC);
    {
        const int bh = item >> 5, n = item & 31, b = bh >> 3, h = bh & 7;
        const float lg = LOGG[h];
        const int al = 16 * w + fr;
        const float xi = __expf(lg * (float)(al + 1));
        {
            const int tok0 = b * 2048 + n * 64;
            u32x4 rk[2], rvt[4], rst[4];
            bf16x8 qf[2];
#pragma unroll
            for (int ks = 0; ks < 2; ++ks) qf[ks] = *(const bf16x8*)(QC + (size_t)(tok0 + 16 * w + fr) * 512 + h * 64 + ks * 32 + fq * 8);
            tile64_load(rk, KC + (size_t)tok0 * 512 + h * 64, 512, tid);
#pragma unroll
            for (int i = 0; i < 4; ++i) {
                const int c = tid + 256 * i, row = c >> 3, col8 = (c & 7) * 8;
                rvt[i] = *(const u32x4*)(VCT + ((size_t)bh * 128 + row) * 2048 + n * 64 + col8);
                rst[i] = *(const u32x4*)(KVT + (size_t)item * 8192 + row * 64 + col8);
            }
            __syncthreads();
            tile64_put(sm.K, rk, tid);
#pragma unroll
            for (int i = 0; i < 4; ++i) {
                const int c = tid + 256 * i, row = c >> 3, col8 = (c & 7) * 8;
                *(u32x4*)(sm.VT + row * LDT + col8) = rvt[i];
                *(u32x4*)(sm.ST + row * LDT + col8) = rst[i];
            }
            __syncthreads();
            f32x4 st[4];
#pragma unroll
            for (int mc = 0; mc < 4; ++mc) {
                st[mc] = (f32x4){0.f, 0.f, 0.f, 0.f};
#pragma unroll
                for (int ks = 0; ks < 2; ++ks) {
                    bf16x8 kf = *(const bf16x8*)(sm.K + (mc * 16 + fr) * LDT + ks * 32 + fq * 8);
                    st[mc] = __builtin_amdgcn_mfma_f32_16x16x32_bf16(kf, qf[ks], st[mc], 0, 0, 0);
                }
#pragma unroll
                for (int r = 0; r < 4; ++r) {
                    const int cc = 16 * mc + 4 * fq + r;
                    st[mc][r] *= __expf(lg * fabsf((float)(al - cc)));
                }
            }
            f32x4 o[8];
#pragma unroll
            for (int me = 0; me < 8; ++me) {
                o[me] = (f32x4){0.f, 0.f, 0.f, 0.f};
#pragma unroll
                for (int ks = 0; ks < 2; ++ks) {
                    bf16x8 sf = *(const bf16x8*)(sm.ST + (me * 16 + fr) * LDT + ks * 32 + fq * 8);
                    o[me] = __builtin_amdgcn_mfma_f32_16x16x32_bf16(sf, qf[ks], o[me], 0, 0, 0);
                }
                o[me] *= xi;
            }
#pragma unroll
            for (int ks = 0; ks < 2; ++ks) {
                bf16x8 pf;
                {
                    u32x4 uu = (u32x4){pack2(st[2 * ks][0], st[2 * ks][1]), pack2(st[2 * ks][2], st[2 * ks][3]),
                                          pack2(st[2 * ks + 1][0], st[2 * ks + 1][1]), pack2(st[2 * ks + 1][2], st[2 * ks + 1][3])};
                    pf = *(bf16x8*)&uu;
                }
#pragma unroll
                for (int me = 0; me < 8; ++me) {
                    const bf16_t* vp = sm.VT + (me * 16 + fr) * LDT + ks * 32 + 4 * fq;
                    u32x2 lo = *(const u32x2*)vp, hi = *(const u32x2*)(vp + 16);
                    u32x4 vv = (u32x4){lo.x, lo.y, hi.x, hi.y};
                    o[me] = __builtin_amdgcn_mfma_f32_16x16x32_bf16(*(bf16x8*)&vv, pf, o[me], 0, 0, 0);
                }
            }
            {
                float s1 = 0.f;
#pragma unroll
                for (int me = 0; me < 8; ++me) s1 += (o[me][0] + o[me][1]) + (o[me][2] + o[me][3]);
                s1 = xrow16_sum(s1);
                const float mu = s1 * (1.0f / 128.0f);
                float s2 = 0.f;
#pragma unroll
                for (int me = 0; me < 8; ++me)
#pragma unroll
                    for (int r = 0; r < 4; ++r) { const float d = o[me][r] - mu; s2 += d * d; }
                s2 = xrow16_sum(s2);
                const float rstd = rsqrtf(s2 * (1.0f / 128.0f) + EPS_);
                bf16_t* gp = GC + (size_t)(tok0 + al) * 1024 + h * 128;
                const float* gr = p.g_ret + (size_t)l * 1024 + h * 128;
#pragma unroll
                for (int me = 0; me < 8; ++me) {
                    const int e0 = me * 16 + 4 * fq;
                    u32x2 gu = *(const u32x2*)(gp + e0);
                    f32x4 g4 = *(const f32x4*)(gr + e0);
                    const float y0 = (o[me][0] - mu) * rstd * g4[0] * __uint_as_float(gu.x << 16);
                    const float y1 = (o[me][1] - mu) * rstd * g4[1] * __uint_as_float(gu.x & 0xffff0000u);
                    const float y2 = (o[me][2] - mu) * rstd * g4[2] * __uint_as_float(gu.y << 16);
                    const float y3 = (o[me][3] - mu) * rstd * g4[3] * __uint_as_float(gu.y & 0xffff0000u);
                    u32x2 ou; ou.x = pack2(y0, y1); ou.y = pack2(y2, y3);
                    *(u32x2*)(gp + e0) = ou;
                }
            }
        }
    }
}

__device__ __forceinline__ void mixa1_item(const Params& p, int item, unsigned char* smem) {
    float* tau_s = (float*)smem;
    int* stau_s = (int*)(smem + 64);
    const int tid = ltid(), lane = tid & 63, w = __builtin_amdgcn_readfirstlane(tid >> 6), fr = lane & 15, fq = lane >> 4;
    unsigned char* r1 = p.ws + OFF_R1;
    const bf16_t* IQ = (const bf16_t*)(r1 + R1_IQ);
    const bf16_t* IK = (const bf16_t*)(r1 + R1_IK);
    const float* IW = (const float*)(p.ws + OFF_IW);
    float* SC = (float*)(p.ws + OFF_R3);
    unsigned long long* MASKB = (unsigned long long*)(p.ws + OFF_MASKB);
    {
        const int c = 31 - (item >> 5), b = (item >> 2) & 7, qq = item & 3;
        __syncthreads();
        const int nj = c + 1, n = 64 * nj;
        const int tq = b * 2048 + c * 64 + 16 * qq + fr;
        float* scrow = SC + (size_t)b * SC_PER_BATCH + (size_t)2048 * c * (c + 1) + (size_t)(16 * qq + fr) * n;
        bf16x8 iqf[4][2];
        float iw[4];
#pragma unroll
        for (int hh = 0; hh < 4; ++hh) {
            iw[hh] = IW[(size_t)tq * 4 + hh];
#pragma unroll
            for (int ks = 0; ks < 2; ++ks) iqf[hh][ks] = *(const bf16x8*)(IQ + (size_t)tq * 256 + hh * 64 + ks * 32 + fq * 8);
        }
        for (int kt = w; kt < nj; kt += 4) {
            bf16x8 ikf[4][2];
#pragma unroll
            for (int mk = 0; mk < 4; ++mk)
#pragma unroll
                for (int ks = 0; ks < 2; ++ks) ikf[mk][ks] = *(const bf16x8*)(IK + (size_t)(b * 2048 + kt * 64 + mk * 16 + fr) * 64 + ks * 32 + fq * 8);
            f32x4 sc[4];
#pragma unroll
            for (int mk = 0; mk < 4; ++mk) sc[mk] = (f32x4){0.f, 0.f, 0.f, 0.f};
#pragma unroll
            for (int hh = 0; hh < 4; ++hh) {
#pragma unroll
                for (int mk = 0; mk < 4; ++mk) {
                    f32x4 a = (f32x4){0.f, 0.f, 0.f, 0.f};
#pragma unroll
                    for (int ks = 0; ks < 2; ++ks) a = __builtin_amdgcn_mfma_f32_16x16x32_bf16(ikf[mk][ks], iqf[hh][ks], a, 0, 0, 0);
#pragma unroll
                    for (int r = 0; r < 4; ++r) sc[mk][r] = __fmaf_rn(iw[hh], fmaxf(a[r], 0.f), sc[mk][r]);
                }
            }
#pragma unroll
            for (int mk = 0; mk < 4; ++mk) *(f32x4*)(scrow + kt * 64 + 16 * mk + 4 * fq) = sc[mk];
        }
        __syncthreads();
        for (int i = 0; i < 4; ++i) {
            const int r16 = 4 * w + i;
            float tau = -__builtin_inff();
            int stau = 1 << 30;
            if (nj > 4) {
                const float* rowp = SC + (size_t)b * SC_PER_BATCH + (size_t)2048 * c * (c + 1) + (size_t)(16 * qq + r16) * n;
                unsigned key[32];
#pragma unroll
                for (int j = 0; j < 32; ++j) key[j] = __float_as_uint(rowp[j * 64 + lane]);
#pragma unroll
                for (int j = 0; j < 32; ++j) {
                    const unsigned u0 = key[j];
                    const unsigned u = (u0 == 0x80000000u) ? 0u : u0;
                    const unsigned k = u ^ ((unsigned)((int)u >> 31) | 0x80000000u);
                    key[j] = (j < nj) ? k : 0u;
                }
                unsigned X = 0u;
                for (int bit = 31; bit >= 0; --bit) {
                    const unsigned cand = X | (1u << bit);
                    int cnt = 0;
                    int c0 = 0, c1 = 0;
#pragma unroll
                    for (int j = 0; j < 32; j += 4) {
                        if (j < nj) {
                            c0 = cnt_ge(c0, key[j], cand); c1 = cnt_ge(c1, key[j + 1], cand);
                            c0 = cnt_ge(c0, key[j + 2], cand); c1 = cnt_ge(c1, key[j + 3], cand);
                        }
                    }
                    cnt = wave_total6(c0 + c1);
                    if (cnt >= 256) X = cand;
                    if (cnt == 256) break;
                }
                int cgt = 0;
                {
                    const unsigned candp = X + 1u;
                    int c0 = 0, c1 = 0;
#pragma unroll
                    for (int j = 0; j < 32; j += 2) { c0 = cnt_ge(c0, key[j], candp); c1 = cnt_ge(c1, key[j + 1], candp); }
                    cgt = wave_total6(c0 + c1);
                }
                const int need = 256 - cgt;
                unsigned eqbits = 0u;
#pragma unroll
                for (int j = 0; j < 32; ++j) {
                    const unsigned ne = min(key[j] ^ X, 1u);
                    eqbits |= (1u - ne) << j;
                }
                const int teq = wave_sum_i(__popc(eqbits));
                if (teq == need) {
                    stau = 1 << 30;
                } else {
                    int lo = 0, hi = n - 1;
                    while (lo < hi) {
                        const int mid = (lo + hi) >> 1;
                        const int jmax = (mid - lane) >> 6;
                        const unsigned msk = jmax < 0 ? 0u : (jmax >= 31 ? 0xffffffffu : ((2u << jmax) - 1u));
                        const int cc = wave_sum_i(__popc(eqbits & msk));
                        if (cc >= need) hi = mid; else lo = mid + 1;
                    }
                    stau = lo;
                }
                unsigned long long* mrow = MASKB + (size_t)(b * 2048 + c * 64 + 16 * qq + r16) * 32;
#pragma unroll
                for (int j = 0; j < 32; ++j) {
                    if (j < nj) {
                        const bool sel = (key[j] > X) || (key[j] == X && (j * 64 + lane) <= stau);
                        const unsigned long long mw = __ballot(sel);
                        if (lane == 0) mrow[j] = mw;
                    }
                }
            } else {
                unsigned long long* mrow = MASKB + (size_t)(b * 2048 + c * 64 + 16 * qq + r16) * 32;
                if (lane < nj) mrow[lane] = ~0ull;
            }
        }
        __syncthreads();
        __syncthreads();
    }
}

__device__ __forceinline__ void a2_tile(const unsigned char* sK, const unsigned char* sV, const float* srs, const bf16x8 (&qf)[2], f32x4 (&O)[4], float& mrun, float& lrun, unsigned long long W, int fr, int fq) {
    f32x4 st[4];
    float mx = -1e30f;
    f32x4 rsv[4];
    const int sw = (fr >> 1) & 7;
#pragma unroll
    for (int mk = 0; mk < 4; ++mk) {
        st[mk] = (f32x4){0.f, 0.f, 0.f, 0.f};
#pragma unroll
        for (int ks = 0; ks < 2; ++ks) {
            bf16x8 kf = *(const bf16x8*)(sK + (mk * 16 + fr) * 128 + (((ks * 4 + fq) ^ sw) << 4));
            st[mk] = __builtin_amdgcn_mfma_f32_16x16x32_bf16(kf, qf[ks], st[mk], 0, 0, 0);
        }
        rsv[mk] = *(const f32x4*)(srs + 16 * mk + 4 * fq);
        const unsigned nib = (unsigned)(W >> (16 * mk + 4 * fq)) & 0xfu;
#pragma unroll
        for (int r = 0; r < 4; ++r) {
            st[mk][r] *= rsv[mk][r];
            if ((nib >> r) & 1u) mx = fmaxf(mx, st[mk][r]);
        }
    }
    mx = xrow16_max(mx);
    const float mnew = fmaxf(mrun, mx);
    const float alpha = __expf(mrun - mnew);
    float ps = 0.f;
    float P[4][4];
#pragma unroll
    for (int mk = 0; mk < 4; ++mk) {
        const unsigned nib = (unsigned)(W >> (16 * mk + 4 * fq)) & 0xfu;
#pragma unroll
        for (int r = 0; r < 4; ++r) {
            const float pv = ((nib >> r) & 1u) ? __expf(st[mk][r] - mnew) : 0.f;
            ps += pv;
            P[mk][r] = pv * rsv[mk][r];
        }
    }
    ps = xrow16_sum(ps);
    lrun = lrun * alpha + ps;
    mrun = mnew;
#pragma unroll
    for (int me = 0; me < 4; ++me) O[me] *= alpha;
#pragma unroll
    for (int ks = 0; ks < 2; ++ks) {
        u32x4 uu = (u32x4){pack2(P[2 * ks][0], P[2 * ks][1]), pack2(P[2 * ks][2], P[2 * ks][3]),
                           pack2(P[2 * ks + 1][0], P[2 * ks + 1][1]), pack2(P[2 * ks + 1][2], P[2 * ks + 1][3])};
        bf16x8 pf = *(bf16x8*)&uu;
        const int ca = ((ks * 4 + (fq >> 1)) ^ sw) << 4, hb8 = (fq & 1) * 8;
#pragma unroll
        for (int me = 0; me < 4; ++me) {
            const unsigned char* vp = sV + (me * 16 + fr) * 128 + hb8;
            u32x2 lo = *(const u32x2*)(vp + ca), hi = *(const u32x2*)(vp + (ca ^ 32));
            u32x4 vv = (u32x4){lo.x, lo.y, hi.x, hi.y};
            O[me] = __builtin_amdgcn_mfma_f32_16x16x32_bf16(*(bf16x8*)&vv, pf, O[me], 0, 0, 0);
        }
    }
}
__device__ __forceinline__ void glds_tile64(unsigned char* dst, const bf16_t* src, size_t src_ld, int tid) {
    const int lane = tid & 63, wid = __builtin_amdgcn_readfirstlane(tid >> 6);
#pragma unroll
    for (int j = 0; j < 2; ++j) {
        const int i = wid * 2 + j, row = 8 * i + (lane >> 3), c = (lane & 7) ^ ((4 * i + (lane >> 4)) & 7);
        __builtin_amdgcn_global_load_lds((const unsigned*)(src + (size_t)row * src_ld + c * 8), (LAS unsigned*)(LAS unsigned char*)(dst + i * 1024), 16, 0, 0);
    }
}
constexpr int A2_STG = 8192 + 8192 + 256;
__device__ __forceinline__ int next_item(int* ctr, unsigned char* smem);
__device__ __forceinline__ void ph_mix_a2(const Params& p, int l, unsigned char* smem) {
    const int tid = ltid(), lane = tid & 63, w = __builtin_amdgcn_readfirstlane(tid >> 6), fr = lane & 15, fq = lane >> 4;
    unsigned char* r1 = p.ws + OFF_R1;
    bf16_t* QA = (bf16_t*)(r1 + R1_QA);
    const bf16_t* KA = (const bf16_t*)(r1 + R1_KA);
    const bf16_t* VAT = (const bf16_t*)(r1 + R1_VAT);
    const float* RS = (const float*)(p.ws + OFF_RS);
    const unsigned long long* MASKB = (const unsigned long long*)(p.ws + OFF_MASKB);
    int* a2ctr = (int*)(p.ws + OFF_CTL) + 272 + l * 4;
    for (;;) {
        const int item = next_item(a2ctr, smem);
        if (item >= 1024) break;
        const int c = 31 - (item >> 5), b = (item >> 2) & 7, h0 = (item & 3) * 2;
        const int tq = b * 2048 + c * 64 + 16 * w + fr;
        bf16x8 qf0[2], qf1[2];
#pragma unroll
        for (int ks = 0; ks < 2; ++ks) {
            qf0[ks] = *(const bf16x8*)(QA + (size_t)tq * 512 + h0 * 64 + ks * 32 + fq * 8);
            qf1[ks] = *(const bf16x8*)(QA + (size_t)tq * 512 + (h0 + 1) * 64 + ks * 32 + fq * 8);
        }
        f32x4 O0[4], O1[4];
#pragma unroll
        for (int me = 0; me < 4; ++me) { O0[me] = (f32x4){0.f, 0.f, 0.f, 0.f}; O1[me] = (f32x4){0.f, 0.f, 0.f, 0.f}; }
        float m0r = -1e30f, l0r = 0.f, m1r = -1e30f, l1r = 0.f;
        __syncthreads();
        glds_tile64(smem, KA + (size_t)(b * 2048) * 64, 64, tid);
        glds_tile64(smem + 8192, VAT + ((size_t)b * 64) * 2048, 2048, tid);
        float rsn = RS[b * 2048 + (tid & 63)];
        unsigned long long W = MASKB[(size_t)tq * 32];
        for (int kt = 0; kt <= c; ++kt) {
            unsigned char* cur = smem + (kt & 1) * A2_STG;
            unsigned char* nxt = smem + ((kt & 1) ^ 1) * A2_STG;
            asm volatile("s_waitcnt vmcnt(0)" ::: "memory");
            if (tid < 64) ((float*)(cur + 16384))[tid] = rsn;
            __syncthreads();
            unsigned long long Wn = 0ull;
            if (kt < c) {
                glds_tile64(nxt, KA + (size_t)(b * 2048 + (kt + 1) * 64) * 64, 64, tid);
                glds_tile64(nxt + 8192, VAT + ((size_t)b * 64) * 2048 + (kt + 1) * 64, 2048, tid);
                rsn = RS[b * 2048 + (kt + 1) * 64 + (tid & 63)];
                Wn = MASKB[(size_t)tq * 32 + kt + 1];
            }
            a2_tile(cur, cur + 8192, (const float*)(cur + 16384), qf0, O0, m0r, l0r, W, fr, fq);
            __builtin_amdgcn_sched_barrier(0);
            a2_tile(cur, cur + 8192, (const float*)(cur + 16384), qf1, O1, m1r, l1r, W, fr, fq);
            W = Wn;
        }
        const float inv0 = 1.0f / l0r, inv1 = 1.0f / l1r;
        const int ts = ltid();
        const int fqs = (ts & 63) >> 4;
        const int tqs = b * 2048 + c * 64 + 16 * (ts >> 6) + (ts & 15);
#pragma unroll
        for (int me = 0; me < 4; ++me) {
            u32x2 u; u.x = pack2(O0[me][0] * inv0, O0[me][1] * inv0); u.y = pack2(O0[me][2] * inv0, O0[me][3] * inv0);
            *(u32x2*)(QA + (size_t)tqs * 512 + h0 * 64 + me * 16 + 4 * fqs) = u;
            u32x2 v; v.x = pack2(O1[me][0] * inv1, O1[me][1] * inv1); v.y = pack2(O1[me][2] * inv1, O1[me][3] * inv1);
            *(u32x2*)(QA + (size_t)tqs * 512 + (h0 + 1) * 64 + me * 16 + 4 * fqs) = v;
        }
    }
}

__device__ __forceinline__ void ph_merge(const Params& p, unsigned char* smem) {
    bf16_t* sT = (bf16_t*)smem;
    const int tid = ltid(), lane = tid & 63, wid = __builtin_amdgcn_readfirstlane(tid >> 6), wr = wid >> 1, wc = wid & 1, fr = lane & 15, fq = lane >> 4;
    unsigned char* r1 = p.ws + OFF_R1;
    const bf16_t* WB = (const bf16_t*)(p.ws + OFF_WB);
    const bf16_t* GATES = (const bf16_t*)(r1 + R1_GATES);
    bf16_t* MG = (bf16_t*)(p.ws + OFF_H);
    const int xcd = blockIdx.x & 7, jb = blockIdx.x >> 3, nper = gridDim.x >> 3;
    for (int q = jb; q < 256; q += nper) {
        const int nt = q >> 4, mtl = q & 15;
        const int mt = 16 * xcd + mtl, m0 = mt * 128, n0 = nt * 64;
        f32x4 macc[4][2];
        zero_acc<2>(macc);
#pragma unroll 1
        for (int br = 0; br < 3; ++br) {
            const bf16_t* A = (const bf16_t*)(r1 + (br == 0 ? R1_QA : (br == 1 ? R1_QB : R1_GC)));
            const int K = (br == 2) ? 1024 : 512;
            const bf16_t* Bt = WB + (br == 0 ? WB_WOA : (br == 1 ? WB_WOB : WB_WOC));
            unsigned ao[4], bo[2];
#pragma unroll
            for (int i = 0; i < 4; ++i) ao[i] = (unsigned)(m0 + stg_row(tid, i, 4)) * (unsigned)K + stg_chunk(tid, i) * 8;
#pragma unroll
            for (int i = 0; i < 2; ++i) bo[i] = (unsigned)(n0 + stg_row(tid, i, 2)) * (unsigned)K + stg_chunk(tid, i) * 8;
            f32x4 acc[4][2];
            zero_acc<2>(acc);
            gemm_kloop2<2>(acc, A, ao, Bt, bo, K, smem, tid);
            {
                const int bb = m0 >> 11, s0 = (m0 & 2047) + wr * 64 + fq * 4;
#pragma unroll
                for (int n = 0; n < 2; ++n) {
                    const bf16_t* gp = GATES + ((size_t)bb * 3072 + br * 1024 + n0 + wc * 32 + n * 16 + fr) * 2048 + s0;
#pragma unroll
                    for (int m = 0; m < 4; ++m) {
                        const u32x2 gu = *(const u32x2*)(gp + m * 16);
                        macc[m][n][0] += __uint_as_float(gu.x << 16) * acc[m][n][0];
                        macc[m][n][1] += __uint_as_float(gu.x & 0xffff0000u) * acc[m][n][1];
                        macc[m][n][2] += __uint_as_float(gu.y << 16) * acc[m][n][2];
                        macc[m][n][3] += __uint_as_float(gu.y & 0xffff0000u) * acc[m][n][3];
                    }
                }
            }
        }
        __syncthreads();
        lds_put_tile<2>(sT, macc, wr, wc, fr, fq);
        __syncthreads();
#pragma unroll
        for (int i = 0; i < 4; ++i) {
            const int c = tid + 256 * i, row = c >> 3, ch = c & 7;
            *(u32x4*)(MG + (size_t)(m0 + row) * 1024 + n0 + ch * 8) = *(const u32x4*)(sT + row * LDE + ch * 8);
        }
    }
}

__device__ __forceinline__ void ph_outproj(const Params& p, unsigned char* smem) {
    bf16_t* sT = (bf16_t*)smem;
    const int tid = ltid(), lane = tid & 63, wid = __builtin_amdgcn_readfirstlane(tid >> 6), wr = wid >> 1, wc = wid & 1, fr = lane & 15, fq = lane >> 4;
    const bf16_t* MG = (const bf16_t*)(p.ws + OFF_H);
    const bf16_t* Bt = (const bf16_t*)(p.ws + OFF_WB) + WB_WOUT;
    bf16_t* Y = (bf16_t*)(p.ws + OFF_R1 + R1_QC);
    for (int tile = blockIdx.x; tile < 128 * 8; tile += gridDim.x) {
        const int mt = tile >> 3, nt = tile & 7, m0 = mt * 128, n0 = nt * 128;
        unsigned ao[4], bo[4];
#pragma unroll
        for (int i = 0; i < 4; ++i) {
            const int R = stg_row(tid, i, 4), g = stg_chunk(tid, i);
            ao[i] = (unsigned)(m0 + R) * 1024u + g * 8;
            bo[i] = (unsigned)(n0 + R) * 1024u + g * 8;
        }
        f32x4 acc[4][4];
        zero_acc<4>(acc);
        gemm_kloop2<4>(acc, MG, ao, Bt, bo, 1024, smem, tid);
        __syncthreads();
        lds_put_tile<4>(sT, acc, wr, wc, fr, fq);
        __syncthreads();
#pragma unroll
        for (int i = 0; i < 8; ++i) {
            const int c = tid + 256 * i, row = c >> 4, ch = c & 15;
            *(u32x4*)(Y + (size_t)(m0 + row) * 1024 + n0 + ch * 8) = *(const u32x4*)(sT + row * LDE + ch * 8);
        }
    }
}

__device__ __forceinline__ void ph_router(const Params& p, int l, unsigned char* smem) {
    const int tid = ltid(), lane = tid & 63, wid = __builtin_amdgcn_readfirstlane(tid >> 6), wr = wid >> 1, wc = wid & 1, fr = lane & 15, fq = lane >> 4;
    const bf16_t* H = (const bf16_t*)(p.ws + OFF_H);
    const bf16_t* Bt = (const bf16_t*)(p.ws + OFF_WB) + WB_WR;
    int* cnt = (int*)(p.ws + OFF_CTL) + l * 64;
    int* LIST = (int*)(p.ws + OFF_LIST);
    float* AW = (float*)(p.ws + OFF_AW);
    const float* bias = p.router_bias + l * 64;
    float* lg = (float*)smem;
    int* hist = (int*)(smem + 128 * 65 * 4);
    for (int mt = blockIdx.x; mt < 128; mt += gridDim.x) {
        const int m0 = mt * 128;
        unsigned ao[4], bo[4];
#pragma unroll
        for (int i = 0; i < 4; ++i) {
            const int R = stg_row(tid, i, 4), g = stg_chunk(tid, i);
            ao[i] = (unsigned)(m0 + R) * 1024u + g * 8;
            bo[i] = (unsigned)R * 1024u + g * 8;
        }
        f32x4 acc[4][4];
        zero_acc<4>(acc);
        gemm_kloop2<4>(acc, H, ao, Bt, bo, 1024, smem, tid);
        __syncthreads();
        if (wc == 0) {
#pragma unroll
            for (int m = 0; m < 4; ++m)
#pragma unroll
                for (int j = 0; j < 4; ++j)
#pragma unroll
                    for (int n = 0; n < 4; ++n) lg[(wr * 64 + m * 16 + fq * 4 + j) * 65 + n * 16 + fr] = acc[m][n][j];
        }
        if (tid < 64) hist[tid] = 0;
        int erank[8], ekeep[8];
#pragma unroll
        for (int k = 0; k < 8; ++k) { erank[k] = 0; ekeep[k] = 0; }
        __syncthreads();
        if (tid < 128) {
            float* row = lg + tid * 65;
            const int t = m0 + tid;
            float gs[8];
#pragma unroll
            for (int g = 0; g < 8; ++g) {
                float m1 = -__builtin_inff(), m2 = -__builtin_inff();
#pragma unroll
                for (int e = 0; e < 8; ++e) {
                    const float v = sigmoidf_(row[g * 8 + e]) + bias[g * 8 + e];
                    row[g * 8 + e] = v;
                    if (v > m1) { m2 = m1; m1 = v; } else if (v > m2) m2 = v;
                }
                gs[g] = m1 + m2;
            }
            unsigned gmask = 0u;
#pragma unroll
            for (int g = 0; g < 8; ++g) {
                int rank = 0;
#pragma unroll
                for (int g2 = 0; g2 < 8; ++g2) rank += (gs[g2] > gs[g] || (gs[g2] == gs[g] && g2 < g)) ? 1 : 0;
                if (rank < 4) gmask |= 1u << g;
            }
            unsigned long long taken = 0ull;
            int eidx[8]; float esc[8];
            float ssum = 0.f;
#pragma unroll
            for (int k = 0; k < 8; ++k) {
                float best = -__builtin_inff(); int bi = 0;
                for (int e = 0; e < 64; ++e) {
                    if (!((gmask >> (e >> 3)) & 1u) || ((taken >> e) & 1ull)) continue;
                    const float v = row[e];
                    if (v > best) { best = v; bi = e; }
                }
                taken |= 1ull << bi;
                eidx[k] = bi;
                esc[k] = best - bias[bi];
                ssum += esc[k];
            }
            const float scale = 2.5f / ssum;
#pragma unroll
            for (int k = 0; k < 8; ++k) {
                erank[k] = atomicAdd(&hist[eidx[k]], 1);
                ekeep[k] = eidx[k];
                AW[(size_t)t * 8 + k] = esc[k] * scale;
            }
        }
        __syncthreads();
        if (tid < 64) hist[64 + tid] = atomicAdd(&cnt[tid], hist[tid]);
        __syncthreads();
        if (tid < 128) {
            const int t = m0 + tid;
#pragma unroll
            for (int k = 0; k < 8; ++k) LIST[(size_t)ekeep[k] * T_ + hist[64 + ekeep[k]] + erank[k]] = t * 8 + k;
        }
        __syncthreads();
    }
}

struct __attribute__((aligned(16))) MoeLds { int tstart[66]; int xs[10]; int pad0[20]; int hbase[66]; int pad1[14]; int rowid[128]; };
__device__ __forceinline__ void moe_setup(MoeLds& sm, const int* cnt, int tid) {
    __syncthreads();
    if (tid == 0) {
        int ts = 0, hb = 0;
        for (int e = 0; e < 65; ++e) {
            const int ce = (e < 64) ? cnt[e] : T_;
            sm.tstart[e] = ts; sm.hbase[e] = hb;
            ts += (ce + 127) >> 7; hb += ce;
        }
        sm.tstart[65] = ts; sm.hbase[65] = hb;
        const int xcd = blockIdx.x & 7;
        int acc = 0;
        for (int k = 0; k < 8; ++k) { sm.xs[k] = acc; acc += sm.tstart[k * 8 + xcd + 1] - sm.tstart[k * 8 + xcd]; }
        sm.xs[8] = acc; acc += 16; sm.xs[9] = acc;
    }
    __syncthreads();
}

__device__ __forceinline__ void ph_moe1(const Params& p, int l, unsigned char* smem) {
    MoeLds& sm = *(MoeLds*)(smem + MISC + 64);
    const int tid = ltid(), lane = tid & 63, wid = __builtin_amdgcn_readfirstlane(tid >> 6), wr = wid >> 1, wc = wid & 1, fr = lane & 15, fq = lane >> 4;
    const bf16_t* H = (const bf16_t*)(p.ws + OFF_H);
    const bf16_t* W13 = (const bf16_t*)(p.ws + OFF_WB) + WB_W13;
    const int* cnt = (const int*)(p.ws + OFF_CTL) + l * 64;
    const int* LIST = (const int*)(p.ws + OFF_LIST);
    bf16_t* HID = (bf16_t*)(p.ws + OFF_R3);
    moe_setup(sm, cnt, tid);
    const int xcd = blockIdx.x & 7, jb = blockIdx.x >> 3, nper = gridDim.x >> 3;
    const int nitems = sm.xs[9] * 4;
    for (int item = jb; item < nitems; item += nper) {
        const int rtl = item >> 2, nt = item & 3;
        int k = 0;
        while (sm.xs[k + 1] <= rtl) ++k;
        const int e = (k < 8) ? (k * 8 + xcd) : 64;
        const int mtl = rtl - sm.xs[k] + ((k == 8) ? 16 * xcd : 0);
        const int ce = (e < 64) ? cnt[e] : T_;
        __syncthreads();
        if (tid < 128) {
            const int slot = mtl * 128 + tid;
            int tok = 0;
            if (slot < ce) tok = (e < 64) ? (LIST[(size_t)e * T_ + slot] >> 3) : slot;
            sm.rowid[tid] = tok;
        }
        __syncthreads();
        unsigned ao[4], bo[4];
#pragma unroll
        for (int i = 0; i < 4; ++i) {
            const int R = stg_row(tid, i, 4), g = stg_chunk(tid, i);
            ao[i] = (unsigned)sm.rowid[R] * 1024u + g * 8;
            bo[i] = (unsigned)(e * 512 + nt * 128 + R) * 1024u + g * 8;
        }
        f32x4 acc[4][4];
        zero_acc<4>(acc);
        gemm_kloop2<4>(acc, H, ao, W13, bo, 1024, smem, tid);
        const int hb = sm.hbase[e] + mtl * 128;
        f32x4 hacc[4][2];
#pragma unroll
        for (int m = 0; m < 4; ++m)
#pragma unroll
            for (int nn = 0; nn < 2; ++nn)
#pragma unroll
                for (int j = 0; j < 4; ++j) hacc[m][nn][j] = siluf_(acc[m][nn][j]) * acc[m][nn + 2][j];
        bf16_t* sT = (bf16_t*)smem;
        __syncthreads();
        lds_put_tile<2>(sT, hacc, wr, wc, fr, fq);
        __syncthreads();
        const int ts = ltid();
#pragma unroll
        for (int i = 0; i < 4; ++i) {
            const int c = ts + 256 * i, row = c >> 3, ch = c & 7;
            if (mtl * 128 + row < ce)
                *(u32x4*)(HID + (size_t)(hb + row) * 256 + nt * 64 + ch * 8) = *(const u32x4*)(sT + row * LDE + ch * 8);
        }
    }
}

__device__ __forceinline__ void ph_moe2(const Params& p, int l, unsigned char* smem) {
    MoeLds& sm = *(MoeLds*)(smem + MISC + 64);
    const int tid = ltid(), lane = tid & 63, wid = __builtin_amdgcn_readfirstlane(tid >> 6), wr = wid >> 1, wc = wid & 1, fr = lane & 15, fq = lane >> 4;
    const bf16_t* W2 = (const bf16_t*)(p.ws + OFF_WB) + WB_W2;
    const int* cnt = (const int*)(p.ws + OFF_CTL) + l * 64;
    const int* LIST = (const int*)(p.ws + OFF_LIST);
    const float* AW = (const float*)(p.ws + OFF_AW);
    const bf16_t* HID = (const bf16_t*)(p.ws + OFF_R3);
    bf16_t* SLOTS = (bf16_t*)(p.ws + OFF_R1);
    moe_setup(sm, cnt, tid);
    const int xcd = blockIdx.x & 7, jb = blockIdx.x >> 3, nper = gridDim.x >> 3;
    const int nitems = sm.xs[9] * 8;
    for (int item = jb; item < nitems; item += nper) {
        const int rtl = item >> 3, nt = item & 7;
        int k = 0;
        while (sm.xs[k + 1] <= rtl) ++k;
        const int e = (k < 8) ? (k * 8 + xcd) : 64;
        const int mtl = rtl - sm.xs[k] + ((k == 8) ? 16 * xcd : 0);
        const int ce = (e < 64) ? cnt[e] : T_;
        __syncthreads();
        if (tid < 128) {
            const int slot = mtl * 128 + tid;
            int aid = -1;
            if (slot < ce) aid = (e < 64) ? LIST[(size_t)e * T_ + slot] : (8 * T_ + slot);
            sm.rowid[tid] = aid;
        }
        __syncthreads();
        const int hb = sm.hbase[e] + mtl * 128;
        unsigned ao[4], bo[4];
#pragma unroll
        for (int i = 0; i < 4; ++i) {
            const int R = stg_row(tid, i, 4), g = stg_chunk(tid, i);
            ao[i] = (unsigned)(hb + R) * 256u + g * 8;
            bo[i] = (unsigned)(e * 1024 + nt * 128 + R) * 256u + g * 8;
        }
        f32x4 acc[4][4];
        zero_acc<4>(acc);
        gemm_kloop2<4>(acc, HID, ao, W2, bo, 256, smem, tid);
        const int ts = ltid();
        const int fqs = (ts & 63) >> 4;
#pragma unroll
        for (int m = 0; m < 4; ++m)
#pragma unroll
            for (int j = 0; j < 4; ++j) {
                const int r = wr * 64 + m * 16 + fqs * 4 + j;
                const int aid = sm.rowid[r];
                const float wt = (aid >= 0 && e < 64) ? AW[aid] : 1.0f;
#pragma unroll
                for (int n = 0; n < 4; ++n) acc[m][n][j] *= wt;
            }
        bf16_t* sT = (bf16_t*)smem;
        __syncthreads();
        lds_put_tile<4>(sT, acc, wr, wc, fr, fq);
        __syncthreads();
#pragma unroll
        for (int i = 0; i < 8; ++i) {
            const int c = ts + 256 * i, row = c >> 4, ch = c & 15;
            const int aid = sm.rowid[row];
            if (aid >= 0)
                __builtin_nontemporal_store(*(const u32x4*)(sT + row * LDE + ch * 8), (u32x4*)(SLOTS + (size_t)aid * 1024 + nt * 128 + ch * 8));
        }
    }
}

struct JobDesc { int K, NQ, src_ld, dst_ld, mode, p0, nbatch, which; unsigned src_lstride, src_bs, dst_bs, dst_off; };
constexpr int NJOBS = 12;
__constant__ JobDesc JOBS[NJOBS] = {
    {1024, 8832, NIN_, 1024, 1, 0, 1, 9, 1024u * NIN_, 0u, 0u, (unsigned)WB_WIN},
    {512, 1024, 1024, 512, 0, 0, 1, 14, 512u * 1024u, 0u, 0u, (unsigned)WB_WOA},
    {512, 1024, 1024, 512, 0, 0, 1, 15, 512u * 1024u, 0u, 0u, (unsigned)WB_WOB},
    {1024, 1024, 1024, 1024, 0, 0, 1, 16, 1024u * 1024u, 0u, 0u, (unsigned)WB_WOC},
    {1024, 1024, 1024, 1024, 0, 0, 1, 17, 1024u * 1024u, 0u, 0u, (unsigned)WB_WOUT},
    {1024, 128, 64, 1024, 3, 0, 1, 18, 1024u * 64u, 0u, 0u, (unsigned)WB_WR},
    {1024, 256, 256, 1024, 2, 0, 64, 20, 64u * 1024u * 256u, 1024u * 256u, 512u * 1024u, (unsigned)WB_W13},
    {1024, 256, 256, 1024, 2, 32, 64, 21, 64u * 1024u * 256u, 1024u * 256u, 512u * 1024u, (unsigned)WB_W13},
    {1024, 256, 256, 1024, 2, 0, 1, 23, 1024u * 256u, 0u, 0u, (unsigned)(WB_W13 + (size_t)64 * 512 * 1024)},
    {1024, 256, 256, 1024, 2, 32, 1, 24, 1024u * 256u, 0u, 0u, (unsigned)(WB_W13 + (size_t)64 * 512 * 1024)},
    {256, 1024, 1024, 256, 0, 0, 64, 22, 64u * 256u * 1024u, 256u * 1024u, 1024u * 256u, (unsigned)WB_W2},
    {256, 1024, 1024, 256, 0, 0, 1, 25, 256u * 1024u, 0u, 0u, (unsigned)(WB_W2 + (size_t)64 * 1024 * 256)},
};
__constant__ int JOBPRE[NJOBS + 1] = {0, 2208, 2336, 2464, 2720, 2976, 3008, 7104, 11200, 11264, 11328, 15424, 15488};
__device__ __forceinline__ TJob make_job(const Params& p, int l, int it, int& base) {
    int j = 0;
    while (JOBPRE[j + 1] <= it) ++j;
    const JobDesc d = JOBS[j];
    TJob tj;
    tj.src = ((const float* const*)&p)[d.which] + (size_t)l * d.src_lstride;
    tj.dst = (bf16_t*)(p.ws + OFF_WB) + d.dst_off;
    tj.K = d.K; tj.NQ = d.NQ; tj.src_ld = d.src_ld; tj.dst_ld = d.dst_ld; tj.mode = d.mode; tj.p0 = d.p0; tj.nbatch = d.nbatch; tj.pad = 0;
    tj.src_bs = d.src_bs; tj.dst_bs = d.dst_bs;
    base = JOBPRE[j];
    return tj;
}
__device__ __forceinline__ void tconv_range(const Params& p, int l, unsigned char* smem, int first, int stride, int it0, int it1) {
    float* tile = (float*)smem;
    const int tid = ltid();
    const int total = it1;
    __syncthreads();
    int it = it0 + first;
    f32x4 r[4];
    if (it < total) { int base; const TJob tj = make_job(p, l, it, base); tconv_load(tj, it - base, tid, r); }
    while (it < total) {
        const int nxt = it + stride;
        tconv_put(tid, r, tile);
        __syncthreads();
        if (nxt < total) { int base; const TJob tj = make_job(p, l, nxt, base); tconv_load(tj, nxt - base, tid, r); }
        { int base; const TJob tj = make_job(p, l, it, base); tconv_emit(tj, it - base, tid, tile); }
        __syncthreads();
        it = nxt;
    }
}

constexpr int TC_MIX_END = 3008;
__device__ __forceinline__ void ph_tconv_mix(const Params& p, int l, unsigned char* smem) { tconv_range(p, l, smem, blockIdx.x, gridDim.x, 0, TC_MIX_END); }
constexpr int SMEM_BYTES = DYN_LDS;
__device__ __forceinline__ int next_item(int* ctr, unsigned char* smem) {
    int* s_item = (int*)(smem + MISC);
    __syncthreads();
    if (ltid() == 0) *s_item = atomicAdd(ctr, 1);
    __syncthreads();
    return *s_item;
}
constexpr int TC_CH = 8;
constexpr int TC_NCH = (15488 - TC_MIX_END + TC_CH - 1) / TC_CH;
__device__ __forceinline__ void ph_tconv_moe(const Params& p, int l, unsigned char* smem) {
    int* ctr = (int*)(p.ws + OFF_CTL) + 256 + l * 4;
    for (;;) { const int it = next_item(ctr + 3, smem); if (it >= TC_NCH) break;
        const int a0 = TC_MIX_END + it * TC_CH; tconv_range(p, l, smem, 0, 1, a0, (a0 + TC_CH < JOBPRE[NJOBS]) ? a0 + TC_CH : JOBPRE[NJOBS]); }
}
__device__ __forceinline__ void ph_mix1(const Params& p, int l, unsigned char* smem) {
    int* ctr = (int*)(p.ws + OFF_CTL) + 256 + l * 4;
    {
        const float* CKVSS = (const float*)(p.ws + OFF_CKVSS);
        float* RS = (float*)(p.ws + OFF_RS);
        for (int t = blockIdx.x * 256 + ltid(); t < T_; t += gridDim.x * 256) {
            const f32x4 s4 = *(const f32x4*)(CKVSS + (size_t)t * 4);
            RS[t] = rsqrtf(((s4[0] + s4[1]) + (s4[2] + s4[3])) * (1.0f / 256.0f) + EPS_);
        }
    }
    for (;;) { const int it = next_item(ctr + 0, smem); if (it >= 2048) break; mixc1_item(p, it, smem); }
    for (;;) { const int it = next_item(ctr + 1, smem); if (it >= 1024) break; mixb_item(p, it, smem); }
    for (;;) { const int it = next_item(ctr + 2, smem); if (it >= 1024) break; mixa1_item(p, it, smem); }
}


constexpr size_t OFF_BAR = 16 * KiB;
#define XB_TMO      128
#define XB_XCNT(j)  (256  + 64 * (j))
#define XB_XSUB(j)  (1280 + 64 * (j))
#define XB_XGEN(j)  (2304 + 64 * (j))
#define XB_TOP      3328
#define XB_TOPGEN   3392
#define XCD_BAR_WORDS 3456
#define XB_SPIN_CAP (1u << 18)
__device__ __forceinline__ unsigned xb_ld(unsigned* p)              { return __hip_atomic_load(p, __ATOMIC_RELAXED, __HIP_MEMORY_SCOPE_AGENT); }
__device__ __forceinline__ unsigned xb_add(unsigned* p, unsigned v) { return __hip_atomic_fetch_add(p, v, __ATOMIC_RELAXED, __HIP_MEMORY_SCOPE_AGENT); }
__device__ __forceinline__ unsigned xb_xcc_id() { return (unsigned)__builtin_amdgcn_s_getreg((3 << 11) | 20) & 0xFu; }
#define XB_SPIN(cond, bar) do { unsigned _sp = 0; while (cond) { __builtin_amdgcn_s_sleep(1); \
    if ((++_sp & 255u) == 0u) { if (xb_ld(&(bar)[XB_TMO])) break; if (_sp > XB_SPIN_CAP) { atomicAdd(&(bar)[XB_TMO], 1u); break; } } } } while (0)
__device__ __forceinline__ void xcd_barrier_post(unsigned* bar) {
    if (threadIdx.x == 0) (void)xb_add(&bar[XB_XCNT(xb_xcc_id())], 1u);
}
__device__ __forceinline__ void xcd_barrier_complete(unsigned* bar, unsigned x, unsigned& nloc, unsigned& nx) {
    const unsigned G = gridDim.x * gridDim.y * gridDim.z;
    unsigned sum, cnt, mine, sp = 0u;
    for (;;) {
        sum = 0u; cnt = 0u; mine = 0u;
#pragma unroll
        for (unsigned j = 0; j < 16; ++j) { const unsigned c = xb_ld(&bar[XB_XCNT(j)]); sum += c; cnt += (c > 0u) ? 1u : 0u; mine = (j == x) ? c : mine; }
        if (sum == G) break;
        __builtin_amdgcn_s_sleep(1);
        if ((++sp & 255u) == 0u) { if (xb_ld(&bar[XB_TMO])) break; if (sp > XB_SPIN_CAP) { atomicAdd(&bar[XB_TMO], 1u); break; } }
    }
    nloc = mine > 0u ? mine : 1u; nx = cnt > 0u ? cnt : 1u;
}
__device__ __forceinline__ void xcd_barrier(unsigned* bar, volatile LAS unsigned* st) {
    asm volatile("s_waitcnt vmcnt(0)" ::: "memory");
    __syncthreads();
    if (threadIdx.x == 0) {
        const unsigned x = xb_xcc_id();
        __builtin_amdgcn_s_waitcnt(0);
        unsigned nloc = st[0], nx = st[1];
        if (nloc == 0u) { xcd_barrier_complete(bar, x, nloc, nx); st[0] = nloc; st[1] = nx; }
        const unsigned old = xb_add(&bar[XB_XSUB(x)], 1u);
        const unsigned gen = old / nloc;
        if (old + 1u == (gen + 1u) * nloc) {
            __builtin_amdgcn_fence(__ATOMIC_RELEASE, "agent");
            asm volatile("s_waitcnt vmcnt(0)" ::: "memory");
            const unsigned og = xb_add(&bar[XB_TOP], 1u);
            const unsigned tg = og / nx;
            if (og + 1u == (tg + 1u) * nx) xb_add(&bar[XB_TOPGEN], 1u);
            else XB_SPIN(xb_ld(&bar[XB_TOPGEN]) == tg, bar);
            __builtin_amdgcn_fence(__ATOMIC_ACQUIRE, "agent");
            xb_add(&bar[XB_XGEN(x)], 1u);
            asm volatile("s_waitcnt vmcnt(0)" ::: "memory");
        } else {
            XB_SPIN(xb_ld(&bar[XB_XGEN(x)]) == gen, bar);
            __builtin_amdgcn_fence(__ATOMIC_ACQUIRE, "agent");
            asm volatile("s_waitcnt vmcnt(0)" ::: "memory");
        }
    }
    __syncthreads();
}

#define LAUNDER()
__global__ void __launch_bounds__(256, 3) mega(Params p_unused) {
    extern __shared__ __attribute__((aligned(16))) unsigned char smem[];
    if (threadIdx.x == 0) *(u32x4*)(smem + MISC + 16) = (u32x4){0u, 0u, 0u, 0u};
    __syncthreads();
    xcd_barrier_post((unsigned*)(getp().ws + OFF_BAR));
#define GSYNC() xcd_barrier((unsigned*)(getp().ws + OFF_BAR), (volatile LAS unsigned*)(smem + MISC + 16))

    ph_rope(getp());
    ph_mod(getp(), smem);
    ph_tconv_mix(getp(), 0, smem);
    ph_wcomp(getp(), 0, smem);
    GSYNC();
    {
        const Params& p = getp();
        const float* mod = (const float*)(p.ws + OFF_MOD);
        NormArgs a;
        a.xin = p.x; a.Y = nullptr; a.slots = nullptr; a.gpost = nullptr; a.gt = nullptr;
        a.mode = 0; a.gpre = p.g_pre_mix; a.sc = mod + 1024; a.sh = mod + 0; a.xres = nullptr; a.out_f32 = 0;
        ph_norm(p, a);
    }
    GSYNC();
#pragma unroll 1
    for (int l = 0; l < DEPTH_; ++l) {
        ph_gemm_z(getp(), smem);
        GSYNC();
        ph_mix1(getp(), l, smem);
        GSYNC();
        ph_mixc2(getp());
        ph_mix_a2(getp(), l, smem);
        GSYNC();
        { const Params& p = getp(); for (int it = blockIdx.x; it < 2048; it += gridDim.x) mixc3_item(p, l, it, smem); }
        GSYNC();
        ph_merge(getp(), smem);
        GSYNC();
        ph_outproj(getp(), smem);
        GSYNC();
        {
            const Params& p = getp();
        const float* mod = (const float*)(p.ws + OFF_MOD);
        NormArgs a;
            a.xin = nullptr; a.slots = nullptr;
            a.mode = 1; a.Y = (const bf16_t*)(p.ws + OFF_R1 + R1_QC); a.xres = (l == 0) ? p.x : nullptr; a.out_f32 = 0;
            a.gpost = p.g_post_mix + l * 1024; a.gt = mod + (size_t)l * 8 * 6144 + 2048;
            a.gpre = p.g_pre_ffn + l * 1024; a.sc = mod + (size_t)l * 8 * 6144 + 4096; a.sh = mod + (size_t)l * 8 * 6144 + 3072;
            ph_norm(p, a);
        }
        GSYNC();
        ph_router(getp(), l, smem);
        ph_tconv_moe(getp(), l, smem);
        GSYNC();
        ph_moe1(getp(), l, smem);
        GSYNC();
        ph_moe2(getp(), l, smem);
        GSYNC();
        {
            const Params& p = getp();
        const float* mod = (const float*)(p.ws + OFF_MOD);
        NormArgs a;
            a.xin = nullptr; a.Y = nullptr;
            a.mode = 2; a.slots = (const bf16_t*)(p.ws + OFF_R1); a.xres = nullptr; a.out_f32 = (l + 1 == DEPTH_) ? 1 : 0;
            a.gpost = p.g_post_ffn + l * 1024; a.gt = mod + (size_t)l * 8 * 6144 + 5120;
            a.gpre = nullptr; a.sc = nullptr; a.sh = nullptr;
            if (l + 1 < DEPTH_) { a.gpre = p.g_pre_mix + (l + 1) * 1024; a.sc = mod + (size_t)(l + 1) * 8 * 6144 + 1024; a.sh = mod + (size_t)(l + 1) * 8 * 6144 + 0; }
            ph_norm(p, a);
        }
        if (l + 1 < DEPTH_) {
            ph_tconv_mix(getp(), l + 1, smem);
            ph_wcomp(getp(), l + 1, smem);
            GSYNC();
        }
    }
}

extern "C" void kernel_launch(void* const* d_in, const int* in_sizes, int n_in, void* d_out, int out_size, void* d_ws, size_t ws_size, hipStream_t stream) {
    if (n_in < 26 || ws_size < WS_TOTAL) { fprintf(stderr, "kernel_launch: bad inputs / workspace too small (%zu < %zu)\n", ws_size, (size_t)WS_TOTAL); return; }
    Params p;
    memset(&p, 0, sizeof(p));
    p.x = (const float*)d_in[0]; p.c = (const float*)d_in[1]; p.positions = (const int*)d_in[2]; p.ada_w = (const float*)d_in[3]; p.ada_b = (const float*)d_in[4];
    p.g_pre_mix = (const float*)d_in[5]; p.g_post_mix = (const float*)d_in[6]; p.g_pre_ffn = (const float*)d_in[7]; p.g_post_ffn = (const float*)d_in[8];
    p.w_in = (const float*)d_in[9]; p.g_kv = (const float*)d_in[10]; p.w_uk = (const float*)d_in[11]; p.w_uv = (const float*)d_in[12]; p.g_ret = (const float*)d_in[13];
    p.w_o_a = (const float*)d_in[14]; p.w_o_b = (const float*)d_in[15]; p.w_o_c = (const float*)d_in[16]; p.w_out = (const float*)d_in[17];
    p.w_router = (const float*)d_in[18]; p.router_bias = (const float*)d_in[19]; p.w1 = (const float*)d_in[20]; p.w3 = (const float*)d_in[21]; p.w2 = (const float*)d_in[22];
    p.ws1 = (const float*)d_in[23]; p.ws3 = (const float*)d_in[24]; p.ws2 = (const float*)d_in[25];
    p.out = (float*)d_out; p.ws = (unsigned char*)d_ws;
    static int grid_blocks = 0;
    if (!grid_blocks) {
        int dev = 0, cus = 0, per_cu = 0;
        (void)hipGetDevice(&dev);
        (void)hipDeviceGetAttribute(&cus, hipDeviceAttributeMultiprocessorCount, dev);
        (void)hipFuncSetAttribute((const void*)mega, hipFuncAttributeMaxDynamicSharedMemorySize, DYN_LDS);
        (void)hipOccupancyMaxActiveBlocksPerMultiprocessor(&per_cu, mega, 256, DYN_LDS);
        if (per_cu < 1) per_cu = 1;
        if (per_cu > 3) per_cu = 3;
        grid_blocks = cus * per_cu;
    }
    (void)hipMemsetAsync((unsigned char*)d_ws + OFF_CTL, 0, 32 * 1024, stream);
    void* args[] = {&p};
    hipError_t e = hipLaunchCooperativeKernel((void*)mega, dim3(grid_blocks), dim3(256), args, DYN_LDS, stream);
    if (e != hipSuccess) fprintf(stderr, "cooperative launch failed: %s (grid %d)\n", hipGetErrorString(e), grid_blocks);
}
```
